# Optimizing an MI355X kernel written in HIP

```python
import jax, jax.numpy as jnp
from jax import lax
import numpy as np

D_MODEL = 1024
BATCH = 4
SEQ = 4096
DEPTH = 4

N_MIXERS = 3
EXPAND = 2
D_INNER = EXPAND * D_MODEL
POOL_WINDOWS = (2, 4, 8, 16)
N_POOL_GROUPS = len(POOL_WINDOWS)
POOL_GROUP = D_INNER // N_POOL_GROUPS
CONV_WIDTH = 3
N_HEADS = 16
QK_NOPE_DIM = 128
QK_ROPE_DIM = 64
V_HEAD_DIM = D_INNER // N_HEADS
Q_LORA_RANK = 384
KV_LORA_RANK = 256
MLA_IN_DIM = Q_LORA_RANK + KV_LORA_RANK + QK_ROPE_DIM + D_INNER
ATTN_SCALE = (QK_NOPE_DIM + QK_ROPE_DIM) ** -0.5
ROPE_BASE = 10000.0
Q_BLOCK = 128
NORM_EPS = 1e-6
MAX_POS_OFFSET = 1024
N_POOL = (DEPTH + 2) // 3
N_CONV = (DEPTH + 1) // 3
N_MLA = DEPTH // 3

kernel_name = "hybrid_pool_conv_mla_gated_trunk"


def rms_norm(x, g):
    xf = x.astype(jnp.float32)
    y = xf * lax.rsqrt(jnp.mean(xf * xf, axis=-1, keepdims=True) + NORM_EPS)
    return (y * g.astype(jnp.float32)).astype(x.dtype)


def pool_mixer(xn, w_in, w_grp, scale, w_out):
    B, S, _ = xn.shape
    u, z = jnp.split(xn @ w_in, 2, axis=-1)
    uf = u.astype(jnp.float32).reshape(B, S, N_POOL_GROUPS, POOL_GROUP)
    cs = jnp.cumsum(uf, axis=1)
    count_base = jnp.arange(1, S + 1, dtype=jnp.float32)
    pooled = []
    for g, w in enumerate(POOL_WINDOWS):
        c = cs[:, :, g]
        prev = jnp.pad(c, ((0, 0), (w, 0), (0, 0)))[:, :S]
        mean = (c - prev) / jnp.minimum(count_base, float(w))[None, :, None]
        pooled.append(mean - uf[:, :, g])
    pooled = jnp.stack(pooled, axis=2).astype(u.dtype)
    mixed = jnp.einsum('bsgc,gcd->bsgd', pooled, w_grp).reshape(B, S, D_INNER) * scale
    return (mixed * jax.nn.silu(z)) @ w_out


def causal_depthwise_conv(x, w):
    return lax.conv_general_dilated(
        x, w[:, None, :].astype(x.dtype), window_strides=(1,),
        padding=[(CONV_WIDTH - 1, 0)], dimension_numbers=('NWC', 'WIO', 'NWC'),
        feature_group_count=x.shape[-1])


def conv_mixer(xn, w_in, conv_w, w_out):
    b, c, h, z = jnp.split(xn @ w_in, 4, axis=-1)
    y = b * causal_depthwise_conv(c * h, conv_w)
    return (y * jax.nn.silu(z)) @ w_out


def apply_rope(x, cos, sin):
    half = x.shape[-1] // 2
    x1, x2 = x[..., :half], x[..., half:]
    return jnp.concatenate([x1 * cos - x2 * sin, x2 * cos + x1 * sin], axis=-1).astype(x.dtype)


def causal_block_attention(q_nope, q_rope, k_nope, k_rope, v):
    B, S, H, _ = q_nope.shape
    nb = S // Q_BLOCK
    qn = q_nope.reshape(B, nb, Q_BLOCK, H, QK_NOPE_DIM).transpose(1, 0, 2, 3, 4)
    qr = q_rope.reshape(B, nb, Q_BLOCK, H, QK_ROPE_DIM).transpose(1, 0, 2, 3, 4)
    starts = jnp.arange(nb, dtype=jnp.int32) * Q_BLOCK
    key_idx = jnp.arange(S, dtype=jnp.int32)

    def one_block(args):
        qn_b, qr_b, start = args
        s = (jnp.einsum('bqhd,bkhd->bhqk', qn_b, k_nope).astype(jnp.float32)
             + jnp.einsum('bqhr,bkr->bhqk', qr_b, k_rope).astype(jnp.float32)) * ATTN_SCALE
        q_idx = start + jnp.arange(Q_BLOCK, dtype=jnp.int32)
        mask = key_idx[None, :] <= q_idx[:, None]
        s = jnp.where(mask[None, None], s, jnp.float32(-1e30))
        p = jax.nn.softmax(s, axis=-1).astype(v.dtype)
        return jnp.einsum('bhqk,bkhd->bqhd', p, v)

    o = lax.map(one_block, (qn, qr, starts))
    return o.transpose(1, 0, 2, 3, 4).reshape(B, S, H, V_HEAD_DIM)


def mla_mixer(xn, cos, sin, w_in, q_norm, w_q_up, kv_norm, w_kv_up, w_out):
    B, S, _ = xn.shape
    h = xn @ w_in
    q_lat, kv_lat, k_rope, z = jnp.split(
        h, [Q_LORA_RANK, Q_LORA_RANK + KV_LORA_RANK,
            Q_LORA_RANK + KV_LORA_RANK + QK_ROPE_DIM], axis=-1)
    q = (rms_norm(q_lat, q_norm) @ w_q_up).reshape(B, S, N_HEADS, QK_NOPE_DIM + QK_ROPE_DIM)
    q_nope = q[..., :QK_NOPE_DIM]
    q_rope = apply_rope(q[..., QK_NOPE_DIM:], cos[:, :, None, :], sin[:, :, None, :])
    kv = (rms_norm(kv_lat, kv_norm) @ w_kv_up).reshape(B, S, N_HEADS, QK_NOPE_DIM + V_HEAD_DIM)
    k_nope, v = kv[..., :QK_NOPE_DIM], kv[..., QK_NOPE_DIM:]
    k_rope = apply_rope(k_rope, cos, sin)
    o = causal_block_attention(q_nope, q_rope, k_nope, k_rope, v)
    return (o.reshape(B, S, D_INNER) * jax.nn.silu(z)) @ w_out


def setup_inputs(seed: int = 0) -> dict:
    key = jax.random.key(seed)
    ks = jax.random.split(key, 20)

    def normal(k, shape, scale):
        return jax.random.normal(k, shape, jnp.float32) * scale

    def gain(k, shape):
        return 1.0 + 0.02 * jax.random.normal(k, shape, jnp.float32)

    x = normal(ks[0], (BATCH, SEQ, D_MODEL), 1.0)
    offset = jax.random.randint(ks[1], (BATCH, 1), 0, MAX_POS_OFFSET, dtype=jnp.int32)
    positions = (offset + jnp.arange(SEQ, dtype=jnp.int32)[None, :]).astype(jnp.int32)
    return {
        "x": x,
        "positions": positions,
        "pool_norm": gain(ks[2], (N_POOL, D_MODEL)),
        "pool_w_in": normal(ks[3], (N_POOL, D_MODEL, 2 * D_INNER), D_MODEL ** -0.5),
        "pool_w_grp": normal(ks[4], (N_POOL, N_POOL_GROUPS, POOL_GROUP, POOL_GROUP), POOL_GROUP ** -0.5),
        "pool_scale": gain(ks[5], (N_POOL, D_INNER)),
        "pool_w_out": normal(ks[6], (N_POOL, D_INNER, D_MODEL), D_INNER ** -0.5),
        "conv_norm": gain(ks[7], (N_CONV, D_MODEL)),
        "conv_w_in": normal(ks[8], (N_CONV, D_MODEL, 4 * D_INNER), D_MODEL ** -0.5),
        "conv_w": normal(ks[9], (N_CONV, CONV_WIDTH, D_INNER), CONV_WIDTH ** -0.5),
        "conv_w_out": normal(ks[10], (N_CONV, D_INNER, D_MODEL), D_INNER ** -0.5),
        "mla_norm": gain(ks[11], (N_MLA, D_MODEL)),
        "mla_w_in": normal(ks[12], (N_MLA, D_MODEL, MLA_IN_DIM), D_MODEL ** -0.5),
        "mla_q_norm": gain(ks[13], (N_MLA, Q_LORA_RANK)),
        "mla_w_q_up": normal(ks[14], (N_MLA, Q_LORA_RANK, N_HEADS * (QK_NOPE_DIM + QK_ROPE_DIM)), Q_LORA_RANK ** -0.5),
        "mla_kv_norm": gain(ks[15], (N_MLA, KV_LORA_RANK)),
        "mla_w_kv_up": normal(ks[16], (N_MLA, KV_LORA_RANK, N_HEADS * (QK_NOPE_DIM + V_HEAD_DIM)), KV_LORA_RANK ** -0.5),
        "mla_w_out": normal(ks[17], (N_MLA, D_INNER, D_MODEL), D_INNER ** -0.5),
        "final_norm": gain(ks[18], (D_MODEL,)),
    }


def reference(x, positions, pool_norm, pool_w_in, pool_w_grp, pool_scale, pool_w_out,
              conv_norm, conv_w_in, conv_w, conv_w_out,
              mla_norm, mla_w_in, mla_q_norm, mla_w_q_up, mla_kv_norm, mla_w_kv_up, mla_w_out,
              final_norm):
    inv_freq = ROPE_BASE ** (-jnp.arange(0, QK_ROPE_DIM, 2, dtype=jnp.float32) / QK_ROPE_DIM)
    angles = positions.astype(jnp.float32)[..., None] * inv_freq
    cos, sin = jnp.cos(angles).astype(x.dtype), jnp.sin(angles).astype(x.dtype)

    for i in range(DEPTH):
        kind, j = i % N_MIXERS, i // N_MIXERS
        if kind == 0:
            xn = rms_norm(x, pool_norm[j])
            x = x + pool_mixer(xn, pool_w_in[j], pool_w_grp[j], pool_scale[j], pool_w_out[j])
        elif kind == 1:
            xn = rms_norm(x, conv_norm[j])
            x = x + conv_mixer(xn, conv_w_in[j], conv_w[j], conv_w_out[j])
        else:
            xn = rms_norm(x, mla_norm[j])
            x = x + mla_mixer(xn, cos, sin, mla_w_in[j], mla_q_norm[j], mla_w_q_up[j],
                              mla_kv_norm[j], mla_w_kv_up[j], mla_w_out[j])
    return rms_norm(x, final_norm)
```

```cpp
#include <hip/hip_runtime.h>
#include <cstdio>
#include <cstdint>

#ifndef MK_N_LAUNCHES
#define MK_N_LAUNCHES 1
#endif
#ifndef MK_DEBUG
#define MK_DEBUG 0
#endif

constexpr int NB = 4, SEQ = 4096, DM = 1024, M = NB * SEQ, EI = 2048;
constexpr int QL = 384, KVL = 256, RD = 64, NHEAD = 16, DN = 128, DV = 128;
constexpr int MLA_IN = QL + KVL + RD + EI;
constexpr float NORM_EPS = 1e-6f;
constexpr float ATTN_SCALE = 0.07216878364870322f;
constexpr float ROPE_BASE = 10000.0f;

constexpr size_t MiB = 1u << 20;
constexpr size_t WS_CTL = 0, CTL_ZERO_BYTES = 1 * MiB;
constexpr size_t WS_SSQ = 1 * MiB;
constexpr size_t WS_SSQQ = 2 * MiB;
constexpr size_t WS_SSQKV = 2 * MiB + 512 * 1024;
constexpr size_t WS_DBG = 3 * MiB;
constexpr size_t WS_COS = 4 * MiB, WS_SIN = 6 * MiB;
constexpr size_t WS_HALO = 8 * MiB;
constexpr size_t WS_WCONV_IN = 12 * MiB;
constexpr size_t WS_WCONV_OUT = 28 * MiB;
constexpr size_t WS_WPOOL0 = 32 * MiB, WS_WPOOL1 = 46 * MiB;
constexpr size_t WPOOL_IN = 0, WPOOL_GRP = 8 * MiB, WPOOL_OUT = 10 * MiB;
constexpr size_t WS_WMLA_B1 = 60 * MiB;
constexpr size_t WS_WMLA_BZ = 62 * MiB;
constexpr size_t WS_WMLA_QUP = 66 * MiB;
constexpr size_t WS_WMLA_KVUP = 69 * MiB;
constexpr size_t WS_WMLA_OUT = 71 * MiB;
constexpr size_t WS_XB = 76 * MiB;
constexpr size_t WS_A1 = 108 * MiB;
constexpr size_t WS_A2 = 172 * MiB;
constexpr size_t WS_QLAT = 236 * MiB;
constexpr size_t WS_END = 248 * MiB;
constexpr size_t WS_QR = WS_WCONV_IN;
constexpr size_t WS_KVLAT = WS_WPOOL0;
constexpr size_t WS_KROPE = WS_WPOOL0 + 8 * MiB;

#define GAS __attribute__((address_space(1)))
#define LAS __attribute__((address_space(3)))
typedef unsigned short bf16;
typedef unsigned v4u __attribute__((ext_vector_type(4)));
typedef unsigned v2u __attribute__((ext_vector_type(2)));
typedef float f32x4 __attribute__((ext_vector_type(4)));
typedef float f32x2 __attribute__((ext_vector_type(2)));
typedef float f32x16 __attribute__((ext_vector_type(16)));
typedef short bf16x8 __attribute__((ext_vector_type(8)));
typedef short s16x4 __attribute__((ext_vector_type(4)));
typedef GAS unsigned gu32;
#define RLX_AGENT __ATOMIC_RELAXED, __HIP_MEMORY_SCOPE_AGENT
#define LDS_WAIT() asm volatile("s_waitcnt lgkmcnt(0)" ::: "memory")
#define VM_WAIT() asm volatile("s_waitcnt vmcnt(0)" ::: "memory")

__device__ __forceinline__ unsigned cvt_pk_bf16(float lo, float hi) { unsigned r; asm volatile("v_cvt_pk_bf16_f32 %0, %1, %2" : "=v"(r) : "v"(lo), "v"(hi)); return r; }
__device__ __forceinline__ float bf2f(unsigned short h) { return __uint_as_float((unsigned)h << 16); }
__device__ __forceinline__ float bflo(unsigned w) { return __uint_as_float(w << 16); }
__device__ __forceinline__ float bfhi(unsigned w) { return __uint_as_float(w & 0xffff0000u); }
__device__ __forceinline__ unsigned short f2bf_bits(float f) { return (unsigned short)(cvt_pk_bf16(f, 0.f) & 0xffffu); }
__device__ __forceinline__ v4u pack8(f32x4 a, f32x4 b) { v4u w; w.x = cvt_pk_bf16(a[0], a[1]); w.y = cvt_pk_bf16(a[2], a[3]); w.z = cvt_pk_bf16(b[0], b[1]); w.w = cvt_pk_bf16(b[2], b[3]); return w; }
__device__ __forceinline__ float silu_f(float z) { return z * __builtin_amdgcn_rcpf(1.0f + __builtin_amdgcn_exp2f(-1.4426950408889634f * z)); }
__device__ __forceinline__ f32x4 silu4(f32x4 z) { f32x4 r; r[0] = silu_f(z[0]); r[1] = silu_f(z[1]); r[2] = silu_f(z[2]); r[3] = silu_f(z[3]); return r; }
__device__ __forceinline__ float wave_sum(float v) {
#pragma unroll
    for (int o = 1; o < 64; o <<= 1) v += __shfl_xor(v, o);
    return v;
}
__device__ __forceinline__ float fq_sum(float s) { s += __shfl_xor(s, 16); s += __shfl_xor(s, 32); return s; }

namespace pg8 {
typedef unsigned short bf16_t;
constexpr int BM = 256, BK = 64, HALF = 128, HTB = HALF * BK * 2  , STAGE_BYTES = 8 * HTB, NXCD = 8, WGM = 8;

__host__ __device__ __forceinline__ int lds_byte(int r, int c) { const int st = (r >> 4) * 2 + (c >> 5), rr = r & 15, cc = c & 31, ob = rr * 64 + cc * 2; return st * 1024 + (ob ^ (((ob >> 9) & 1) << 5)); }
__host__ __device__ __forceinline__ void stage_rc(int b, int& R, int& C) { const int st = b / 1024, sb = b % 1024, swz = sb ^ (((sb >> 9) & 1) << 5); R = (st >> 1) * 16 + swz / 64; C = (st & 1) * 32 + (swz % 64) / 2; }
__host__ __device__ __forceinline__ int perm32(int rho) { const int n = rho >> 4, i = rho & 15; return 8 * (i >> 2) + 4 * n + (i & 3); }

struct Unit { int pm, pn; };
struct Gemm { const bf16_t* A; const bf16_t* Bt; int lda, ldb, K, agt, ags; };

struct StaticOrder {
    int nM, nN, nwg, G, c;
    __host__ __device__ void init(int M_, int N_, int G_, int c_) { nM = M_ / BM; nN = N_ / BM; nwg = nM * nN; G = G_; c = c_; }
    __host__ __device__ bool next(int i, Unit& u) const {
        const long L = (long)i * G + c; if (L >= nwg) return false;
        int wgid = (int)L; { const int q = nwg / NXCD, r = nwg % NXCD, xcd = wgid % NXCD, off = wgid / NXCD; wgid = (xcd < r ? xcd * (q + 1) : r * (q + 1) + (xcd - r) * q) + off; }
        const int nig = WGM * nN, gid = wgid / nig, fm = gid * WGM, gsz = (nM - fm) < WGM ? (nM - fm) : WGM;
        u.pm = fm + ((wgid % nig) % gsz); u.pn = (wgid % nig) / gsz; return true;
    }
};

template <class Epi, class Sched, bool ALIGN_EPI = false>
__device__ __forceinline__ void gemm_phase(LAS unsigned char* lds, const Gemm g, const Sched& S, const Epi& E) {
    int tid_ = threadIdx.x; asm volatile("" : "+v"(tid_));
    const int tid = tid_, wid = __builtin_amdgcn_readfirstlane(tid >> 6), lane = tid & 63, wr = wid >> 2, wc = wid & 3, fr = lane & 15, fq = lane >> 4;
    const int K = g.K, nt = K / BK;
    unsigned voffA[2], voffB[2];
#pragma unroll
    for (int i = 0; i < 2; ++i) { int R, C; stage_rc(tid * 16 + i * 8192, R, C); const int Rb = (R & ~31) + perm32(R & 31);
        voffA[i] = (unsigned)(R * g.lda + C) * 2u; voffB[i] = (unsigned)(Rb * g.ldb + C) * 2u; }
    const size_t kstep = (size_t)(BK * 2);
    const size_t hstepA = (size_t)HALF * g.lda * 2, hstepB = (size_t)HALF * g.ldb * 2;
    const unsigned ldsw = (unsigned)wid * 1024u;
    const int aoff = lds_byte(wr * 64 + fr, fq * 8), boff = lds_byte(wc * 32 + fr, fq * 8);
#define PG8_AOF(u) ((const char*)g.A + ((size_t)(u).pm * BM * g.lda + (g.agt ? (size_t)((u).pn / g.agt) * g.ags : (size_t)0)) * 2)
#define PG8_BOF(u) ((const char*)g.Bt + (size_t)(u).pn * BM * g.ldb * 2)
#define PG8_SA(b, h) (((b) * 2 + (h)) * HTB)
#define PG8_SB(b, h) ((4 + (b) * 2 + (h)) * HTB)
#define PG8_STAGE(bufoff, gbase, voff) do { _Pragma("unroll") for (int _i = 0; _i < 2; ++_i) \
        __builtin_amdgcn_global_load_lds((const unsigned*)((const char*)(gbase) + (voff)[_i]), (LAS unsigned*)(lds + (bufoff) + ldsw + _i * 8192), 16, 0, 0); } while (0)
#define PG8_LDA(dst, b, h) do { _Pragma("unroll") for (int m = 0; m < 4; ++m) _Pragma("unroll") for (int k = 0; k < 2; ++k) dst[m][k] = *(const LAS bf16x8*)(lds + PG8_SA(b, h) + aoff + m * 2048 + k * 1024); } while (0)
#define PG8_LDB(dst, b, h) do { _Pragma("unroll") for (int n = 0; n < 2; ++n) _Pragma("unroll") for (int k = 0; k < 2; ++k) dst[n][k] = *(const LAS bf16x8*)(lds + PG8_SB(b, h) + boff + n * 2048 + k * 1024); } while (0)
#define PG8_MMA(ai, bj, At, Bt) do { __builtin_amdgcn_s_setprio(1); _Pragma("unroll") for (int m = 0; m < 4; ++m) _Pragma("unroll") for (int n = 0; n < 2; ++n) _Pragma("unroll") for (int k = 0; k < 2; ++k) \
        acc[ai][bj][m][n] = __builtin_amdgcn_mfma_f32_16x16x32_bf16(Bt[n][k], At[m][k], acc[ai][bj][m][n], 0, 0, 0); __builtin_amdgcn_s_setprio(0); } while (0)
#define PG8_WAIT_V(n) asm volatile("s_waitcnt vmcnt(" #n ")" ::: "memory")
#define PG8_WAIT_L(n) asm volatile("s_waitcnt lgkmcnt(" #n ")" ::: "memory")
#define PG8_BAR __builtin_amdgcn_s_barrier()
#define PG8_SCHED __builtin_amdgcn_sched_barrier(0)
    Unit cur, nxt; int ui = 0;
    if (!S.next(0, cur)) return;
    f32x4 acc[2][2][4][2];
#pragma unroll
    for (int a = 0; a < 2; ++a)
#pragma unroll
        for (int b = 0; b < 2; ++b)
#pragma unroll
            for (int m = 0; m < 4; ++m)
#pragma unroll
                for (int n = 0; n < 2; ++n) acc[a][b][m][n] = (f32x4){0.f, 0.f, 0.f, 0.f};
    bf16x8 At[4][2], B0[2][2], B1[2][2];
    const char* cA = PG8_AOF(cur); const char* cB = PG8_BOF(cur);
    PG8_STAGE(PG8_SB(0, 0), cB, voffB); PG8_STAGE(PG8_SB(0, 1), cB + hstepB, voffB); PG8_STAGE(PG8_SA(0, 0), cA, voffA); PG8_STAGE(PG8_SA(0, 1), cA + hstepA, voffA);
    if (wr == 1) PG8_BAR;
    PG8_WAIT_V(2); PG8_BAR;
    PG8_STAGE(PG8_SB(1, 0), cB + kstep, voffB); PG8_STAGE(PG8_SA(1, 0), cA + kstep, voffA); PG8_STAGE(PG8_SB(1, 1), cB + hstepB + kstep, voffB);
    PG8_WAIT_V(6); PG8_BAR;
    for (;;) {
        const bool has_next = S.next(ui + 1, nxt);
        const char* nA = has_next ? PG8_AOF(nxt) : cA; const char* nB = has_next ? PG8_BOF(nxt) : cB;
#pragma nounroll
        for (int t = 0; t < nt; t += 2) {
            const bool last = (t == nt - 2);
            const char* a1 = cA + (size_t)(t + 1) * kstep;
            const char* a2 = last ? nA : cA + (size_t)(t + 2) * kstep; const char* b2 = last ? nB : cB + (size_t)(t + 2) * kstep;
            const char* a3 = a2 + kstep; const char* b3 = b2 + kstep;
            PG8_LDB(B0, 0, 0); PG8_LDB(B1, 0, 1); PG8_SCHED; PG8_LDA(At, 0, 0); PG8_STAGE(PG8_SA(1, 1), a1 + hstepA, voffA);
            PG8_WAIT_V(8); PG8_WAIT_L(0); PG8_BAR; PG8_MMA(0, 0, At, B0); PG8_MMA(0, 1, At, B1); PG8_BAR; PG8_SCHED;
            PG8_LDA(At, 0, 1); PG8_STAGE(PG8_SB(0, 0), b2, voffB); PG8_STAGE(PG8_SB(0, 1), b2 + hstepB, voffB); PG8_STAGE(PG8_SA(0, 0), a2, voffA);
            PG8_WAIT_V(8); PG8_WAIT_L(0); PG8_BAR; PG8_MMA(1, 0, At, B0); PG8_MMA(1, 1, At, B1); PG8_BAR; PG8_SCHED;
            PG8_LDB(B0, 1, 0); PG8_LDB(B1, 1, 1); PG8_SCHED; PG8_LDA(At, 1, 0); PG8_STAGE(PG8_SA(0, 1), a2 + hstepA, voffA);
            PG8_WAIT_V(8); PG8_WAIT_L(0); PG8_BAR; PG8_MMA(0, 0, At, B0); PG8_MMA(0, 1, At, B1); PG8_BAR; PG8_SCHED;
            PG8_LDA(At, 1, 1); PG8_STAGE(PG8_SB(1, 0), b3, voffB); PG8_STAGE(PG8_SB(1, 1), b3 + hstepB, voffB); PG8_STAGE(PG8_SA(1, 0), a3, voffA);
            PG8_WAIT_V(8); PG8_WAIT_L(0); PG8_BAR; PG8_MMA(1, 0, At, B0); PG8_MMA(1, 1, At, B1); PG8_BAR; PG8_SCHED;
        }
        if constexpr (ALIGN_EPI) { if (wr == 0) PG8_BAR; }
        E(acc, cur, wr, wc, fr, fq);
        if (!has_next) break;
#pragma unroll
        for (int a = 0; a < 2; ++a)
#pragma unroll
            for (int b = 0; b < 2; ++b)
#pragma unroll
                for (int m = 0; m < 4; ++m)
#pragma unroll
                    for (int n = 0; n < 2; ++n) acc[a][b][m][n] = (f32x4){0.f, 0.f, 0.f, 0.f};
        cur = nxt; cA = nA; cB = nB; ++ui;
        if constexpr (ALIGN_EPI) { if (wr == 1) PG8_BAR; }
    }
    PG8_WAIT_V(0);
    if constexpr (!ALIGN_EPI) { if (wr == 0) PG8_BAR; }
    PG8_BAR;
#undef PG8_AOF
#undef PG8_BOF
#undef PG8_SA
#undef PG8_SB
#undef PG8_STAGE
#undef PG8_LDA
#undef PG8_LDB
#undef PG8_MMA
#undef PG8_WAIT_V
#undef PG8_WAIT_L
#undef PG8_BAR
#undef PG8_SCHED
}
}

namespace epi {
using pg8::Unit; using pg8::BM; using pg8::HALF;
typedef f32x4 Acc[2][2][4][2];
#define EPI_ROWLOOP for (int ai = 0; ai < 2; ++ai) _Pragma("unroll") for (int m = 0; m < 4; ++m)
__device__ __forceinline__ float rstd16(const float* SSQ, int row, int fq, float inv_n) {
    const f32x4 v = *(const f32x4*)(SSQ + (size_t)row * 16 + fq * 4);
    const float s = fq_sum((v[0] + v[1]) + (v[2] + v[3]));
    return 1.0f / sqrtf(s * inv_n + NORM_EPS);
}
__device__ __forceinline__ float sq8(f32x4 a, f32x4 b) { return (a[0] * a[0] + a[1] * a[1]) + (a[2] * a[2] + a[3] * a[3]) + (b[0] * b[0] + b[1] * b[1]) + (b[2] * b[2] + b[3] * b[3]); }

struct EpiPoolIn {
    bf16* U; bf16* SZ; bf16* HALO; const float* SSQ;
    __device__ __forceinline__ void operator()(const Acc& acc, const Unit& u, int wr, int wc, int fr, int fq) const {
        const int row0 = u.pm * BM + wr * 64 + fr; const bool isz = u.pn >= 8; const int colt = (u.pn & 7) * BM + wc * 32 + 8 * fq;
#pragma unroll
        EPI_ROWLOOP { const int row = row0 + ai * HALF + m * 16; const float rs = rstd16(SSQ, row, fq, 1.0f / DM);
#pragma unroll
            for (int bj = 0; bj < 2; ++bj) { f32x4 v0 = acc[ai][bj][m][0] * rs, v1 = acc[ai][bj][m][1] * rs; const int col = colt + bj * HALF;
                if (isz) { v0 = silu4(v0); v1 = silu4(v1); *(v4u*)(SZ + (size_t)row * EI + col) = pack8(v0, v1); }
                else { const v4u w = pack8(v0, v1); *(v4u*)(U + (size_t)row * EI + col) = w;
                    if (ai == 1 && wr == 1 && m == 3) *(v4u*)(HALO + ((size_t)u.pm * 16 + fr) * EI + col) = w; } }
            asm volatile("" ::: "memory"); }
    }
};
struct EpiPoolGrp {
    bf16* Y; const float* scale;
    __device__ __forceinline__ void operator()(const Acc& acc, const Unit& u, int wr, int wc, int fr, int fq) const {
        const int row0 = u.pm * BM + wr * 64 + fr; const int colt = u.pn * BM + wc * 32 + 8 * fq;
        f32x4 sc[2][2];
#pragma unroll
        for (int bj = 0; bj < 2; ++bj) { sc[bj][0] = *(const f32x4*)(scale + colt + bj * HALF); sc[bj][1] = *(const f32x4*)(scale + colt + bj * HALF + 4); }
#pragma unroll
        EPI_ROWLOOP { const int row = row0 + ai * HALF + m * 16;
#pragma unroll
            for (int bj = 0; bj < 2; ++bj) { bf16* p = Y + (size_t)row * EI + colt + bj * HALF; const v4u s = *(const v4u*)p;
                f32x4 v0 = acc[ai][bj][m][0] * sc[bj][0], v1 = acc[ai][bj][m][1] * sc[bj][1];
                v0 = v0 * (f32x4){bflo(s.x), bfhi(s.x), bflo(s.y), bfhi(s.y)}; v1 = v1 * (f32x4){bflo(s.z), bfhi(s.z), bflo(s.w), bfhi(s.w)};
                *(v4u*)p = pack8(v0, v1); }
            asm volatile("" ::: "memory"); }
    }
};
struct EpiResid {
    const float* Xin; float* Xout; bf16* XB; float* SSQ;
    __device__ __forceinline__ void operator()(const Acc& acc, const Unit& u, int wr, int wc, int fr, int fq) const {
        const int row0 = u.pm * BM + wr * 64 + fr; const int colt = u.pn * BM + wc * 32 + 8 * fq;
#pragma unroll
        EPI_ROWLOOP { const int row = row0 + ai * HALF + m * 16; float ss = 0.f;
#pragma unroll
            for (int bj = 0; bj < 2; ++bj) { const size_t off = (size_t)row * DM + colt + bj * HALF;
                const f32x4 v0 = *(const f32x4*)(Xin + off) + acc[ai][bj][m][0], v1 = *(const f32x4*)(Xin + off + 4) + acc[ai][bj][m][1];
                *(f32x4*)(Xout + off) = v0; *(f32x4*)(Xout + off + 4) = v1; *(v4u*)(XB + off) = pack8(v0, v1); ss += sq8(v0, v1); }
            ss = fq_sum(ss); if (fq == 0) SSQ[(size_t)row * 16 + u.pn * 4 + wc] = ss;
            asm volatile("" ::: "memory"); }
    }
};
struct EpiConvIn {
    bf16* CH; bf16* BZ; const float* SSQ;
    __device__ __forceinline__ void operator()(const Acc& acc, const Unit& u, int wr, int wc, int fr, int fq) const {
        const int row0 = u.pm * BM + wr * 64 + fr; const int j0 = u.pn * 64 + (wc & 1) * 32 + 8 * fq; const bool isch = wc >= 2;
#pragma unroll
        EPI_ROWLOOP { const int row = row0 + ai * HALF + m * 16; const float rs = rstd16(SSQ, row, fq, 1.0f / DM);
            const f32x4 p0 = acc[ai][0][m][0] * rs, p1 = acc[ai][0][m][1] * rs, q0 = acc[ai][1][m][0] * rs, q1 = acc[ai][1][m][1] * rs;
            if (isch) *(v4u*)(CH + (size_t)row * EI + j0) = pack8(p0 * q0, p1 * q1);
            else *(v4u*)(BZ + (size_t)row * EI + j0) = pack8(p0 * silu4(q0), p1 * silu4(q1));
            asm volatile("" ::: "memory"); }
    }
};
__device__ __forceinline__ v4u rope8(f32x4 x1, f32x4 x2, const float* cosr, const float* sinr) {
    const f32x4 c = *(const f32x4*)cosr, s = *(const f32x4*)sinr;
    return pack8(x1 * c - x2 * s, x2 * c + x1 * s);
}
struct EpiMlaIn {
    bf16* KVLAT; bf16* QLAT; bf16* KROPE; float* SSQKV; float* SSQQ; const float* SSQ; const float* COS; const float* SIN;
    __device__ __forceinline__ void operator()(const Acc& acc, const Unit& u, int wr, int wc, int fr, int fq) const {
        const int row0 = u.pm * BM + wr * 64 + fr; const int cl = wc * 32 + 8 * fq;
#pragma unroll
        EPI_ROWLOOP { const int row = row0 + ai * HALF + m * 16; const float rs = rstd16(SSQ, row, fq, 1.0f / DM);
            const f32x4 a0 = acc[ai][0][m][0] * rs, a1 = acc[ai][0][m][1] * rs, b0 = acc[ai][1][m][0] * rs, b1 = acc[ai][1][m][1] * rs;
            if (u.pn == 0) { *(v4u*)(KVLAT + (size_t)row * KVL + cl) = pack8(a0, a1); *(v4u*)(KVLAT + (size_t)row * KVL + HALF + cl) = pack8(b0, b1);
                const float ss = fq_sum(sq8(a0, a1) + sq8(b0, b1)); if (fq == 0) SSQKV[(size_t)row * 4 + wc] = ss; }
            else if (u.pn == 1) { *(v4u*)(QLAT + (size_t)row * QL + cl) = pack8(a0, a1); *(v4u*)(QLAT + (size_t)row * QL + HALF + cl) = pack8(b0, b1);
                const float ss = fq_sum(sq8(a0, a1) + sq8(b0, b1)); if (fq == 0) SSQQ[(size_t)row * 8 + wc] = ss; }
            else { *(v4u*)(QLAT + (size_t)row * QL + 256 + cl) = pack8(a0, a1);
                const float ss = fq_sum(sq8(a0, a1)); if (fq == 0) SSQQ[(size_t)row * 8 + 4 + wc] = ss;
                if (wc < 2) { const int ii = 16 * wc + 4 * fq; *(v4u*)(KROPE + (size_t)row * RD + cl) = rope8(b0, b1, COS + (size_t)row * 32 + ii, SIN + (size_t)row * 32 + ii); } }
            asm volatile("" ::: "memory"); }
    }
};
struct EpiQUp {
    bf16* QN; bf16* QR; const float* SSQQ; const float* COS; const float* SIN; int hh;
    __device__ __forceinline__ void operator()(const Acc& acc, const Unit& u, int wr, int wc, int fr, int fq) const {
        const int row0 = u.pm * BM + wr * 64 + fr; const int cl = wc * 32 + 8 * fq;
#pragma unroll
        EPI_ROWLOOP { const int row = row0 + ai * HALF + m * 16;
            const f32x2 pq = *(const f32x2*)(SSQQ + (size_t)row * 8 + fq * 2); const float rs = 1.0f / sqrtf(fq_sum(pq[0] + pq[1]) * (1.0f / QL) + NORM_EPS);
#pragma unroll
            for (int bj = 0; bj < 2; ++bj) { const f32x4 v0 = acc[ai][bj][m][0] * rs, v1 = acc[ai][bj][m][1] * rs;
                if (u.pn < 4) *(v4u*)(QN + (size_t)row * EI + hh * 1024 + u.pn * BM + bj * HALF + cl) = pack8(v0, v1);
                else { const int hl = (u.pn - 4) * 4 + 2 * bj + (wc >> 1), ii = 16 * (wc & 1) + 4 * fq;
                    *(v4u*)(QR + (size_t)row * 512 + hl * RD + 32 * (wc & 1) + 8 * fq) = rope8(v0, v1, COS + (size_t)row * 32 + ii, SIN + (size_t)row * 32 + ii); } }
            asm volatile("" ::: "memory"); }
    }
};
struct EpiKvUp {
    bf16* KN; bf16* V; const float* SSQKV;
    __device__ __forceinline__ void operator()(const Acc& acc, const Unit& u, int wr, int wc, int fr, int fq) const {
        const int row0 = u.pm * BM + wr * 64 + fr; const int cl = u.pn * DN + wc * 32 + 8 * fq;
#pragma unroll
        EPI_ROWLOOP { const int row = row0 + ai * HALF + m * 16;
            const float rs = 1.0f / sqrtf(fq_sum(SSQKV[(size_t)row * 4 + fq]) * (1.0f / KVL) + NORM_EPS);
            *(v4u*)(KN + (size_t)row * 1024 + cl) = pack8(acc[ai][0][m][0] * rs, acc[ai][0][m][1] * rs);
            *(v4u*)(V + (size_t)row * 1024 + cl) = pack8(acc[ai][1][m][0] * rs, acc[ai][1][m][1] * rs);
            asm volatile("" ::: "memory"); }
    }
};
struct EpiGate {
    bf16* Y; const float* SSQ;
    __device__ __forceinline__ void operator()(const Acc& acc, const Unit& u, int wr, int wc, int fr, int fq) const {
        const int row0 = u.pm * BM + wr * 64 + fr; const int colt = u.pn * BM + wc * 32 + 8 * fq;
#pragma unroll
        EPI_ROWLOOP { const int row = row0 + ai * HALF + m * 16; const float rs = rstd16(SSQ, row, fq, 1.0f / DM);
#pragma unroll
            for (int bj = 0; bj < 2; ++bj) { bf16* p = Y + (size_t)row * EI + colt + bj * HALF; const v4u s = *(const v4u*)p;
                const f32x4 v0 = silu4(acc[ai][bj][m][0] * rs) * (f32x4){bflo(s.x), bfhi(s.x), bflo(s.y), bfhi(s.y)};
                const f32x4 v1 = silu4(acc[ai][bj][m][1] * rs) * (f32x4){bflo(s.z), bfhi(s.z), bflo(s.w), bfhi(s.w)};
                *(v4u*)p = pack8(v0, v1); }
            asm volatile("" ::: "memory"); }
    }
};
#undef EPI_ROWLOOP
}

namespace att {
constexpr int NW = 8, QBLK = 32, KVBLK = 64, QB = NW * QBLK, D = 128;
constexpr int PQN = 2048, PQR = 512, PKV = 1024, PKR = 64;
constexpr int SHM_V = KVBLK * D * 2, SHM_K = KVBLK * D * 2, KR_ROWB = 144, SHM_KR = KVBLK * KR_ROWB;
constexpr int OFF_K = 2 * SHM_V, OFF_KR = 2 * SHM_V + 2 * SHM_K, OFF_WS = OFF_KR + 2 * SHM_KR;
constexpr int OFF_QRL = OFF_WS + NW * 64 * 4;
constexpr int NQREG = 4;
constexpr int QRL_WAVE = (12 - NQREG) * 1024;
constexpr int LDS_BYTES = OFF_QRL + NW * QRL_WAVE;
constexpr float SCALE = ATTN_SCALE;
constexpr float THR = 8.f;
#define KSWZ(row, colB) ((row) * 256 + ((colB) ^ (((row) & 7) << 4)))
#define SBAR() __builtin_amdgcn_sched_barrier(0)
__device__ __forceinline__ int v_st(int k, int c) { const int kk = (k & ~0xC) | ((k & 4) << 1) | ((k & 8) >> 1); return ((kk >> 3) * 4 + (c >> 5)) * 512 + ((kk & 7) * 32 + (c & 31)) * 2; }
__device__ __forceinline__ int v_rd_base(int lane) { return ((lane & 3) << 3) | (((lane >> 2) & 3) << 6) | (((lane >> 4) & 1) << 5) | (((lane >> 5) & 1) << 8); }
constexpr int v_rd_off(int d0, int ks, int half) { return d0 * 512 + ks * 4096 + half * 2048; }
__device__ __forceinline__ int crow(int r, int hi) { return (r & 3) + 8 * (r >> 2) + 4 * hi; }
__device__ __forceinline__ unsigned cvtpk(float lo, float hi) { unsigned r; asm volatile("v_cvt_pk_bf16_f32 %0, %1, %2" : "=v"(r) : "v"(lo), "v"(hi)); return r; }
__device__ __forceinline__ bf16x8 load8(const bf16* p) { return *reinterpret_cast<const bf16x8*>(p); }
__device__ __forceinline__ void mask_tile(f32x16& p0, f32x16& p1, int dq) {
    const float NEG = -__builtin_inff();
#pragma unroll
    for (int r = 0; r < 16; ++r) {
        const int c = (r & 3) + 8 * (r >> 2);
        if (dq - c < 0) p0[r] = NEG;
        if (dq - c - 32 < 0) p1[r] = NEG;
    }
}
__device__ __forceinline__ void partialSM(f32x16& p0, f32x16& p1, float& m_reg, float& mn, float& alpha) {
    float pmax = p0[0]; for (int r = 1; r < 16; ++r) pmax = fmaxf(pmax, p0[r]); for (int r = 0; r < 16; ++r) pmax = fmaxf(pmax, p1[r]);
    { auto rr = __builtin_amdgcn_permlane32_swap(__float_as_uint(pmax), __float_as_uint(pmax), false, false);
      pmax = fmaxf(__uint_as_float(rr[0]), __uint_as_float(rr[1])); }
    constexpr float C2 = 1.4426950408889634f * SCALE;
    if (__builtin_expect(__all((pmax - m_reg) * SCALE <= THR), 1)) { mn = m_reg; alpha = 1.f; }
    else { mn = fmaxf(m_reg, pmax); alpha = __builtin_amdgcn_exp2f((m_reg - mn) * C2); m_reg = mn; }
    const float mnL = -mn * C2;
    for (int r = 0; r < 16; ++r) p0[r] = fmaf(p0[r], C2, mnL); for (int r = 0; r < 16; ++r) p1[r] = fmaf(p1[r], C2, mnL);
    for (int r = 0; r < 16; ++r) p0[r] = __builtin_amdgcn_exp2f(p0[r]);
}
__device__ __forceinline__ void finishSM(f32x16& p0, f32x16& p1, float alpha, float& l_reg, bf16x8& pa0, bf16x8& pa1, bf16x8& pa2, bf16x8& pa3) {
    for (int r = 0; r < 16; ++r) p1[r] = __builtin_amdgcn_exp2f(p1[r]);
    float ps = 0; for (int r = 0; r < 16; ++r) ps += p0[r]; for (int r = 0; r < 16; ++r) ps += p1[r];
    { auto rr = __builtin_amdgcn_permlane32_swap(__float_as_uint(ps), __float_as_uint(ps), false, false);
      ps = __uint_as_float(rr[0]) + __uint_as_float(rr[1]); }
    l_reg = l_reg * alpha + ps;
#define PK4(P, B_, OUT) do { unsigned a0 = cvtpk(P[B_+0], P[B_+1]), a1 = cvtpk(P[B_+2], P[B_+3]);                          \
        unsigned b0 = cvtpk(P[B_+4], P[B_+5]), b1 = cvtpk(P[B_+6], P[B_+7]);                                             \
        auto r0 = __builtin_amdgcn_permlane32_swap(a0, b0, false, false); auto r1 = __builtin_amdgcn_permlane32_swap(a1, b1, false, false); \
        v4u w = {r0[0], r1[0], r0[1], r1[1]}; OUT = *reinterpret_cast<bf16x8*>(&w); } while (0)
    PK4(p0, 0, pa0); PK4(p0, 8, pa1); PK4(p1, 0, pa2); PK4(p1, 8, pa3);
#undef PK4
}
template <int KB>
__device__ __forceinline__ void qkt(f32x16& p0, f32x16& p1, const char* lds, int r32, int hi, const bf16x8* qr, const char* qrl) {
    p0 = f32x16{}; p1 = f32x16{};
    const char* kb[4];
#pragma unroll
    for (int dd = 0; dd < 4; ++dd) kb[dd] = lds + OFF_K + KB * SHM_K + KSWZ(r32, (dd * 16 + hi * 8) * 2);
#pragma unroll
    for (int d0 = 0; d0 < 8; ++d0) { const char* a = kb[d0 & 3] + (d0 >> 2) * 128;
        bf16x8 b0 = *reinterpret_cast<const bf16x8*>(a);
        bf16x8 b1 = *reinterpret_cast<const bf16x8*>(a + 32 * 256);
        bf16x8 qf; if (d0 < NQREG) qf = qr[d0]; else qf = *reinterpret_cast<const bf16x8*>(qrl + (4 + d0 - NQREG) * 1024);
        p0 = __builtin_amdgcn_mfma_f32_32x32x16_bf16(b0, qf, p0, 0, 0, 0);
        p1 = __builtin_amdgcn_mfma_f32_32x32x16_bf16(b1, qf, p1, 0, 0, 0); }
    const char* kr = lds + OFF_KR + KB * SHM_KR + r32 * KR_ROWB + hi * 16;
#pragma unroll
    for (int d0 = 0; d0 < 4; ++d0) {
        bf16x8 b0 = *reinterpret_cast<const bf16x8*>(kr + d0 * 32);
        bf16x8 b1 = *reinterpret_cast<const bf16x8*>(kr + d0 * 32 + 32 * KR_ROWB);
        const bf16x8 qf = *reinterpret_cast<const bf16x8*>(qrl + d0 * 1024);
        p0 = __builtin_amdgcn_mfma_f32_32x32x16_bf16(b0, qf, p0, 0, 0, 0);
        p1 = __builtin_amdgcn_mfma_f32_32x32x16_bf16(b1, qf, p1, 0, 0, 0); }
}
template <int VB>
__device__ __forceinline__ void pv_tile(f32x16* o, int vb0, bf16x8 pa0, bf16x8 pa1, bf16x8 pa2, bf16x8 pa3) {
#define TRRD(dst, off) asm volatile("ds_read_b64_tr_b16 %0, %1 offset:%2" : "=&v"(dst) : "v"(vb0), "i"(off) : "memory")
#define PV_D0(d0) do { s16x4 l0, l1, l2, l3, h0, h1, h2, h3; constexpr int b_ = VB * SHM_V + v_rd_off(d0, 0, 0); \
        TRRD(l0, b_); TRRD(h0, b_ + 2048); TRRD(l1, b_ + 4096); TRRD(h1, b_ + 6144); TRRD(l2, b_ + 8192); TRRD(h2, b_ + 10240); TRRD(l3, b_ + 12288); TRRD(h3, b_ + 14336); \
        asm volatile("s_waitcnt lgkmcnt(0)" ::: "memory"); SBAR();   \
        o[d0] = __builtin_amdgcn_mfma_f32_32x32x16_bf16(pa0, (bf16x8){l0[0], l0[1], l0[2], l0[3], h0[0], h0[1], h0[2], h0[3]}, o[d0], 0, 0, 0);   \
        o[d0] = __builtin_amdgcn_mfma_f32_32x32x16_bf16(pa1, (bf16x8){l1[0], l1[1], l1[2], l1[3], h1[0], h1[1], h1[2], h1[3]}, o[d0], 0, 0, 0);   \
        o[d0] = __builtin_amdgcn_mfma_f32_32x32x16_bf16(pa2, (bf16x8){l2[0], l2[1], l2[2], l2[3], h2[0], h2[1], h2[2], h2[3]}, o[d0], 0, 0, 0);   \
        o[d0] = __builtin_amdgcn_mfma_f32_32x32x16_bf16(pa3, (bf16x8){l3[0], l3[1], l3[2], l3[3], h3[0], h3[1], h3[2], h3[3]}, o[d0], 0, 0, 0); } while (0)
    PV_D0(0); PV_D0(1); PV_D0(2); PV_D0(3);
#undef PV_D0
#undef TRRD
}
struct BlockRef { const bf16* Q; const bf16* QR; const bf16* K; const bf16* V; const bf16* KR; bf16* O; int P0; };
struct Seam { bf16x8 qr[NQREG]; bf16x8 st_v0, st_v1, st_k0, st_k1, st_kr; };
#define ROWKV(p, k0, rr) ((p) + (size_t)((k0) + (rr)) * PKV + sc)
#define VMW() asm volatile("s_waitcnt vmcnt(0)" ::: "memory")
#define VMWN(n) asm volatile("s_waitcnt vmcnt(%0)" :: "i"(n) : "memory")
#define SLOAD_H(Kp, Vp, KRp, k0) do { S.st_v0 = load8(ROWKV(Vp, k0, sr)); S.st_v1 = load8(ROWKV(Vp, k0, 32 + sr));              \
                         S.st_k0 = load8(ROWKV(Kp, k0, sr)); S.st_k1 = load8(ROWKV(Kp, k0, 32 + sr)); S.st_kr = load8((KRp) + (size_t)((k0) + krr) * PKR + krc); } while (0)
#define SWRITE_HK(bf) do { *(bf16x8*)(K_lds + (bf) * SHM_K + kws) = S.st_k0; *(bf16x8*)(K_lds + (bf) * SHM_K + kws + 32 * 256) = S.st_k1; *(bf16x8*)(KR_lds + (bf) * SHM_KR + krws) = S.st_kr; } while (0)
#define SWRITE_HV(bf) do { *(bf16x8*)(V_lds + (bf) * SHM_V + vst0) = S.st_v0; *(bf16x8*)(V_lds + (bf) * SHM_V + vst1) = S.st_v1; } while (0)
#define SWRITE_H(bf) do { SWRITE_HV(bf); SWRITE_HK(bf); } while (0)
#define QLOAD(R) do { _Pragma("unroll") for (int d0 = 0; d0 < NQREG; ++d0) S.qr[d0] = load8((R).Q + (size_t)(wid * QBLK + r32) * PQN + d0 * 16 + hi * 8); } while (0)
#define QRLOAD(R) do { _Pragma("unroll") for (int d0 = 0; d0 < 4; ++d0) *(bf16x8*)(qrl + d0 * 1024) = load8((R).QR + (size_t)(wid * QBLK + r32) * PQR + d0 * 16 + hi * 8); \
                       _Pragma("unroll") for (int d0 = NQREG; d0 < 8; ++d0) *(bf16x8*)(qrl + (4 + d0 - NQREG) * 1024) = load8((R).Q + (size_t)(wid * QBLK + r32) * PQN + d0 * 16 + hi * 8); } while (0)
__device__ __forceinline__ void attn_prime(const BlockRef& cur, char* lds, Seam& S) {
    int tid_ = threadIdx.x; asm volatile("" : "+v"(tid_));
    const int tid = tid_, wid = __builtin_amdgcn_readfirstlane(tid >> 6), lane = tid & 63, r32 = lane & 31, hi = lane >> 5;
    const int sr = tid >> 4, sc = (tid & 15) * 8, kws = KSWZ(sr, sc * 2); char* K_lds = lds + OFF_K; char* KR_lds = lds + OFF_KR;
    const int krr = tid >> 3, krc = (tid & 7) * 8, krws = krr * KR_ROWB + krc * 2;
    char* qrl = lds + OFF_QRL + wid * QRL_WAVE + lane * 16;
    QLOAD(cur); QRLOAD(cur);
    SLOAD_H(cur.K, cur.V, cur.KR, 0); VMW(); SWRITE_HK(0);
    __syncthreads();
}
__device__ __forceinline__ void attn_block(const BlockRef& cur, const BlockRef& nxt, char* lds, Seam& S) {
    int tid_ = threadIdx.x; asm volatile("" : "+v"(tid_));
    const int tid = tid_, wid = __builtin_amdgcn_readfirstlane(tid >> 6), lane = tid & 63, r32 = lane & 31, hi = lane >> 5;
    const int NT = (cur.P0 + QB) / KVBLK;
    const int qlo = cur.P0 + wid * QBLK, qm = qlo + r32 - 4 * hi;
    char* V_lds = lds; char* K_lds = lds + OFF_K; char* KR_lds = lds + OFF_KR;
    float* ws = (float*)(lds + OFF_WS) + wid * 64; float* li_l = ws, * al_l = ws + 32;
    float m_reg = -1e30f, l_reg = 0; f32x16 o[4] = {};
    const int sr = tid >> 4, sc = (tid & 15) * 8, vst0 = v_st(sr, sc), vst1 = v_st(32 + sr, sc), kws = KSWZ(sr, sc * 2);
    const int krr = tid >> 3, krc = (tid & 7) * 8, krws = krr * KR_ROWB + krc * 2;
    const int vb0 = (int)(uintptr_t)V_lds + v_rd_base(lane);
    char* qrl = lds + OFF_QRL + wid * QRL_WAVE + lane * 16;
    const bf16* Kh = cur.K; const bf16* Vh = cur.V; const bf16* KRh = cur.KR;
#define RESC(a) do { if (__any((a) < 1.f)) { if (hi == 0) al_l[r32] = (a); asm volatile("s_waitcnt lgkmcnt(0)" ::: "memory");              \
                     for (int d_ = 0; d_ < 4; ++d_) for (int r = 0; r < 16; ++r) o[d_][r] *= al_l[crow(r, hi)]; } } while (0)
#define KBASE(t) ((t) * KVBLK)
#define MASKT(P0_, P1_, t) do { const int kb_ = KBASE(t); if (kb_ + KVBLK - 1 > qlo) mask_tile(P0_, P1_, qm - kb_); } while (0)
    constexpr int NQL = NQREG;
#define SEAM_K0() do { VMWN(NQL); SWRITE_HK(0); SBAR(); } while (0)
    f32x16 pA0, pA1, pB0, pB1; float mnA, mnB, alA, alB; bf16x8 pa0, pa1, pa2, pa3;
    SWRITE_HV(0); SBAR();
    if (NT > 1) { SLOAD_H(Kh, Vh, KRh, KBASE(1)); }
    SBAR(); qkt<0>(pA0, pA1, lds, r32, hi, S.qr, qrl);
    MASKT(pA0, pA1, 0); partialSM(pA0, pA1, m_reg, mnA, alA);
    if (NT > 1) { VMW(); SWRITE_H(1); }
    __syncthreads();
#define HALF_STEP(PX0, PX1, mnX, alX, PY0, PY1, alY, t, KB, VB, SB) do {                                                      \
        SBAR(); qkt<KB>(PX0, PX1, lds, r32, hi, S.qr, qrl);                                             \
        finishSM(PY0, PY1, alY, l_reg, pa0, pa1, pa2, pa3); SBAR();                                                           \
        if ((t) + 1 < NT) { SLOAD_H(Kh, Vh, KRh, KBASE((t) + 1)); SBAR(); }                                               \
        pv_tile<VB>(o, vb0, pa0, pa1, pa2, pa3); MASKT(PX0, PX1, (t)); partialSM(PX0, PX1, m_reg, mnX, alX);                                        \
        __syncthreads();                                                                                                      \
        if ((t) + 1 < NT) { VMW(); SWRITE_H(SB); }                                                                          \
        RESC(alX); __syncthreads(); } while (0)
    for (int t = 1; t + 1 < NT; t += 2) {
        HALF_STEP(pB0, pB1, mnB, alB, pA0, pA1, alA, t, 1, 0, 0);
        HALF_STEP(pA0, pA1, mnA, alA, pB0, pB1, alB, t + 1, 0, 1, 1);
    }
    const bool even = (NT & 1) == 0;
    if (even) { SBAR(); qkt<1>(pB0, pB1, lds, r32, hi, S.qr, qrl); SBAR(); }
    SLOAD_H(nxt.K, nxt.V, nxt.KR, 0); SBAR();
    QLOAD(nxt);
    SBAR();
    finishSM(pA0, pA1, alA, l_reg, pa0, pa1, pa2, pa3); SBAR();
    pv_tile<0>(o, vb0, pa0, pa1, pa2, pa3);
    if (even) { MASKT(pB0, pB1, NT - 1); partialSM(pB0, pB1, m_reg, mnB, alB); __syncthreads(); RESC(alB);
        finishSM(pB0, pB1, alB, l_reg, pa0, pa1, pa2, pa3); SBAR(); pv_tile<1>(o, vb0, pa0, pa1, pa2, pa3); }
    SBAR(); SEAM_K0();
    if (hi == 0) li_l[r32] = l_reg; asm volatile("s_waitcnt lgkmcnt(0)" ::: "memory");
    float rli[16];
#pragma unroll
    for (int r = 0; r < 16; ++r) rli[r] = __builtin_amdgcn_rcpf(li_l[crow(r, hi)]);
    int hio = hi; asm volatile("" : "+v"(hio));
    bf16* Ow = cur.O + (size_t)(wid * QBLK + 4 * hio) * PQN + r32;
#pragma unroll
    for (int r = 0; r < 16; ++r) { const int orow = (r & 3) + 8 * (r >> 2);
#pragma unroll
        for (int d0 = 0; d0 < 4; ++d0) { const float v = o[d0][r] * rli[r];
            const float vn = __shfl_xor(v, 1);
            if ((r32 & 1) == 0) *(unsigned*)(Ow + (size_t)orow * PQN + d0 * 32) = cvtpk(v, vn); }
        if ((r & 3) == 3) asm volatile("" ::: "memory"); }
    QRLOAD(nxt);
    __syncthreads();
#undef RESC
#undef KBASE
#undef MASKT
#undef SEAM_K0
#undef HALF_STEP
}
#undef ROWKV
#undef VMW
#undef VMWN
#undef SLOAD_H
#undef SWRITE_HK
#undef SWRITE_HV
#undef SWRITE_H
#undef QLOAD
#undef QRLOAD
#undef KSWZ
#undef SBAR
__device__ __forceinline__ BlockRef block_ref(int L, int pass, int hh, const bf16* QN, const bf16* QR, const bf16* KN, const bf16* V, const bf16* KR, bf16* O) {
    const int x = L & 7, k = L >> 3, bh = x * 4 + (k >> 3), y = k & 7, b = bh >> 3, h8 = bh & 7, qb = pass ? 15 - y : y;
    const size_t row0 = (size_t)b * SEQ + (size_t)qb * QB, rowb = (size_t)b * SEQ;
    BlockRef r;
    r.Q = QN + row0 * PQN + (hh * 8 + h8) * DN; r.O = O + row0 * PQN + (hh * 8 + h8) * DN; r.QR = QR + row0 * PQR + h8 * RD;
    r.K = KN + rowb * PKV + h8 * DN; r.V = V + rowb * PKV + h8 * DV; r.KR = KR + rowb * PKR; r.P0 = qb * QB;
    return r;
}
__device__ __forceinline__ void attn_phase(char* lds, int hh, const bf16* QN, const bf16* QR, const bf16* KN, const bf16* V, const bf16* KR, bf16* O, int bid, int G) {
    int L = bid; if (L >= 256) return;
    int pass = 0;
    BlockRef cur = block_ref(L, 0, hh, QN, QR, KN, V, KR, O);
    Seam S;
    attn_prime(cur, lds, S);
    for (;;) {
        const bool more_pass = pass == 0, more_item = L + G < 256, last = !more_pass && !more_item;
        int passn = pass + 1, Ln = L;
        if (!more_pass) { passn = 0; Ln = more_item ? L + G : L; }
        const BlockRef nxt = last ? cur : block_ref(Ln, passn, hh, QN, QR, KN, V, KR, O);
        attn_block(cur, nxt, lds, S);
        if (last) break;
        cur = nxt; pass = passn; L = Ln;
    }
}
}

constexpr int NWAVES = 8;
constexpr int NPH = 20;
constexpr int N_LAUNCHES = MK_N_LAUNCHES;
static_assert(N_LAUNCHES == 1 || N_LAUNCHES == NPH, "MK_N_LAUNCHES is 1 or NPH");
constexpr int CW_BAR = 4096;
constexpr int RING_OFF = 0, RING_BYTES = 155648;
constexpr int LDSCTL_OFF = RING_BYTES, MISC_OFF = LDSCTL_OFF + 320;
constexpr int LDS_BYTES = RING_BYTES + 1024;
static_assert(att::LDS_BYTES <= RING_BYTES, "attention LDS");

#define XB_TMO      128
#define XB_XCNT(j)  (256  + 64 * (j))
#define XB_XSUB(j)  (1280 + 64 * (j))
#define XB_XGEN(j)  (2304 + 64 * (j))
#define XB_TOP      3328
#define XB_TOPGEN   3392
#define XCD_BAR_WORDS 3456
#define XB_SPIN_CAP (1u << 18)
__device__ __forceinline__ unsigned xb_ld(unsigned* p)              { return __hip_atomic_load(p, __ATOMIC_RELAXED, __HIP_MEMORY_SCOPE_AGENT); }
__device__ __forceinline__ unsigned xb_add(unsigned* p, unsigned v) { return __hip_atomic_fetch_add(p, v, __ATOMIC_RELAXED, __HIP_MEMORY_SCOPE_AGENT); }
__device__ __forceinline__ unsigned xb_xcc_id() { return (unsigned)__builtin_amdgcn_s_getreg((3 << 11) | 20) & 0xFu; }
#define XB_SPIN(cond, bar) do { unsigned _sp = 0; while (cond) { __builtin_amdgcn_s_sleep(1); \
    if ((++_sp & 255u) == 0u) { if (xb_ld(&(bar)[XB_TMO])) break; if (_sp > XB_SPIN_CAP) { atomicAdd(&(bar)[XB_TMO], 1u); break; } } } } while (0)
struct XcdBarrier { unsigned* bar; unsigned x; volatile LAS unsigned* st; };
__device__ __forceinline__ XcdBarrier xcd_barrier_post(unsigned* bar, volatile LAS unsigned* st) {
    XcdBarrier b; b.bar = bar; b.x = xb_xcc_id(); b.st = st;
    if (threadIdx.x == 0) (void)xb_add(&bar[XB_XCNT(b.x)], 1u);
    return b;
}
__device__ __forceinline__ void xcd_barrier_complete(unsigned* bar, unsigned x, unsigned& nloc, unsigned& nx) {
    const unsigned G = gridDim.x * gridDim.y * gridDim.z;
    unsigned sum, cnt, mine, sp = 0u;
    for (;;) {
        sum = 0u; cnt = 0u; mine = 0u;
#pragma unroll
        for (unsigned j = 0; j < 16; ++j) { const unsigned c = xb_ld(&bar[XB_XCNT(j)]); sum += c; cnt += (c > 0u) ? 1u : 0u; mine = (j == x) ? c : mine; }
        if (sum == G) break;
        __builtin_amdgcn_s_sleep(1);
        if ((++sp & 255u) == 0u) { if (xb_ld(&bar[XB_TMO])) break; if (sp > XB_SPIN_CAP) { atomicAdd(&bar[XB_TMO], 1u); break; } }
    }
    nloc = mine > 0u ? mine : 1u; nx = cnt > 0u ? cnt : 1u;
}
__device__ __forceinline__ void xcd_barrier(const XcdBarrier& b) {
    asm volatile("s_waitcnt vmcnt(0)" ::: "memory");
    __syncthreads();
    if (threadIdx.x == 0) {
        unsigned* bar = b.bar;
        __builtin_amdgcn_s_waitcnt(0);
        unsigned nloc = b.st[0], nx = b.st[1];
        if (nloc == 0u) { xcd_barrier_complete(bar, b.x, nloc, nx); b.st[0] = nloc; b.st[1] = nx; }
        const unsigned old = xb_add(&bar[XB_XSUB(b.x)], 1u);
        const unsigned gen = old / nloc;
        if (old + 1u == (gen + 1u) * nloc) {
            __builtin_amdgcn_fence(__ATOMIC_RELEASE, "agent");
            asm volatile("s_waitcnt vmcnt(0)" ::: "memory");
            const unsigned og = xb_add(&bar[XB_TOP], 1u);
            const unsigned tg = og / nx;
            if (og + 1u == (tg + 1u) * nx) xb_add(&bar[XB_TOPGEN], 1u);
            else XB_SPIN(xb_ld(&bar[XB_TOPGEN]) == tg, bar);
            __builtin_amdgcn_fence(__ATOMIC_ACQUIRE, "agent");
            xb_add(&bar[XB_XGEN(b.x)], 1u);
            asm volatile("s_waitcnt vmcnt(0)" ::: "memory");
        } else {
            XB_SPIN(xb_ld(&bar[XB_XGEN(b.x)]) == gen, bar);
            __builtin_amdgcn_fence(__ATOMIC_ACQUIRE, "agent");
            asm volatile("s_waitcnt vmcnt(0)" ::: "memory");
        }
    }
    __syncthreads();
}

struct Args { const void* in[19]; float* out; unsigned char* ws; int ph_lo, ph_hi; };
static_assert(sizeof(Args) == 19 * 8 + 8 + 8 + 8, "Args has no padding");

struct Frame { LAS unsigned char* lds; int tid, lane, wave, vcu, G; const Args* ap; };

enum { MAP_ID = 0, MAP_CONV = 1, MAP_MLAIN = 2, MAP_QUP = 3 };
__device__ __forceinline__ int map_row(int mapid, int s) {
    if (mapid == MAP_ID) return s;
    if (mapid == MAP_CONV) { const int kind = s >> 11, j = s & 2047, pn = j >> 6, jl = j & 63;
        const int wchi = (kind == 1 || kind == 2) ? 1 : 0, bj = (kind >= 2) ? 1 : 0;
        return pn * 256 + bj * 128 + (wchi * 2 + (jl >> 5)) * 32 + (jl & 31); }
    if (mapid == MAP_MLAIN) {
        if (s < QL) return 256 + s;
        if (s < QL + KVL) return s - QL;
        if (s < QL + KVL + RD) { const int e = s - (QL + KVL), half = e >> 5, ii = e & 31; return 640 + 32 * (ii >> 4) + 8 * ((ii >> 2) & 3) + 4 * half + (ii & 3); }
        return 768 + (s - (QL + KVL + RD)); }
    { const int h = s / 192, d = s % 192, hh = h >> 3, h8 = h & 7;
        if (d < DN) return hh * 1536 + h8 * DN + d;
        const int e = d - DN, half = e >> 5, ii = e & 31, tr = h8 >> 2, hl = h8 & 3, bj = hl >> 1, wc = (hl & 1) * 2 + (ii >> 4);
        return hh * 1536 + 1024 + tr * 256 + bj * 128 + wc * 32 + 8 * ((ii >> 2) & 3) + 4 * half + (ii & 3); }
}
__device__ __forceinline__ void prep_item(const float* W, int Nsrc, const float* gk, bf16* WT, int ldd, int mapid, LAS float* scr, int item, int lane) {
    const int nblk = Nsrc / 32, kb = item / nblk, nb = item % nblk, k0 = 64 * kb, n0 = 32 * nb;
#pragma unroll 8
    for (int i = 0; i < 32; ++i) { const int kk = 2 * i + (lane >> 5); float v = W[(size_t)(k0 + kk) * Nsrc + n0 + (lane & 31)]; if (gk) v *= gk[k0 + kk]; scr[kk * 33 + (lane & 31)] = v; }
    LDS_WAIT(); asm volatile("" ::: "memory");
    const int c = lane & 7;
#pragma unroll
    for (int j = 0; j < 4; ++j) { const int n = (lane >> 3) + 8 * j; const LAS float* s = scr + (8 * c) * 33 + n;
        v4u o; o.x = cvt_pk_bf16(s[0 * 33], s[1 * 33]); o.y = cvt_pk_bf16(s[2 * 33], s[3 * 33]); o.z = cvt_pk_bf16(s[4 * 33], s[5 * 33]); o.w = cvt_pk_bf16(s[6 * 33], s[7 * 33]);
        *(GAS v4u*)(WT + (size_t)map_row(mapid, n0 + n) * ldd + k0 + 8 * c) = o; }
    LDS_WAIT(); asm volatile("" ::: "memory");
}
#define INP(i) ((const float*)F.ap->in[i])
__device__ __forceinline__ void p0_prologue(Frame& F) {
    unsigned char* ws = F.ap->ws;
    LAS float* scr = (LAS float*)(F.lds + RING_OFF + F.wave * 16384);
    const int gw = F.vcu * NWAVES + F.wave, NGW = F.G * NWAVES;
    constexpr int I_PIN = 16 * 128, I_PGRP = 8 * 16, I_POUT = 32 * 32, I_CIN = 16 * 256, I_COUT = 32 * 32, I_MIN = 16 * 86, I_QUP = 6 * 96, I_KVUP = 4 * 128, I_MOUT = 32 * 32;
    constexpr int I_POOL = I_PIN + 4 * I_PGRP + I_POUT;
    constexpr int NITEMS = 2 * I_POOL + I_CIN + I_COUT + I_MIN + I_QUP + I_KVUP + I_MOUT;
    for (int it = gw; it < NITEMS; it += NGW) {
        int r = it;
        if (r < 2 * I_POOL) { const int j = r / I_POOL; r -= j * I_POOL; unsigned char* wb = ws + (j ? WS_WPOOL1 : WS_WPOOL0);
            if (r < I_PIN) { prep_item(INP(3) + (size_t)j * DM * 4096, 4096, INP(2) + j * DM, (bf16*)(wb + WPOOL_IN), DM, MAP_ID, scr, r, F.lane); continue; } r -= I_PIN;
            if (r < 4 * I_PGRP) { const int g = r / I_PGRP; r -= g * I_PGRP;
                prep_item(INP(4) + ((size_t)j * 4 + g) * 512 * 512, 512, nullptr, (bf16*)(wb + WPOOL_GRP) + (size_t)g * 512 * 512, 512, MAP_ID, scr, r, F.lane); continue; } r -= 4 * I_PGRP;
            prep_item(INP(6) + (size_t)j * EI * DM, DM, nullptr, (bf16*)(wb + WPOOL_OUT), EI, MAP_ID, scr, r, F.lane); continue; }
        r -= 2 * I_POOL;
        if (r < I_CIN) { prep_item(INP(8), 8192, INP(7), (bf16*)(ws + WS_WCONV_IN), DM, MAP_CONV, scr, r, F.lane); continue; } r -= I_CIN;
        if (r < I_COUT) { prep_item(INP(10), DM, nullptr, (bf16*)(ws + WS_WCONV_OUT), EI, MAP_ID, scr, r, F.lane); continue; } r -= I_COUT;
        if (r < I_MIN) { prep_item(INP(12), MLA_IN, INP(11), (bf16*)(ws + WS_WMLA_B1), DM, MAP_MLAIN, scr, r, F.lane); continue; } r -= I_MIN;
        if (r < I_QUP) { prep_item(INP(14), 3072, INP(13), (bf16*)(ws + WS_WMLA_QUP), QL, MAP_QUP, scr, r, F.lane); continue; } r -= I_QUP;
        if (r < I_KVUP) { prep_item(INP(16), 4096, INP(15), (bf16*)(ws + WS_WMLA_KVUP), KVL, MAP_ID, scr, r, F.lane); continue; } r -= I_KVUP;
        prep_item(INP(17), DM, nullptr, (bf16*)(ws + WS_WMLA_OUT), EI, MAP_ID, scr, r, F.lane);
    }
    for (int i = gw * 64 + F.lane; i < 64 * 128; i += NGW * 64) *(GAS v4u*)((bf16*)(ws + WS_WMLA_B1) + (size_t)704 * DM + (size_t)i * 8) = (v4u){0u, 0u, 0u, 0u};
    { const float* x = INP(0); bf16* XB = (bf16*)(ws + WS_XB); float* SSQ = (float*)(ws + WS_SSQ);
      for (int m = gw; m < M; m += NGW) { const GAS f32x4* xr = (const GAS f32x4*)(x + (size_t)m * DM) + F.lane; f32x4 v[4]; float s = 0.f;
#pragma unroll
          for (int j = 0; j < 4; ++j) { v[j] = xr[64 * j]; s += (v[j].x * v[j].x + v[j].y * v[j].y) + (v[j].z * v[j].z + v[j].w * v[j].w); }
          s = wave_sum(s);
          GAS v2u* o8 = (GAS v2u*)(XB + (size_t)m * DM) + F.lane;
#pragma unroll
          for (int j = 0; j < 4; ++j) o8[64 * j] = (v2u){cvt_pk_bf16(v[j].x, v[j].y), cvt_pk_bf16(v[j].z, v[j].w)};
          if (F.lane < 16) SSQ[(size_t)m * 16 + F.lane] = F.lane == 0 ? s : 0.f; } }
    { const int* pos = (const int*)F.ap->in[1]; float* COS = (float*)(ws + WS_COS); float* SIN = (float*)(ws + WS_SIN);
      for (int e = F.vcu * (NWAVES * 64) + F.tid; e < M * 32; e += F.G * NWAVES * 64) { const int row = e >> 5, i = e & 31;
          const float invf = powf(ROPE_BASE, -(float)(2 * i) / (float)RD); const float ang = (float)pos[row] * invf;
          const double a = (double)ang; const double n = __builtin_rint(a * 0.15915494309189535); const float r = (float)__builtin_fma(n, -6.283185307179586, a);
          COS[e] = cosf(r); SIN[e] = sinf(r); } }
}

template <int W>
__device__ __forceinline__ void pool_rows(const v2u (&v)[31], int t0, bf16* out_base) {
    float s[4];
#pragma unroll
    for (int c = 0; c < 4; ++c) s[c] = 0.f;
#pragma unroll
    for (int j = 0; j < W; ++j) { const v2u w = v[15 - j]; s[0] += bflo(w.x); s[1] += bfhi(w.x); s[2] += bflo(w.y); s[3] += bfhi(w.y); }
#pragma unroll
    for (int i = 0; i < 16; ++i) {
        const int t = t0 + i; const float inv = __builtin_amdgcn_rcpf((float)(t + 1 < W ? t + 1 : W));
        const v2u cu = v[15 + i];
        const float o0 = s[0] * inv - bflo(cu.x), o1 = s[1] * inv - bfhi(cu.x), o2 = s[2] * inv - bflo(cu.y), o3 = s[3] * inv - bfhi(cu.y);
        *(GAS v2u*)(out_base + (size_t)i * EI) = (v2u){cvt_pk_bf16(o0, o1), cvt_pk_bf16(o2, o3)};
        if (i < 15) { const v2u a = v[16 + i], d = v[16 + i - W];
            s[0] += bflo(a.x) - bflo(d.x); s[1] += bfhi(a.x) - bfhi(d.x); s[2] += bflo(a.y) - bflo(d.y); s[3] += bfhi(a.y) - bfhi(d.y); }
    }
}
__device__ __forceinline__ void pool_mix_phase(Frame& F, bf16* U, const bf16* HALO) {
    const int cb = F.tid & 31, rb = F.tid >> 5;
    for (int unit = F.vcu; unit < 64 * 16; unit += F.G) {
        const int pm = unit >> 4, cs = unit & 15, col = cs * 128 + cb * 4, g = cs >> 2;
        const int r0 = pm * 256 + rb * 16, t0 = r0 & (SEQ - 1);
        v2u v[31];
#pragma unroll
        for (int i = 0; i < 31; ++i) { const int dr = i - 15;
            if (dr >= 0 || rb > 0) v[i] = *(const GAS v2u*)(U + (size_t)(r0 + dr) * EI + col);
            else if ((pm & 15) == 0) v[i] = (v2u){0u, 0u};
            else v[i] = *(const GAS v2u*)(HALO + ((size_t)(pm - 1) * 16 + (16 + dr)) * EI + col); }
        VM_WAIT(); __syncthreads();
        bf16* ob = U + (size_t)r0 * EI + col;
        if (g == 0) pool_rows<2>(v, t0, ob); else if (g == 1) pool_rows<4>(v, t0, ob); else if (g == 2) pool_rows<8>(v, t0, ob); else pool_rows<16>(v, t0, ob);
    }
}
__device__ __forceinline__ void conv_mix_phase(Frame& F, const bf16* CH, bf16* BZ, const float* cw) {
    const int cb = F.tid & 31, rb = F.tid >> 5;
    for (int unit = F.vcu; unit < 64 * 8; unit += F.G) {
        const int pm = unit >> 3, cs = unit & 7, col = cs * 256 + cb * 8;
        const int r0 = pm * 256 + rb * 16, t0 = r0 & (SEQ - 1);
        float w[3][8];
#pragma unroll
        for (int j = 0; j < 3; ++j) { const f32x4 a = *(const GAS f32x4*)(cw + j * EI + col), b = *(const GAS f32x4*)(cw + j * EI + col + 4);
            w[j][0] = a[0]; w[j][1] = a[1]; w[j][2] = a[2]; w[j][3] = a[3]; w[j][4] = b[0]; w[j][5] = b[1]; w[j][6] = b[2]; w[j][7] = b[3]; }
        v4u c[18];
#pragma unroll
        for (int i = 0; i < 18; ++i) { const int dr = i - 2; if (t0 + dr >= 0) c[i] = *(const GAS v4u*)(CH + (size_t)(r0 + dr) * EI + col); else c[i] = (v4u){0u, 0u, 0u, 0u}; }
#pragma unroll
        for (int i = 0; i < 16; ++i) { bf16* p = BZ + (size_t)(r0 + i) * EI + col; const v4u z = *(const GAS v4u*)p; const v4u x0 = c[i], x1 = c[i + 1], x2 = c[i + 2];
            float o[8];
#define CV(k, X0, X1, X2, Z) o[k] = (Z) * (w[0][k] * (X0) + w[1][k] * (X1) + w[2][k] * (X2))
            CV(0, bflo(x0.x), bflo(x1.x), bflo(x2.x), bflo(z.x)); CV(1, bfhi(x0.x), bfhi(x1.x), bfhi(x2.x), bfhi(z.x));
            CV(2, bflo(x0.y), bflo(x1.y), bflo(x2.y), bflo(z.y)); CV(3, bfhi(x0.y), bfhi(x1.y), bfhi(x2.y), bfhi(z.y));
            CV(4, bflo(x0.z), bflo(x1.z), bflo(x2.z), bflo(z.z)); CV(5, bfhi(x0.z), bfhi(x1.z), bfhi(x2.z), bfhi(z.z));
            CV(6, bflo(x0.w), bflo(x1.w), bflo(x2.w), bflo(z.w)); CV(7, bfhi(x0.w), bfhi(x1.w), bfhi(x2.w), bfhi(z.w));
#undef CV
            *(GAS v4u*)p = (v4u){cvt_pk_bf16(o[0], o[1]), cvt_pk_bf16(o[2], o[3]), cvt_pk_bf16(o[4], o[5]), cvt_pk_bf16(o[6], o[7])}; }
    }
}
__device__ __forceinline__ void final_norm_phase(Frame& F, float* X, const float* gain) {
    const int gw = F.vcu * NWAVES + F.wave, NGW = F.G * NWAVES;
    f32x4 gv[4];
#pragma unroll
    for (int j = 0; j < 4; ++j) gv[j] = *((const GAS f32x4*)gain + F.lane + 64 * j);
    for (int m = gw; m < M; m += NGW) { GAS f32x4* xr = (GAS f32x4*)(X + (size_t)m * DM) + F.lane; f32x4 v[4]; float s = 0.f;
#pragma unroll
        for (int j = 0; j < 4; ++j) { v[j] = xr[64 * j]; s += (v[j].x * v[j].x + v[j].y * v[j].y) + (v[j].z * v[j].z + v[j].w * v[j].w); }
        const float rs = 1.0f / sqrtf(wave_sum(s) * (1.0f / DM) + NORM_EPS);
#pragma unroll
        for (int j = 0; j < 4; ++j) xr[64 * j] = v[j] * rs * gv[j]; }
}

__device__ __forceinline__ void run_phase(Frame& F, int ph) {
    { int t_ = threadIdx.x; asm volatile("" : "+v"(t_)); F.tid = t_; F.lane = t_ & 63; F.wave = __builtin_amdgcn_readfirstlane(t_ >> 6); }
    unsigned char* ws = F.ap->ws; const int bid = (int)blockIdx.x;
    bf16* XB = (bf16*)(ws + WS_XB); bf16* A1 = (bf16*)(ws + WS_A1); bf16* A2 = (bf16*)(ws + WS_A2);
    float* SSQ = (float*)(ws + WS_SSQ); float* X = F.ap->out;
    const float* COS = (const float*)(ws + WS_COS); const float* SIN = (const float*)(ws + WS_SIN);
    LAS unsigned char* ring = F.lds + RING_OFF;
#ifndef MK_PHMASK
#define MK_PHMASK 0xFFFFF
#endif
#define PH_EN(k) ((MK_PHMASK >> (k)) & 1)
    if (PH_EN(0) && ph == 0) { p0_prologue(F); return; }
    if (PH_EN(19) && ph == 19) { final_norm_phase(F, X, INP(18)); return; }
    const bool pool = (ph >= 1 && ph <= 4) || (ph >= 15 && ph <= 18);
    const int j = ph >= 15 ? 1 : 0, pp = pool ? (ph >= 15 ? ph - 15 : ph - 1) : -1;
    unsigned char* wpool = ws + (j ? WS_WPOOL1 : WS_WPOOL0);
    if (PH_EN(1) && pool && pp == 0) {
        pg8::Gemm g{XB, (const bf16*)(wpool + WPOOL_IN), DM, DM, DM, 0, 0}; pg8::StaticOrder S; S.init(M, 4096, F.G, bid);
        epi::EpiPoolIn E{A1, A2, (bf16*)(ws + WS_HALO), SSQ};
        pg8::gemm_phase<epi::EpiPoolIn, pg8::StaticOrder, true>(ring, g, S, E); return; }
    if (PH_EN(2) && pool && pp == 1) { pool_mix_phase(F, A1, (const bf16*)(ws + WS_HALO)); return; }
    if (PH_EN(3) && pool && pp == 2) {
        pg8::Gemm g{A1, (const bf16*)(wpool + WPOOL_GRP), EI, 512, 512, 2, 512}; pg8::StaticOrder S; S.init(M, EI, F.G, bid);
        epi::EpiPoolGrp E{A2, INP(5) + j * EI};
        pg8::gemm_phase<epi::EpiPoolGrp, pg8::StaticOrder, true>(ring, g, S, E); return; }
    if (PH_EN(4) && ((pool && pp == 3) || ph == 7 || ph == 14)) {
        const bf16* Y = ph == 14 ? A1 : A2;
        const bf16* Wt = pool ? (const bf16*)(wpool + WPOOL_OUT) : ph == 7 ? (const bf16*)(ws + WS_WCONV_OUT) : (const bf16*)(ws + WS_WMLA_OUT);
        pg8::Gemm g{Y, Wt, EI, EI, EI, 0, 0}; pg8::StaticOrder S; S.init(M, DM, F.G, bid);
        epi::EpiResid E{ph == 4 ? INP(0) : (const float*)X, X, XB, SSQ};
        pg8::gemm_phase<epi::EpiResid, pg8::StaticOrder, false>(ring, g, S, E); return; }
    if (PH_EN(5) && ph == 5) {
        pg8::Gemm g{XB, (const bf16*)(ws + WS_WCONV_IN), DM, DM, DM, 0, 0}; pg8::StaticOrder S; S.init(M, 8192, F.G, bid);
        epi::EpiConvIn E{A1, A2, SSQ};
        pg8::gemm_phase<epi::EpiConvIn, pg8::StaticOrder, true>(ring, g, S, E); return; }
    if (PH_EN(6) && ph == 6) { conv_mix_phase(F, A1, A2, INP(9)); return; }
    bf16* KVLAT = (bf16*)(ws + WS_KVLAT); bf16* QLAT = (bf16*)(ws + WS_QLAT); bf16* KROPE = (bf16*)(ws + WS_KROPE); bf16* QR = (bf16*)(ws + WS_QR);
    float* SSQQ = (float*)(ws + WS_SSQQ); float* SSQKV = (float*)(ws + WS_SSQKV);
    if (PH_EN(8) && ph == 8) {
        pg8::Gemm g{XB, (const bf16*)(ws + WS_WMLA_B1), DM, DM, DM, 0, 0}; pg8::StaticOrder S; S.init(M, 768, F.G, bid);
        epi::EpiMlaIn E{KVLAT, QLAT, KROPE, SSQKV, SSQQ, SSQ, COS, SIN};
        pg8::gemm_phase<epi::EpiMlaIn, pg8::StaticOrder, false>(ring, g, S, E); return; }
    if (PH_EN(9) && (ph == 9 || ph == 11)) {
        const int hh = ph == 9 ? 0 : 1;
        { pg8::Gemm g{QLAT, (const bf16*)(ws + WS_WMLA_QUP) + (size_t)hh * 1536 * QL, QL, QL, QL, 0, 0}; pg8::StaticOrder S; S.init(M, 1536, F.G, bid);
          epi::EpiQUp E{A1, QR, SSQQ, COS, SIN, hh};
          pg8::gemm_phase<epi::EpiQUp, pg8::StaticOrder, true>(ring, g, S, E); }
        { pg8::Gemm g{KVLAT, (const bf16*)(ws + WS_WMLA_KVUP) + (size_t)hh * 2048 * KVL, KVL, KVL, KVL, 0, 0}; pg8::StaticOrder S; S.init(M, 2048, F.G, F.G - 1 - bid);
          epi::EpiKvUp E{A2, A2 + (size_t)M * 1024, SSQKV};
          pg8::gemm_phase<epi::EpiKvUp, pg8::StaticOrder, true>(ring, g, S, E); }
        return; }
    if (PH_EN(10) && (ph == 10 || ph == 12)) { att::attn_phase((char*)ring, ph == 10 ? 0 : 1, A1, QR, A2, A2 + (size_t)M * 1024, KROPE, A1, bid, F.G); return; }
    if (PH_EN(13) && ph == 13) {
        pg8::Gemm g{XB, (const bf16*)(ws + WS_WMLA_B1) + (size_t)768 * DM, DM, DM, DM, 0, 0}; pg8::StaticOrder S; S.init(M, EI, F.G, bid);
        epi::EpiGate E{A1, SSQ};
        pg8::gemm_phase<epi::EpiGate, pg8::StaticOrder, true>(ring, g, S, E); return; }
}

__global__ void __launch_bounds__(NWAVES * 64, 2) trunk_fwd(Args args) {
    extern __shared__ __attribute__((aligned(16))) unsigned char lds[];
    Frame F;
    F.lds = (LAS unsigned char*)lds; F.ap = &args;
    F.tid = threadIdx.x; F.lane = F.tid & 63; F.wave = __builtin_amdgcn_readfirstlane(F.tid >> 6);
    F.G = gridDim.x; { const int bx = blockIdx.x; F.vcu = (F.G % 8 == 0) ? (bx % 8) * (F.G / 8) + bx / 8 : bx; }
    for (int u = F.tid; u < (LDS_BYTES - LDSCTL_OFF) / 4; u += NWAVES * 64) ((LAS unsigned*)(F.lds + LDSCTL_OFF))[u] = 0u;
    __syncthreads();
    XcdBarrier bar; bar.bar = (unsigned*)(args.ws + WS_CTL) + CW_BAR; bar.x = 0; bar.st = nullptr;
    if (N_LAUNCHES == 1) bar = xcd_barrier_post((unsigned*)(args.ws + WS_CTL) + CW_BAR, (volatile LAS unsigned*)(F.lds + MISC_OFF) + 8);
    const int lo = args.ph_lo, hi = args.ph_hi;
#define PHASE(k) if (lo <= (k) && (k) < hi) { run_phase(F, (k)); if ((k) + 1 < hi) { if (N_LAUNCHES == 1) xcd_barrier(bar); } }
    PHASE(0) PHASE(1) PHASE(2) PHASE(3) PHASE(4) PHASE(5) PHASE(6) PHASE(7) PHASE(8) PHASE(9)
    PHASE(10) PHASE(11) PHASE(12) PHASE(13) PHASE(14) PHASE(15) PHASE(16) PHASE(17) PHASE(18) PHASE(19)
#undef PHASE
}


extern "C" void kernel_launch(void* const* d_in, const int* in_sizes, int n_in, void* d_out, int out_size, void* d_ws, size_t ws_size, hipStream_t stream) {
    static int grid = 0;
    if (grid == 0) {
        if (n_in != 19 || in_sizes[0] != M * DM || out_size != M * DM || ws_size < WS_END) {
            fprintf(stderr, "kernel_launch: built for 19 inputs, x/out of %d floats, >= %zu bytes of workspace; got n_in %d, in0 %d, out %d, ws %zu; nothing launched\n", M * DM, (size_t)WS_END, n_in, n_in > 0 ? in_sizes[0] : -1, out_size, ws_size);
            grid = -1; return; }
        int dev = 0, cus = 0;
        if (hipGetDevice(&dev) != hipSuccess || hipDeviceGetAttribute(&cus, hipDeviceAttributeMultiprocessorCount, dev) != hipSuccess) { fprintf(stderr, "kernel_launch: device query failed\n"); grid = -1; return; }
        if (hipFuncSetAttribute((const void*)trunk_fwd, hipFuncAttributeMaxDynamicSharedMemorySize, LDS_BYTES) != hipSuccess) { fprintf(stderr, "kernel_launch: hipFuncSetAttribute failed\n"); grid = -1; return; }
        int per_cu = 0;
        if (hipOccupancyMaxActiveBlocksPerMultiprocessor(&per_cu, (const void*)trunk_fwd, NWAVES * 64, LDS_BYTES) != hipSuccess || per_cu < 1)
            fprintf(stderr, "kernel_launch: note: occupancy query reports %d workgroups per CU\n", per_cu);
        (void)hipGetLastError();
        grid = cus;
    }
    if (grid < 0) return;
    if (hipMemsetAsync((char*)d_ws + WS_CTL, 0, CTL_ZERO_BYTES, stream) != hipSuccess) { fprintf(stderr, "kernel_launch: hipMemsetAsync failed\n"); return; }
    Args a{};
    for (int i = 0; i < 19; ++i) a.in[i] = d_in[i];
    a.out = (float*)d_out; a.ws = (unsigned char*)d_ws;
#if MK_DEBUG
    dbg_launch_all(a, grid, stream);
#else
    for (int li = 0; li < N_LAUNCHES; ++li) {
        a.ph_lo = (N_LAUNCHES == NPH) ? li : 0; a.ph_hi = (N_LAUNCHES == NPH) ? li + 1 : NPH;
        hipLaunchKernelGGL(trunk_fwd, dim3(grid), dim3(NWAVES * 64), LDS_BYTES, stream, a);
        const hipError_t le = hipPeekAtLastError();
        if (le != hipSuccess) { fprintf(stderr, "kernel_launch: launch %d failed: %s\n", li, hipGetErrorName(le)); break; }
    }
#endif
}
```

```cpp
#include <hip/hip_runtime.h>
#include <cstdio>
#include <cstdint>

#ifndef MK_N_LAUNCHES
#define MK_N_LAUNCHES 1
#endif
#ifndef MK_DEBUG
#define MK_DEBUG 0
#endif

constexpr int NB = 4, SEQ = 4096, DM = 1024, M = NB * SEQ, EI = 2048;
constexpr int QL = 384, KVL = 256, RD = 64, NHEAD = 16, DN = 128, DV = 128;
constexpr int MLA_IN = QL + KVL + RD + EI;
constexpr float NORM_EPS = 1e-6f;
constexpr float ATTN_SCALE = 0.07216878364870322f;
constexpr float ROPE_BASE = 10000.0f;

constexpr size_t MiB = 1u << 20;
constexpr size_t WS_CTL = 0, CTL_ZERO_BYTES = 1 * MiB;
constexpr size_t WS_SSQ = 1 * MiB;
constexpr size_t WS_SSQQ = 2 * MiB;
constexpr size_t WS_SSQKV = 2 * MiB + 512 * 1024;
constexpr size_t WS_DBG = 3 * MiB;
constexpr size_t WS_COS = 4 * MiB, WS_SIN = 6 * MiB;
constexpr size_t WS_HALO = 8 * MiB;
constexpr size_t WS_WCONV_IN = 12 * MiB;
constexpr size_t WS_WCONV_OUT = 28 * MiB;
constexpr size_t WS_WPOOL0 = 32 * MiB, WS_WPOOL1 = 46 * MiB;
constexpr size_t WPOOL_IN = 0, WPOOL_GRP = 8 * MiB, WPOOL_OUT = 10 * MiB;
constexpr size_t WS_WMLA_B1 = 60 * MiB;
constexpr size_t WS_WMLA_BZ = 62 * MiB;
constexpr size_t WS_WMLA_QUP = 66 * MiB;
constexpr size_t WS_WMLA_KVUP = 69 * MiB;
constexpr size_t WS_WMLA_OUT = 71 * MiB;
constexpr size_t WS_XB = 76 * MiB;
constexpr size_t WS_A1 = 108 * MiB;
constexpr size_t WS_A2 = 172 * MiB;
constexpr size_t WS_QLAT = 236 * MiB;
constexpr size_t WS_END = 248 * MiB;
constexpr size_t WS_QR = WS_WCONV_IN;
constexpr size_t WS_KVLAT = WS_WPOOL0;
constexpr size_t WS_KROPE = WS_WPOOL0 + 8 * MiB;

#define GAS __attribute__((address_space(1)))
#define LAS __attribute__((address_space(3)))
typedef unsigned short bf16;
typedef unsigned v4u __attribute__((ext_vector_type(4)));
typedef unsigned v2u __attribute__((ext_vector_type(2)));
typedef float f32x4 __attribute__((ext_vector_type(4)));
typedef float f32x2 __attribute__((ext_vector_type(2)));
typedef float f32x16 __attribute__((ext_vector_type(16)));
typedef short bf16x8 __attribute__((ext_vector_type(8)));
typedef short s16x4 __attribute__((ext_vector_type(4)));
typedef GAS unsigned gu32;
#define RLX_AGENT __ATOMIC_RELAXED, __HIP_MEMORY_SCOPE_AGENT
#define LDS_WAIT() asm volatile("s_waitcnt lgkmcnt(0)" ::: "memory")
#define VM_WAIT() asm volatile("s_waitcnt vmcnt(0)" ::: "memory")

__device__ __forceinline__ unsigned cvt_pk_bf16(float lo, float hi) { unsigned r; asm volatile("v_cvt_pk_bf16_f32 %0, %1, %2" : "=v"(r) : "v"(lo), "v"(hi)); return r; }
__device__ __forceinline__ float bf2f(unsigned short h) { return __uint_as_float((unsigned)h << 16); }
__device__ __forceinline__ float bflo(unsigned w) { return __uint_as_float(w << 16); }
__device__ __forceinline__ float bfhi(unsigned w) { return __uint_as_float(w & 0xffff0000u); }
__device__ __forceinline__ unsigned short f2bf_bits(float f) { return (unsigned short)(cvt_pk_bf16(f, 0.f) & 0xffffu); }
__device__ __forceinline__ v4u pack8(f32x4 a, f32x4 b) { v4u w; w.x = cvt_pk_bf16(a[0], a[1]); w.y = cvt_pk_bf16(a[2], a[3]); w.z = cvt_pk_bf16(b[0], b[1]); w.w = cvt_pk_bf16(b[2], b[3]); return w; }
__device__ __forceinline__ float silu_f(float z) { return z * __builtin_amdgcn_rcpf(1.0f + __builtin_amdgcn_exp2f(-1.4426950408889634f * z)); }
__device__ __forceinline__ f32x4 silu4(f32x4 z) { f32x4 r; r[0] = silu_f(z[0]); r[1] = silu_f(z[1]); r[2] = silu_f(z[2]); r[3] = silu_f(z[3]); return r; }
__device__ __forceinline__ float wave_sum(float v) {
#pragma unroll
    for (int o = 1; o < 64; o <<= 1) v += __shfl_xor(v, o);
    return v;
}
__device__ __forceinline__ float fq_sum(float s) { s += __shfl_xor(s, 16); s += __shfl_xor(s, 32); return s; }

namespace pg8 {
typedef unsigned short bf16_t;
constexpr int BM = 256, BK = 64, HALF = 128, HTB = HALF * BK * 2  , STAGE_BYTES = 8 * HTB, NXCD = 8, WGM = 8;

__host__ __device__ __forceinline__ int lds_byte(int r, int c) { const int st = (r >> 4) * 2 + (c >> 5), rr = r & 15, cc = c & 31, ob = rr * 64 + cc * 2; return st * 1024 + (ob ^ (((ob >> 9) & 1) << 5)); }
__host__ __device__ __forceinline__ void stage_rc(int b, int& R, int& C) { const int st = b / 1024, sb = b % 1024, swz = sb ^ (((sb >> 9) & 1) << 5); R = (st >> 1) * 16 + swz / 64; C = (st & 1) * 32 + (swz % 64) / 2; }
__host__ __device__ __forceinline__ int perm32(int rho) { const int n = rho >> 4, i = rho & 15; return 8 * (i >> 2) + 4 * n + (i & 3); }

struct Unit { int pm, pn; };
struct Gemm { const bf16_t* A; const bf16_t* Bt; int lda, ldb, K, agt, ags; };

struct StaticOrder {
    int nM, nN, nwg, G, c;
    __host__ __device__ void init(int M_, int N_, int G_, int c_) { nM = M_ / BM; nN = N_ / BM; nwg = nM * nN; G = G_; c = c_; }
    __host__ __device__ bool next(int i, Unit& u) const {
        const long L = (long)i * G + c; if (L >= nwg) return false;
        int wgid = (int)L; { const int q = nwg / NXCD, r = nwg % NXCD, xcd = wgid % NXCD, off = wgid / NXCD; wgid = (xcd < r ? xcd * (q + 1) : r * (q + 1) + (xcd - r) * q) + off; }
        const int nig = WGM * nN, gid = wgid / nig, fm = gid * WGM, gsz = (nM - fm) < WGM ? (nM - fm) : WGM;
        u.pm = fm + ((wgid % nig) % gsz); u.pn = (wgid % nig) / gsz; return true;
    }
};

template <class Epi, class Sched, bool ALIGN_EPI = false>
__device__ __forceinline__ void gemm_phase(LAS unsigned char* lds, const Gemm g, const Sched& S, const Epi& E) {
    int tid_ = threadIdx.x; asm volatile("" : "+v"(tid_));
    const int tid = tid_, wid = __builtin_amdgcn_readfirstlane(tid >> 6), lane = tid & 63, wr = wid >> 2, wc = wid & 3, fr = lane & 15, fq = lane >> 4;
    const int K = g.K, nt = K / BK;
    unsigned voffA[2], voffB[2];
#pragma unroll
    for (int i = 0; i < 2; ++i) { int R, C; stage_rc(tid * 16 + i * 8192, R, C); const int Rb = (R & ~31) + perm32(R & 31);
        voffA[i] = (unsigned)(R * g.lda + C) * 2u; voffB[i] = (unsigned)(Rb * g.ldb + C) * 2u; }
    const size_t kstep = (size_t)(BK * 2);
    const size_t hstepA = (size_t)HALF * g.lda * 2, hstepB = (size_t)HALF * g.ldb * 2;
    const unsigned ldsw = (unsigned)wid * 1024u;
    const int aoff = lds_byte(wr * 64 + fr, fq * 8), boff = lds_byte(wc * 32 + fr, fq * 8);
#define PG8_AOF(u) ((const char*)g.A + ((size_t)(u).pm * BM * g.lda + (g.agt ? (size_t)((u).pn / g.agt) * g.ags : (size_t)0)) * 2)
#define PG8_BOF(u) ((const char*)g.Bt + (size_t)(u).pn * BM * g.ldb * 2)
#define PG8_SA(b, h) (((b) * 2 + (h)) * HTB)
#define PG8_SB(b, h) ((4 + (b) * 2 + (h)) * HTB)
#define PG8_STAGE(bufoff, gbase, voff) do { _Pragma("unroll") for (int _i = 0; _i < 2; ++_i) \
        __builtin_amdgcn_global_load_lds((const unsigned*)((const char*)(gbase) + (voff)[_i]), (LAS unsigned*)(lds + (bufoff) + ldsw + _i * 8192), 16, 0, 0); } while (0)
#define PG8_LDA(dst, b, h) do { _Pragma("unroll") for (int m = 0; m < 4; ++m) _Pragma("unroll") for (int k = 0; k < 2; ++k) dst[m][k] = *(const LAS bf16x8*)(lds + PG8_SA(b, h) + aoff + m * 2048 + k * 1024); } while (0)
#define PG8_LDB(dst, b, h) do { _Pragma("unroll") for (int n = 0; n < 2; ++n) _Pragma("unroll") for (int k = 0; k < 2; ++k) dst[n][k] = *(const LAS bf16x8*)(lds + PG8_SB(b, h) + boff + n * 2048 + k * 1024); } while (0)
#define PG8_MMA(ai, bj, At, Bt) do { __builtin_amdgcn_s_setprio(1); _Pragma("unroll") for (int m = 0; m < 4; ++m) _Pragma("unroll") for (int n = 0; n < 2; ++n) _Pragma("unroll") for (int k = 0; k < 2; ++k) \
        acc[ai][bj][m][n] = __builtin_amdgcn_mfma_f32_16x16x32_bf16(Bt[n][k], At[m][k], acc[ai][bj][m][n], 0, 0, 0); __builtin_amdgcn_s_setprio(0); } while (0)
#define PG8_WAIT_V(n) asm volatile("s_waitcnt vmcnt(" #n ")" ::: "memory")
#define PG8_WAIT_L(n) asm volatile("s_waitcnt lgkmcnt(" #n ")" ::: "memory")
#define PG8_BAR __builtin_amdgcn_s_barrier()
#define PG8_SCHED __builtin_amdgcn_sched_barrier(0)
    Unit cur, nxt; int ui = 0;
    if (!S.next(0, cur)) return;
    f32x4 acc[2][2][4][2];
#pragma unroll
    for (int a = 0; a < 2; ++a)
#pragma unroll
        for (int b = 0; b < 2; ++b)
#pragma unroll
            for (int m = 0; m < 4; ++m)
#pragma unroll
                for (int n = 0; n < 2; ++n) acc[a][b][m][n] = (f32x4){0.f, 0.f, 0.f, 0.f};
    bf16x8 At[4][2], B0[2][2], B1[2][2];
    const char* cA = PG8_AOF(cur); const char* cB = PG8_BOF(cur);
    PG8_STAGE(PG8_SB(0, 0), cB, voffB); PG8_STAGE(PG8_SB(0, 1), cB + hstepB, voffB); PG8_STAGE(PG8_SA(0, 0), cA, voffA); PG8_STAGE(PG8_SA(0, 1), cA + hstepA, voffA);
    if (wr == 1) PG8_BAR;
    PG8_WAIT_V(2); PG8_BAR;
    PG8_STAGE(PG8_SB(1, 0), cB + kstep, voffB); PG8_STAGE(PG8_SA(1, 0), cA + kstep, voffA); PG8_STAGE(PG8_SB(1, 1), cB + hstepB + kstep, voffB);
    PG8_WAIT_V(6); PG8_BAR;
    for (;;) {
        const bool has_next = S.next(ui + 1, nxt);
        const char* nA = has_next ? PG8_AOF(nxt) : cA; const char* nB = has_next ? PG8_BOF(nxt) : cB;
#pragma nounroll
        for (int t = 0; t < nt; t += 2) {
            const bool last = (t == nt - 2);
            const char* a1 = cA + (size_t)(t + 1) * kstep;
            const char* a2 = last ? nA : cA + (size_t)(t + 2) * kstep; const char* b2 = last ? nB : cB + (size_t)(t + 2) * kstep;
            const char* a3 = a2 + kstep; const char* b3 = b2 + kstep;
            PG8_LDB(B0, 0, 0); PG8_LDB(B1, 0, 1); PG8_SCHED; PG8_LDA(At, 0, 0); PG8_STAGE(PG8_SA(1, 1), a1 + hstepA, voffA);
            PG8_WAIT_V(8); PG8_WAIT_L(0); PG8_BAR; PG8_MMA(0, 0, At, B0); PG8_MMA(0, 1, At, B1); PG8_BAR; PG8_SCHED;
            PG8_LDA(At, 0, 1); PG8_STAGE(PG8_SB(0, 0), b2, voffB); PG8_STAGE(PG8_SB(0, 1), b2 + hstepB, voffB); PG8_STAGE(PG8_SA(0, 0), a2, voffA);
            PG8_WAIT_V(8); PG8_WAIT_L(0); PG8_BAR; PG8_MMA(1, 0, At, B0); PG8_MMA(1, 1, At, B1); PG8_BAR; PG8_SCHED;
            PG8_LDB(B0, 1, 0); PG8_LDB(B1, 1, 1); PG8_SCHED; PG8_LDA(At, 1, 0); PG8_STAGE(PG8_SA(0, 1), a2 + hstepA, voffA);
            PG8_WAIT_V(8); PG8_WAIT_L(0); PG8_BAR; PG8_MMA(0, 0, At, B0); PG8_MMA(0, 1, At, B1); PG8_BAR; PG8_SCHED;
            PG8_LDA(At, 1, 1); PG8_STAGE(PG8_SB(1, 0), b3, voffB); PG8_STAGE(PG8_SB(1, 1), b3 + hstepB, voffB); PG8_STAGE(PG8_SA(1, 0), a3, voffA);
            PG8_WAIT_V(8); PG8_WAIT_L(0); PG8_BAR; PG8_MMA(1, 0, At, B0); PG8_MMA(1, 1, At, B1); PG8_BAR; PG8_SCHED;
        }
        if constexpr (ALIGN_EPI) { if (wr == 0) PG8_BAR; }
        E(acc, cur, wr, wc, fr, fq);
        if (!has_next) break;
#pragma unroll
        for (int a = 0; a < 2; ++a)
#pragma unroll
            for (int b = 0; b < 2; ++b)
#pragma unroll
                for (int m = 0; m < 4; ++m)
#pragma unroll
                    for (int n = 0; n < 2; ++n) acc[a][b][m][n] = (f32x4){0.f, 0.f, 0.f, 0.f};
        cur = nxt; cA = nA; cB = nB; ++ui;
        if constexpr (ALIGN_EPI) { if (wr == 1) PG8_BAR; }
    }
    PG8_WAIT_V(0);
    if constexpr (!ALIGN_EPI) { if (wr == 0) PG8_BAR; }
    PG8_BAR;
#undef PG8_AOF
#undef PG8_BOF
#undef PG8_SA
#undef PG8_SB
#undef PG8_STAGE
#undef PG8_LDA
#undef PG8_LDB
#undef PG8_MMA
#undef PG8_WAIT_V
#undef PG8_WAIT_L
#undef PG8_BAR
#undef PG8_SCHED
}
}

namespace epi {
using pg8::Unit; using pg8::BM; using pg8::HALF;
typedef f32x4 Acc[2][2][4][2];
__device__ __forceinline__ float sq8(f32x4 a, f32x4 b) { return (a[0] * a[0] + a[1] * a[1]) + (a[2] * a[2] + a[3] * a[3]) + (b[0] * b[0] + b[1] * b[1]) + (b[2] * b[2] + b[3] * b[3]); }
#define EPI_ROW(g) (row0 + ((g) >> 2) * HALF + ((g) & 3) * 16)
__device__ __forceinline__ void rstd16x8(float (&rs)[8], const float* SSQ, int row0, int fq, float inv_n) {
    f32x4 v[8];
#pragma unroll
    for (int g = 0; g < 8; ++g) v[g] = *(const f32x4*)(SSQ + (size_t)EPI_ROW(g) * 16 + fq * 4);
#pragma unroll
    for (int g = 0; g < 8; ++g) rs[g] = 1.0f / sqrtf(fq_sum((v[g][0] + v[g][1]) + (v[g][2] + v[g][3])) * inv_n + NORM_EPS);
}

struct EpiPoolIn {
    bf16* U; bf16* SZ; bf16* HALO; const float* SSQ;
    __device__ __forceinline__ void operator()(const Acc& acc, const Unit& u, int wr, int wc, int fr, int fq) const {
        const int row0 = u.pm * BM + wr * 64 + fr; const bool isz = u.pn >= 8; const int colt = (u.pn & 7) * BM + wc * 32 + 8 * fq;
        float rs[8]; rstd16x8(rs, SSQ, row0, fq, 1.0f / DM);
#pragma unroll
        for (int g = 0; g < 8; ++g) { const int ai = g >> 2, m = g & 3; const int row = EPI_ROW(g);
#pragma unroll
            for (int bj = 0; bj < 2; ++bj) { f32x4 v0 = acc[ai][bj][m][0] * rs[g], v1 = acc[ai][bj][m][1] * rs[g]; const int col = colt + bj * HALF;
                if (isz) { v0 = silu4(v0); v1 = silu4(v1); *(v4u*)(SZ + (size_t)row * EI + col) = pack8(v0, v1); }
                else { const v4u w = pack8(v0, v1); *(v4u*)(U + (size_t)row * EI + col) = w;
                    if (g == 7 && wr == 1) *(v4u*)(HALO + ((size_t)u.pm * 16 + fr) * EI + col) = w; } } }
    }
};
struct EpiPoolGrp {
    bf16* Y; const float* scale;
    __device__ __forceinline__ void operator()(const Acc& acc, const Unit& u, int wr, int wc, int fr, int fq) const {
        const int row0 = u.pm * BM + wr * 64 + fr; const int colt = u.pn * BM + wc * 32 + 8 * fq;
        f32x4 sc[2][2];
#pragma unroll
        for (int bj = 0; bj < 2; ++bj) { sc[bj][0] = *(const f32x4*)(scale + colt + bj * HALF); sc[bj][1] = *(const f32x4*)(scale + colt + bj * HALF + 4); }
#pragma unroll
        for (int ai = 0; ai < 2; ++ai) { v4u s[4][2];
#pragma unroll
            for (int m = 0; m < 4; ++m)
#pragma unroll
                for (int bj = 0; bj < 2; ++bj) s[m][bj] = *(const v4u*)(Y + (size_t)EPI_ROW(4 * ai + m) * EI + colt + bj * HALF);
#pragma unroll
            for (int m = 0; m < 4; ++m)
#pragma unroll
                for (int bj = 0; bj < 2; ++bj) { const v4u z = s[m][bj];
                    f32x4 v0 = acc[ai][bj][m][0] * sc[bj][0], v1 = acc[ai][bj][m][1] * sc[bj][1];
                    v0 = v0 * (f32x4){bflo(z.x), bfhi(z.x), bflo(z.y), bfhi(z.y)}; v1 = v1 * (f32x4){bflo(z.z), bfhi(z.z), bflo(z.w), bfhi(z.w)};
                    *(v4u*)(Y + (size_t)EPI_ROW(4 * ai + m) * EI + colt + bj * HALF) = pack8(v0, v1); }
            asm volatile("" ::: "memory"); }
    }
};
struct EpiResid {
    const float* Xin; float* Xout; bf16* XB; float* SSQ;
    __device__ __forceinline__ void operator()(const Acc& acc, const Unit& u, int wr, int wc, int fr, int fq) const {
        const int row0 = u.pm * BM + wr * 64 + fr; const int colt = u.pn * BM + wc * 32 + 8 * fq;
#pragma unroll
        for (int ai = 0; ai < 2; ++ai) { f32x4 x[4][2][2];
#pragma unroll
            for (int m = 0; m < 4; ++m)
#pragma unroll
                for (int bj = 0; bj < 2; ++bj) { const size_t off = (size_t)EPI_ROW(4 * ai + m) * DM + colt + bj * HALF; x[m][bj][0] = *(const f32x4*)(Xin + off); x[m][bj][1] = *(const f32x4*)(Xin + off + 4); }
#pragma unroll
            for (int m = 0; m < 4; ++m) { const int row = EPI_ROW(4 * ai + m); float ss = 0.f;
#pragma unroll
                for (int bj = 0; bj < 2; ++bj) { const size_t off = (size_t)row * DM + colt + bj * HALF;
                    const f32x4 v0 = x[m][bj][0] + acc[ai][bj][m][0], v1 = x[m][bj][1] + acc[ai][bj][m][1];
                    *(f32x4*)(Xout + off) = v0; *(f32x4*)(Xout + off + 4) = v1; *(v4u*)(XB + off) = pack8(v0, v1); ss += sq8(v0, v1); }
                ss = fq_sum(ss); if (fq == 0) SSQ[(size_t)row * 16 + u.pn * 4 + wc] = ss; }
            asm volatile("" ::: "memory"); }
    }
};
struct EpiConvIn {
    bf16* CH; bf16* BZ; const float* SSQ;
    __device__ __forceinline__ void operator()(const Acc& acc, const Unit& u, int wr, int wc, int fr, int fq) const {
        const int row0 = u.pm * BM + wr * 64 + fr; const int j0 = u.pn * 64 + (wc & 1) * 32 + 8 * fq; const bool isch = wc >= 2;
        float rs[8]; rstd16x8(rs, SSQ, row0, fq, 1.0f / DM);
#pragma unroll
        for (int g = 0; g < 8; ++g) { const int ai = g >> 2, m = g & 3; const int row = EPI_ROW(g); const float r = rs[g];
            const f32x4 p0 = acc[ai][0][m][0] * r, p1 = acc[ai][0][m][1] * r, q0 = acc[ai][1][m][0] * r, q1 = acc[ai][1][m][1] * r;
            if (isch) *(v4u*)(CH + (size_t)row * EI + j0) = pack8(p0 * q0, p1 * q1);
            else *(v4u*)(BZ + (size_t)row * EI + j0) = pack8(p0 * silu4(q0), p1 * silu4(q1)); }
    }
};
__device__ __forceinline__ v4u rope8v(f32x4 x1, f32x4 x2, f32x4 c, f32x4 s) { return pack8(x1 * c - x2 * s, x2 * c + x1 * s); }
struct EpiMlaIn {
    bf16* KVLAT; bf16* QLAT; bf16* KROPE; float* SSQKV; float* SSQQ; const float* SSQ; const float* COS; const float* SIN;
    __device__ __forceinline__ void operator()(const Acc& acc, const Unit& u, int wr, int wc, int fr, int fq) const {
        const int row0 = u.pm * BM + wr * 64 + fr; const int cl = wc * 32 + 8 * fq;
        float rs[8]; rstd16x8(rs, SSQ, row0, fq, 1.0f / DM);
        const bool dorope = u.pn == 2 && wc < 2; const int ii = 16 * (wc & 1) + 4 * fq;
#pragma unroll
        for (int ai = 0; ai < 2; ++ai) { f32x4 cs[4][2];
            if (dorope) {
#pragma unroll
                for (int m = 0; m < 4; ++m) { const size_t ro = (size_t)EPI_ROW(4 * ai + m) * 32 + ii; cs[m][0] = *(const f32x4*)(COS + ro); cs[m][1] = *(const f32x4*)(SIN + ro); } }
#pragma unroll
            for (int m = 0; m < 4; ++m) { const int row = EPI_ROW(4 * ai + m); const float r = rs[4 * ai + m];
                const f32x4 a0 = acc[ai][0][m][0] * r, a1 = acc[ai][0][m][1] * r, b0 = acc[ai][1][m][0] * r, b1 = acc[ai][1][m][1] * r;
                if (u.pn == 0) { *(v4u*)(KVLAT + (size_t)row * KVL + cl) = pack8(a0, a1); *(v4u*)(KVLAT + (size_t)row * KVL + HALF + cl) = pack8(b0, b1);
                    const float ss = fq_sum(sq8(a0, a1) + sq8(b0, b1)); if (fq == 0) SSQKV[(size_t)row * 4 + wc] = ss; }
                else if (u.pn == 1) { *(v4u*)(QLAT + (size_t)row * QL + cl) = pack8(a0, a1); *(v4u*)(QLAT + (size_t)row * QL + HALF + cl) = pack8(b0, b1);
                    const float ss = fq_sum(sq8(a0, a1) + sq8(b0, b1)); if (fq == 0) SSQQ[(size_t)row * 8 + wc] = ss; }
                else { *(v4u*)(QLAT + (size_t)row * QL + 256 + cl) = pack8(a0, a1);
                    const float ss = fq_sum(sq8(a0, a1)); if (fq == 0) SSQQ[(size_t)row * 8 + 4 + wc] = ss;
                    if (dorope) *(v4u*)(KROPE + (size_t)row * RD + cl) = rope8v(b0, b1, cs[m][0], cs[m][1]); } }
            asm volatile("" ::: "memory"); }
    }
};
struct EpiQUp {
    bf16* QN; bf16* QR; const float* SSQQ; const float* COS; const float* SIN; int hh;
    __device__ __forceinline__ void operator()(const Acc& acc, const Unit& u, int wr, int wc, int fr, int fq) const {
        const int row0 = u.pm * BM + wr * 64 + fr; const int cl = wc * 32 + 8 * fq;
        float rs[8];
        { f32x2 pq[8];
#pragma unroll
          for (int g = 0; g < 8; ++g) pq[g] = *(const f32x2*)(SSQQ + (size_t)EPI_ROW(g) * 8 + fq * 2);
#pragma unroll
          for (int g = 0; g < 8; ++g) rs[g] = 1.0f / sqrtf(fq_sum(pq[g][0] + pq[g][1]) * (1.0f / QL) + NORM_EPS); }
        const bool isr = u.pn >= 4; const int ii = 16 * (wc & 1) + 4 * fq;
#pragma unroll
        for (int ai = 0; ai < 2; ++ai) { f32x4 cs[4][2];
            if (isr) {
#pragma unroll
                for (int m = 0; m < 4; ++m) { const size_t ro = (size_t)EPI_ROW(4 * ai + m) * 32 + ii; cs[m][0] = *(const f32x4*)(COS + ro); cs[m][1] = *(const f32x4*)(SIN + ro); } }
#pragma unroll
            for (int m = 0; m < 4; ++m) { const int row = EPI_ROW(4 * ai + m); const float r = rs[4 * ai + m];
#pragma unroll
                for (int bj = 0; bj < 2; ++bj) { const f32x4 v0 = acc[ai][bj][m][0] * r, v1 = acc[ai][bj][m][1] * r;
                    if (!isr) *(v4u*)(QN + (size_t)row * EI + hh * 1024 + u.pn * BM + bj * HALF + cl) = pack8(v0, v1);
                    else { const int hl = (u.pn - 4) * 4 + 2 * bj + (wc >> 1);
                        *(v4u*)(QR + (size_t)row * 512 + hl * RD + 32 * (wc & 1) + 8 * fq) = rope8v(v0, v1, cs[m][0], cs[m][1]); } } }
            asm volatile("" ::: "memory"); }
    }
};
struct EpiKvUp {
    bf16* KN; bf16* V; const float* SSQKV;
    __device__ __forceinline__ void operator()(const Acc& acc, const Unit& u, int wr, int wc, int fr, int fq) const {
        const int row0 = u.pm * BM + wr * 64 + fr; const int cl = u.pn * DN + wc * 32 + 8 * fq;
        float rs[8];
#pragma unroll
        for (int g = 0; g < 8; ++g) rs[g] = SSQKV[(size_t)EPI_ROW(g) * 4 + fq];
#pragma unroll
        for (int g = 0; g < 8; ++g) rs[g] = 1.0f / sqrtf(fq_sum(rs[g]) * (1.0f / KVL) + NORM_EPS);
#pragma unroll
        for (int g = 0; g < 8; ++g) { const int ai = g >> 2, m = g & 3; const int row = EPI_ROW(g);
            *(v4u*)(KN + (size_t)row * 1024 + cl) = pack8(acc[ai][0][m][0] * rs[g], acc[ai][0][m][1] * rs[g]);
            *(v4u*)(V + (size_t)row * 1024 + cl) = pack8(acc[ai][1][m][0] * rs[g], acc[ai][1][m][1] * rs[g]); }
    }
};
struct EpiGate {
    bf16* Y; const float* SSQ;
    __device__ __forceinline__ void operator()(const Acc& acc, const Unit& u, int wr, int wc, int fr, int fq) const {
        const int row0 = u.pm * BM + wr * 64 + fr; const int colt = u.pn * BM + wc * 32 + 8 * fq;
        float rs[8]; rstd16x8(rs, SSQ, row0, fq, 1.0f / DM);
#pragma unroll
        for (int ai = 0; ai < 2; ++ai) { v4u s[4][2];
#pragma unroll
            for (int m = 0; m < 4; ++m)
#pragma unroll
                for (int bj = 0; bj < 2; ++bj) s[m][bj] = *(const v4u*)(Y + (size_t)EPI_ROW(4 * ai + m) * EI + colt + bj * HALF);
#pragma unroll
            for (int m = 0; m < 4; ++m)
#pragma unroll
                for (int bj = 0; bj < 2; ++bj) { const v4u z = s[m][bj]; const float r = rs[4 * ai + m];
                    const f32x4 v0 = silu4(acc[ai][bj][m][0] * r) * (f32x4){bflo(z.x), bfhi(z.x), bflo(z.y), bfhi(z.y)};
                    const f32x4 v1 = silu4(acc[ai][bj][m][1] * r) * (f32x4){bflo(z.z), bfhi(z.z), bflo(z.w), bfhi(z.w)};
                    *(v4u*)(Y + (size_t)EPI_ROW(4 * ai + m) * EI + colt + bj * HALF) = pack8(v0, v1); }
            asm volatile("" ::: "memory"); }
    }
};
#undef EPI_ROW
}

namespace att {
constexpr int NW = 8, QBLK = 32, KVBLK = 64, QB = NW * QBLK, D = 128;
constexpr int PQN = 2048, PQR = 512, PKV = 1024, PKR = 64;
constexpr int SHM_V = KVBLK * D * 2, SHM_K = KVBLK * D * 2, KR_ROWB = 144, SHM_KR = KVBLK * KR_ROWB;
constexpr int OFF_K = 2 * SHM_V, OFF_KR = 2 * SHM_V + 2 * SHM_K, OFF_WS = OFF_KR + 2 * SHM_KR;
constexpr int OFF_QRL = OFF_WS + NW * 64 * 4;
constexpr int NQREG = 4;
constexpr int QRL_WAVE = (12 - NQREG) * 1024;
constexpr int LDS_BYTES = OFF_QRL + NW * QRL_WAVE;
constexpr float SCALE = ATTN_SCALE;
constexpr float THR = 8.f;
#define KSWZ(row, colB) ((row) * 256 + ((colB) ^ (((row) & 7) << 4)))
#define SBAR() __builtin_amdgcn_sched_barrier(0)
__device__ __forceinline__ int v_st(int k, int c) { const int kk = (k & ~0xC) | ((k & 4) << 1) | ((k & 8) >> 1); return ((kk >> 3) * 4 + (c >> 5)) * 512 + ((kk & 7) * 32 + (c & 31)) * 2; }
__device__ __forceinline__ int v_rd_base(int lane) { return ((lane & 3) << 3) | (((lane >> 2) & 3) << 6) | (((lane >> 4) & 1) << 5) | (((lane >> 5) & 1) << 8); }
constexpr int v_rd_off(int d0, int ks, int half) { return d0 * 512 + ks * 4096 + half * 2048; }
__device__ __forceinline__ int crow(int r, int hi) { return (r & 3) + 8 * (r >> 2) + 4 * hi; }
__device__ __forceinline__ unsigned cvtpk(float lo, float hi) { unsigned r; asm volatile("v_cvt_pk_bf16_f32 %0, %1, %2" : "=v"(r) : "v"(lo), "v"(hi)); return r; }
__device__ __forceinline__ bf16x8 load8(const bf16* p) { return *reinterpret_cast<const bf16x8*>(p); }
__device__ __forceinline__ void mask_tile(f32x16& p0, f32x16& p1, int dq) {
    const float NEG = -__builtin_inff();
#pragma unroll
    for (int r = 0; r < 16; ++r) {
        const int c = (r & 3) + 8 * (r >> 2);
        if (dq - c < 0) p0[r] = NEG;
        if (dq - c - 32 < 0) p1[r] = NEG;
    }
}
__device__ __forceinline__ void partialSM(f32x16& p0, f32x16& p1, float& m_reg, float& mn, float& alpha) {
    float pmax = p0[0]; for (int r = 1; r < 16; ++r) pmax = fmaxf(pmax, p0[r]); for (int r = 0; r < 16; ++r) pmax = fmaxf(pmax, p1[r]);
    { auto rr = __builtin_amdgcn_permlane32_swap(__float_as_uint(pmax), __float_as_uint(pmax), false, false);
      pmax = fmaxf(__uint_as_float(rr[0]), __uint_as_float(rr[1])); }
    constexpr float C2 = 1.4426950408889634f * SCALE;
    if (__builtin_expect(__all((pmax - m_reg) * SCALE <= THR), 1)) { mn = m_reg; alpha = 1.f; }
    else { mn = fmaxf(m_reg, pmax); alpha = __builtin_amdgcn_exp2f((m_reg - mn) * C2); m_reg = mn; }
    const float mnL = -mn * C2;
    for (int r = 0; r < 16; ++r) p0[r] = fmaf(p0[r], C2, mnL); for (int r = 0; r < 16; ++r) p1[r] = fmaf(p1[r], C2, mnL);
    for (int r = 0; r < 16; ++r) p0[r] = __builtin_amdgcn_exp2f(p0[r]);
}
__device__ __forceinline__ void finishSM(f32x16& p0, f32x16& p1, float alpha, float& l_reg, bf16x8& pa0, bf16x8& pa1, bf16x8& pa2, bf16x8& pa3) {
    for (int r = 0; r < 16; ++r) p1[r] = __builtin_amdgcn_exp2f(p1[r]);
    float ps = 0; for (int r = 0; r < 16; ++r) ps += p0[r]; for (int r = 0; r < 16; ++r) ps += p1[r];
    { auto rr = __builtin_amdgcn_permlane32_swap(__float_as_uint(ps), __float_as_uint(ps), false, false);
      ps = __uint_as_float(rr[0]) + __uint_as_float(rr[1]); }
    l_reg = l_reg * alpha + ps;
#define PK4(P, B_, OUT) do { unsigned a0 = cvtpk(P[B_+0], P[B_+1]), a1 = cvtpk(P[B_+2], P[B_+3]);                          \
        unsigned b0 = cvtpk(P[B_+4], P[B_+5]), b1 = cvtpk(P[B_+6], P[B_+7]);                                             \
        auto r0 = __builtin_amdgcn_permlane32_swap(a0, b0, false, false); auto r1 = __builtin_amdgcn_permlane32_swap(a1, b1, false, false); \
        v4u w = {r0[0], r1[0], r0[1], r1[1]}; OUT = *reinterpret_cast<bf16x8*>(&w); } while (0)
    PK4(p0, 0, pa0); PK4(p0, 8, pa1); PK4(p1, 0, pa2); PK4(p1, 8, pa3);
#undef PK4
}
template <int KB>
__device__ __forceinline__ void qkt(f32x16& p0, f32x16& p1, const char* lds, int r32, int hi, const bf16x8* qr, const char* qrl) {
    p0 = f32x16{}; p1 = f32x16{};
    const char* kb[4];
#pragma unroll
    for (int dd = 0; dd < 4; ++dd) kb[dd] = lds + OFF_K + KB * SHM_K + KSWZ(r32, (dd * 16 + hi * 8) * 2);
#pragma unroll
    for (int d0 = 0; d0 < 8; ++d0) { const char* a = kb[d0 & 3] + (d0 >> 2) * 128;
        bf16x8 b0 = *reinterpret_cast<const bf16x8*>(a);
        bf16x8 b1 = *reinterpret_cast<const bf16x8*>(a + 32 * 256);
        bf16x8 qf; if (d0 < NQREG) qf = qr[d0]; else qf = *reinterpret_cast<const bf16x8*>(qrl + (4 + d0 - NQREG) * 1024);
        p0 = __builtin_amdgcn_mfma_f32_32x32x16_bf16(b0, qf, p0, 0, 0, 0);
        p1 = __builtin_amdgcn_mfma_f32_32x32x16_bf16(b1, qf, p1, 0, 0, 0); }
    const char* kr = lds + OFF_KR + KB * SHM_KR + r32 * KR_ROWB + hi * 16;
#pragma unroll
    for (int d0 = 0; d0 < 4; ++d0) {
        bf16x8 b0 = *reinterpret_cast<const bf16x8*>(kr + d0 * 32);
        bf16x8 b1 = *reinterpret_cast<const bf16x8*>(kr + d0 * 32 + 32 * KR_ROWB);
        const bf16x8 qf = *reinterpret_cast<const bf16x8*>(qrl + d0 * 1024);
        p0 = __builtin_amdgcn_mfma_f32_32x32x16_bf16(b0, qf, p0, 0, 0, 0);
        p1 = __builtin_amdgcn_mfma_f32_32x32x16_bf16(b1, qf, p1, 0, 0, 0); }
}
template <int VB>
__device__ __forceinline__ void pv_tile(f32x16* o, int vb0, bf16x8 pa0, bf16x8 pa1, bf16x8 pa2, bf16x8 pa3) {
#define TRRD(dst, off) asm volatile("ds_read_b64_tr_b16 %0, %1 offset:%2" : "=&v"(dst) : "v"(vb0), "i"(off) : "memory")
#define PV_D0(d0) do { s16x4 l0, l1, l2, l3, h0, h1, h2, h3; constexpr int b_ = VB * SHM_V + v_rd_off(d0, 0, 0); \
        TRRD(l0, b_); TRRD(h0, b_ + 2048); TRRD(l1, b_ + 4096); TRRD(h1, b_ + 6144); TRRD(l2, b_ + 8192); TRRD(h2, b_ + 10240); TRRD(l3, b_ + 12288); TRRD(h3, b_ + 14336); \
        asm volatile("s_waitcnt lgkmcnt(0)" ::: "memory"); SBAR();   \
        o[d0] = __builtin_amdgcn_mfma_f32_32x32x16_bf16(pa0, (bf16x8){l0[0], l0[1], l0[2], l0[3], h0[0], h0[1], h0[2], h0[3]}, o[d0], 0, 0, 0);   \
        o[d0] = __builtin_amdgcn_mfma_f32_32x32x16_bf16(pa1, (bf16x8){l1[0], l1[1], l1[2], l1[3], h1[0], h1[1], h1[2], h1[3]}, o[d0], 0, 0, 0);   \
        o[d0] = __builtin_amdgcn_mfma_f32_32x32x16_bf16(pa2, (bf16x8){l2[0], l2[1], l2[2], l2[3], h2[0], h2[1], h2[2], h2[3]}, o[d0], 0, 0, 0);   \
        o[d0] = __builtin_amdgcn_mfma_f32_32x32x16_bf16(pa3, (bf16x8){l3[0], l3[1], l3[2], l3[3], h3[0], h3[1], h3[2], h3[3]}, o[d0], 0, 0, 0); } while (0)
    PV_D0(0); PV_D0(1); PV_D0(2); PV_D0(3);
#undef PV_D0
#undef TRRD
}
struct BlockRef { const bf16* Q; const bf16* QR; const bf16* K; const bf16* V; const bf16* KR; bf16* O; int P0; };
struct Seam { bf16x8 qr[NQREG]; bf16x8 st_v0, st_v1, st_k0, st_k1, st_kr; };
#define ROWKV(p, k0, rr) ((p) + (size_t)((k0) + (rr)) * PKV + sc)
#define VMW() asm volatile("s_waitcnt vmcnt(0)" ::: "memory")
#define VMWN(n) asm volatile("s_waitcnt vmcnt(%0)" :: "i"(n) : "memory")
#define SLOAD_H(Kp, Vp, KRp, k0) do { S.st_v0 = load8(ROWKV(Vp, k0, sr)); S.st_v1 = load8(ROWKV(Vp, k0, 32 + sr));              \
                         S.st_k0 = load8(ROWKV(Kp, k0, sr)); S.st_k1 = load8(ROWKV(Kp, k0, 32 + sr)); S.st_kr = load8((KRp) + (size_t)((k0) + krr) * PKR + krc); } while (0)
#define SWRITE_HK(bf) do { *(bf16x8*)(K_lds + (bf) * SHM_K + kws) = S.st_k0; *(bf16x8*)(K_lds + (bf) * SHM_K + kws + 32 * 256) = S.st_k1; *(bf16x8*)(KR_lds + (bf) * SHM_KR + krws) = S.st_kr; } while (0)
#define SWRITE_HV(bf) do { *(bf16x8*)(V_lds + (bf) * SHM_V + vst0) = S.st_v0; *(bf16x8*)(V_lds + (bf) * SHM_V + vst1) = S.st_v1; } while (0)
#define SWRITE_H(bf) do { SWRITE_HV(bf); SWRITE_HK(bf); } while (0)
#define QLOAD(R) do { _Pragma("unroll") for (int d0 = 0; d0 < NQREG; ++d0) S.qr[d0] = load8((R).Q + (size_t)(wid * QBLK + r32) * PQN + d0 * 16 + hi * 8); } while (0)
#define QRLOAD(R) do { _Pragma("unroll") for (int d0 = 0; d0 < 4; ++d0) *(bf16x8*)(qrl + d0 * 1024) = load8((R).QR + (size_t)(wid * QBLK + r32) * PQR + d0 * 16 + hi * 8); \
                       _Pragma("unroll") for (int d0 = NQREG; d0 < 8; ++d0) *(bf16x8*)(qrl + (4 + d0 - NQREG) * 1024) = load8((R).Q + (size_t)(wid * QBLK + r32) * PQN + d0 * 16 + hi * 8); } while (0)
__device__ __forceinline__ void attn_prime(const BlockRef& cur, char* lds, Seam& S) {
    int tid_ = threadIdx.x; asm volatile("" : "+v"(tid_));
    const int tid = tid_, wid = __builtin_amdgcn_readfirstlane(tid >> 6), lane = tid & 63, r32 = lane & 31, hi = lane >> 5;
    const int sr = tid >> 4, sc = (tid & 15) * 8, kws = KSWZ(sr, sc * 2); char* K_lds = lds + OFF_K; char* KR_lds = lds + OFF_KR;
    const int krr = tid >> 3, krc = (tid & 7) * 8, krws = krr * KR_ROWB + krc * 2;
    char* qrl = lds + OFF_QRL + wid * QRL_WAVE + lane * 16;
    QLOAD(cur); QRLOAD(cur);
    SLOAD_H(cur.K, cur.V, cur.KR, 0); VMW(); SWRITE_HK(0);
    __syncthreads();
}
__device__ __forceinline__ void attn_block(const BlockRef& cur, const BlockRef& nxt, char* lds, Seam& S) {
    int tid_ = threadIdx.x; asm volatile("" : "+v"(tid_));
    const int tid = tid_, wid = __builtin_amdgcn_readfirstlane(tid >> 6), lane = tid & 63, r32 = lane & 31, hi = lane >> 5;
    const int NT = (cur.P0 + QB) / KVBLK;
    const int qlo = cur.P0 + wid * QBLK, qm = qlo + r32 - 4 * hi;
    char* V_lds = lds; char* K_lds = lds + OFF_K; char* KR_lds = lds + OFF_KR;
    float* ws = (float*)(lds + OFF_WS) + wid * 64; float* li_l = ws, * al_l = ws + 32;
    float m_reg = -1e30f, l_reg = 0; f32x16 o[4] = {};
    const int sr = tid >> 4, sc = (tid & 15) * 8, vst0 = v_st(sr, sc), vst1 = v_st(32 + sr, sc), kws = KSWZ(sr, sc * 2);
    const int krr = tid >> 3, krc = (tid & 7) * 8, krws = krr * KR_ROWB + krc * 2;
    const int vb0 = (int)(uintptr_t)V_lds + v_rd_base(lane);
    char* qrl = lds + OFF_QRL + wid * QRL_WAVE + lane * 16;
    const bf16* Kh = cur.K; const bf16* Vh = cur.V; const bf16* KRh = cur.KR;
#define RESC(a) do { if (__any((a) < 1.f)) { if (hi == 0) al_l[r32] = (a); asm volatile("s_waitcnt lgkmcnt(0)" ::: "memory");              \
                     for (int d_ = 0; d_ < 4; ++d_) for (int r = 0; r < 16; ++r) o[d_][r] *= al_l[crow(r, hi)]; } } while (0)
#define KBASE(t) ((t) * KVBLK)
#define MASKT(P0_, P1_, t) do { const int kb_ = KBASE(t); if (kb_ + KVBLK - 1 > qlo) mask_tile(P0_, P1_, qm - kb_); } while (0)
    constexpr int NQL = NQREG;
#define SEAM_K0() do { VMWN(NQL); SWRITE_HK(0); SBAR(); } while (0)
    f32x16 pA0, pA1, pB0, pB1; float mnA, mnB, alA, alB; bf16x8 pa0, pa1, pa2, pa3;
    SWRITE_HV(0); SBAR();
    if (NT > 1) { SLOAD_H(Kh, Vh, KRh, KBASE(1)); }
    SBAR(); qkt<0>(pA0, pA1, lds, r32, hi, S.qr, qrl);
    MASKT(pA0, pA1, 0); partialSM(pA0, pA1, m_reg, mnA, alA);
    if (NT > 1) { VMW(); SWRITE_H(1); }
    __syncthreads();
#define HALF_STEP(PX0, PX1, mnX, alX, PY0, PY1, alY, t, KB, VB, SB) do {                                                      \
        SBAR(); qkt<KB>(PX0, PX1, lds, r32, hi, S.qr, qrl);                                             \
        finishSM(PY0, PY1, alY, l_reg, pa0, pa1, pa2, pa3); SBAR();                                                           \
        if ((t) + 1 < NT) { SLOAD_H(Kh, Vh, KRh, KBASE((t) + 1)); SBAR(); }                                               \
        pv_tile<VB>(o, vb0, pa0, pa1, pa2, pa3); MASKT(PX0, PX1, (t)); partialSM(PX0, PX1, m_reg, mnX, alX);                                        \
        __syncthreads();                                                                                                      \
        if ((t) + 1 < NT) { VMW(); SWRITE_H(SB); }                                                                          \
        RESC(alX); __syncthreads(); } while (0)
    for (int t = 1; t + 1 < NT; t += 2) {
        HALF_STEP(pB0, pB1, mnB, alB, pA0, pA1, alA, t, 1, 0, 0);
        HALF_STEP(pA0, pA1, mnA, alA, pB0, pB1, alB, t + 1, 0, 1, 1);
    }
    const bool even = (NT & 1) == 0;
    if (even) { SBAR(); qkt<1>(pB0, pB1, lds, r32, hi, S.qr, qrl); SBAR(); }
    SLOAD_H(nxt.K, nxt.V, nxt.KR, 0); SBAR();
    QLOAD(nxt);
    SBAR();
    finishSM(pA0, pA1, alA, l_reg, pa0, pa1, pa2, pa3); SBAR();
    pv_tile<0>(o, vb0, pa0, pa1, pa2, pa3);
    if (even) { MASKT(pB0, pB1, NT - 1); partialSM(pB0, pB1, m_reg, mnB, alB); __syncthreads(); RESC(alB);
        finishSM(pB0, pB1, alB, l_reg, pa0, pa1, pa2, pa3); SBAR(); pv_tile<1>(o, vb0, pa0, pa1, pa2, pa3); }
    SBAR(); SEAM_K0();
    if (hi == 0) li_l[r32] = l_reg; asm volatile("s_waitcnt lgkmcnt(0)" ::: "memory");
    float rli[16];
#pragma unroll
    for (int r = 0; r < 16; ++r) rli[r] = __builtin_amdgcn_rcpf(li_l[crow(r, hi)]);
    int hio = hi; asm volatile("" : "+v"(hio));
    bf16* Ow = cur.O + (size_t)(wid * QBLK + 4 * hio) * PQN + r32;
#pragma unroll
    for (int r = 0; r < 16; ++r) { const int orow = (r & 3) + 8 * (r >> 2);
#pragma unroll
        for (int d0 = 0; d0 < 4; ++d0) { const float v = o[d0][r] * rli[r];
            const float vn = __shfl_xor(v, 1);
            if ((r32 & 1) == 0) *(unsigned*)(Ow + (size_t)orow * PQN + d0 * 32) = cvtpk(v, vn); }
        if ((r & 3) == 3) asm volatile("" ::: "memory"); }
    QRLOAD(nxt);
    __syncthreads();
#undef RESC
#undef KBASE
#undef MASKT
#undef SEAM_K0
#undef HALF_STEP
}
#undef ROWKV
#undef VMW
#undef VMWN
#undef SLOAD_H
#undef SWRITE_HK
#undef SWRITE_HV
#undef SWRITE_H
#undef QLOAD
#undef QRLOAD
#undef KSWZ
#undef SBAR
__device__ __forceinline__ BlockRef block_ref(int L, int pass, int hh, const bf16* QN, const bf16* QR, const bf16* KN, const bf16* V, const bf16* KR, bf16* O) {
    const int x = L & 7, k = L >> 3, bh = x * 4 + (k >> 3), y = k & 7, b = bh >> 3, h8 = bh & 7, qb = pass ? 15 - y : y;
    const size_t row0 = (size_t)b * SEQ + (size_t)qb * QB, rowb = (size_t)b * SEQ;
    BlockRef r;
    r.Q = QN + row0 * PQN + (hh * 8 + h8) * DN; r.O = O + row0 * PQN + (hh * 8 + h8) * DN; r.QR = QR + row0 * PQR + h8 * RD;
    r.K = KN + rowb * PKV + h8 * DN; r.V = V + rowb * PKV + h8 * DV; r.KR = KR + rowb * PKR; r.P0 = qb * QB;
    return r;
}
__device__ __forceinline__ void attn_phase(char* lds, int hh, const bf16* QN, const bf16* QR, const bf16* KN, const bf16* V, const bf16* KR, bf16* O, int bid, int G) {
    int L = bid; if (L >= 256) return;
    int pass = 0;
    BlockRef cur = block_ref(L, 0, hh, QN, QR, KN, V, KR, O);
    Seam S;
    attn_prime(cur, lds, S);
    for (;;) {
        const bool more_pass = pass == 0, more_item = L + G < 256, last = !more_pass && !more_item;
        int passn = pass + 1, Ln = L;
        if (!more_pass) { passn = 0; Ln = more_item ? L + G : L; }
        const BlockRef nxt = last ? cur : block_ref(Ln, passn, hh, QN, QR, KN, V, KR, O);
        attn_block(cur, nxt, lds, S);
        if (last) break;
        cur = nxt; pass = passn; L = Ln;
    }
}
}

constexpr int NWAVES = 8;
constexpr int NPH = 20;
constexpr int N_LAUNCHES = MK_N_LAUNCHES;
static_assert(N_LAUNCHES == 1 || N_LAUNCHES == NPH, "MK_N_LAUNCHES is 1 or NPH");
constexpr int CW_BAR = 4096;
constexpr int RING_OFF = 0, RING_BYTES = 155648;
constexpr int LDSCTL_OFF = RING_BYTES, MISC_OFF = LDSCTL_OFF + 320;
constexpr int LDS_BYTES = RING_BYTES + 1024;
static_assert(att::LDS_BYTES <= RING_BYTES, "attention LDS");

#define XB_TMO      128
#define XB_XCNT(j)  (256  + 64 * (j))
#define XB_XSUB(j)  (1280 + 64 * (j))
#define XB_XGEN(j)  (2304 + 64 * (j))
#define XB_TOP      3328
#define XB_TOPGEN   3392
#define XCD_BAR_WORDS 3456
#define XB_SPIN_CAP (1u << 18)
__device__ __forceinline__ unsigned xb_ld(unsigned* p)              { return __hip_atomic_load(p, __ATOMIC_RELAXED, __HIP_MEMORY_SCOPE_AGENT); }
__device__ __forceinline__ unsigned xb_add(unsigned* p, unsigned v) { return __hip_atomic_fetch_add(p, v, __ATOMIC_RELAXED, __HIP_MEMORY_SCOPE_AGENT); }
__device__ __forceinline__ unsigned xb_xcc_id() { return (unsigned)__builtin_amdgcn_s_getreg((3 << 11) | 20) & 0xFu; }
#define XB_SPIN(cond, bar) do { unsigned _sp = 0; while (cond) { __builtin_amdgcn_s_sleep(1); \
    if ((++_sp & 255u) == 0u) { if (xb_ld(&(bar)[XB_TMO])) break; if (_sp > XB_SPIN_CAP) { atomicAdd(&(bar)[XB_TMO], 1u); break; } } } } while (0)
struct XcdBarrier { unsigned* bar; unsigned x; volatile LAS unsigned* st; };
__device__ __forceinline__ XcdBarrier xcd_barrier_post(unsigned* bar, volatile LAS unsigned* st) {
    XcdBarrier b; b.bar = bar; b.x = xb_xcc_id(); b.st = st;
    if (threadIdx.x == 0) (void)xb_add(&bar[XB_XCNT(b.x)], 1u);
    return b;
}
__device__ __forceinline__ void xcd_barrier_complete(unsigned* bar, unsigned x, unsigned& nloc, unsigned& nx) {
    const unsigned G = gridDim.x * gridDim.y * gridDim.z;
    unsigned sum, cnt, mine, sp = 0u;
    for (;;) {
        sum = 0u; cnt = 0u; mine = 0u;
#pragma unroll
        for (unsigned j = 0; j < 16; ++j) { const unsigned c = xb_ld(&bar[XB_XCNT(j)]); sum += c; cnt += (c > 0u) ? 1u : 0u; mine = (j == x) ? c : mine; }
        if (sum == G) break;
        __builtin_amdgcn_s_sleep(1);
        if ((++sp & 255u) == 0u) { if (xb_ld(&bar[XB_TMO])) break; if (sp > XB_SPIN_CAP) { atomicAdd(&bar[XB_TMO], 1u); break; } }
    }
    nloc = mine > 0u ? mine : 1u; nx = cnt > 0u ? cnt : 1u;
}
__device__ __forceinline__ void xcd_barrier(const XcdBarrier& b) {
    asm volatile("s_waitcnt vmcnt(0)" ::: "memory");
    __syncthreads();
    if (threadIdx.x == 0) {
        unsigned* bar = b.bar;
        __builtin_amdgcn_s_waitcnt(0);
        unsigned nloc = b.st[0], nx = b.st[1];
        if (nloc == 0u) { xcd_barrier_complete(bar, b.x, nloc, nx); b.st[0] = nloc; b.st[1] = nx; }
        const unsigned old = xb_add(&bar[XB_XSUB(b.x)], 1u);
        const unsigned gen = old / nloc;
        if (old + 1u == (gen + 1u) * nloc) {
            __builtin_amdgcn_fence(__ATOMIC_RELEASE, "agent");
            asm volatile("s_waitcnt vmcnt(0)" ::: "memory");
            const unsigned og = xb_add(&bar[XB_TOP], 1u);
            const unsigned tg = og / nx;
            if (og + 1u == (tg + 1u) * nx) xb_add(&bar[XB_TOPGEN], 1u);
            else XB_SPIN(xb_ld(&bar[XB_TOPGEN]) == tg, bar);
            __builtin_amdgcn_fence(__ATOMIC_ACQUIRE, "agent");
            xb_add(&bar[XB_XGEN(b.x)], 1u);
            asm volatile("s_waitcnt vmcnt(0)" ::: "memory");
        } else {
            XB_SPIN(xb_ld(&bar[XB_XGEN(b.x)]) == gen, bar);
            __builtin_amdgcn_fence(__ATOMIC_ACQUIRE, "agent");
            asm volatile("s_waitcnt vmcnt(0)" ::: "memory");
        }
    }
    __syncthreads();
}

struct Args { const void* in[19]; float* out; unsigned char* ws; int ph_lo, ph_hi; };
static_assert(sizeof(Args) == 19 * 8 + 8 + 8 + 8, "Args has no padding");

struct Frame { LAS unsigned char* lds; int tid, lane, wave, vcu, G; const Args* ap; };

enum { MAP_ID = 0, MAP_CONV = 1, MAP_MLAIN = 2, MAP_QUP = 3 };
__device__ __forceinline__ int map_row(int mapid, int s) {
    if (mapid == MAP_ID) return s;
    if (mapid == MAP_CONV) { const int kind = s >> 11, j = s & 2047, pn = j >> 6, jl = j & 63;
        const int wchi = (kind == 1 || kind == 2) ? 1 : 0, bj = (kind >= 2) ? 1 : 0;
        return pn * 256 + bj * 128 + (wchi * 2 + (jl >> 5)) * 32 + (jl & 31); }
    if (mapid == MAP_MLAIN) {
        if (s < QL) return 256 + s;
        if (s < QL + KVL) return s - QL;
        if (s < QL + KVL + RD) { const int e = s - (QL + KVL), half = e >> 5, ii = e & 31; return 640 + 32 * (ii >> 4) + 8 * ((ii >> 2) & 3) + 4 * half + (ii & 3); }
        return 768 + (s - (QL + KVL + RD)); }
    { const int h = s / 192, d = s % 192, hh = h >> 3, h8 = h & 7;
        if (d < DN) return hh * 1536 + h8 * DN + d;
        const int e = d - DN, half = e >> 5, ii = e & 31, tr = h8 >> 2, hl = h8 & 3, bj = hl >> 1, wc = (hl & 1) * 2 + (ii >> 4);
        return hh * 1536 + 1024 + tr * 256 + bj * 128 + wc * 32 + 8 * ((ii >> 2) & 3) + 4 * half + (ii & 3); }
}
__device__ __forceinline__ void prep_item(const float* W, int Nsrc, const float* gk, bf16* WT, int ldd, int mapid, LAS float* scr, int item, int lane) {
    const int nblk = Nsrc / 32, kb = item / nblk, nb = item % nblk, k0 = 64 * kb, n0 = 32 * nb;
#pragma unroll 8
    for (int i = 0; i < 32; ++i) { const int kk = 2 * i + (lane >> 5); float v = W[(size_t)(k0 + kk) * Nsrc + n0 + (lane & 31)]; if (gk) v *= gk[k0 + kk]; scr[kk * 33 + (lane & 31)] = v; }
    LDS_WAIT(); asm volatile("" ::: "memory");
    const int c = lane & 7;
#pragma unroll
    for (int j = 0; j < 4; ++j) { const int n = (lane >> 3) + 8 * j; const LAS float* s = scr + (8 * c) * 33 + n;
        v4u o; o.x = cvt_pk_bf16(s[0 * 33], s[1 * 33]); o.y = cvt_pk_bf16(s[2 * 33], s[3 * 33]); o.z = cvt_pk_bf16(s[4 * 33], s[5 * 33]); o.w = cvt_pk_bf16(s[6 * 33], s[7 * 33]);
        *(GAS v4u*)(WT + (size_t)map_row(mapid, n0 + n) * ldd + k0 + 8 * c) = o; }
    LDS_WAIT(); asm volatile("" ::: "memory");
}
#define INP(i) ((const float*)F.ap->in[i])
__device__ __forceinline__ void p0_prologue(Frame& F) {
    unsigned char* ws = F.ap->ws;
    LAS float* scr = (LAS float*)(F.lds + RING_OFF + F.wave * 16384);
    const int gw = F.vcu * NWAVES + F.wave, NGW = F.G * NWAVES;
    constexpr int I_PIN = 16 * 128, I_PGRP = 8 * 16, I_POUT = 32 * 32, I_CIN = 16 * 256, I_COUT = 32 * 32, I_MIN = 16 * 86, I_QUP = 6 * 96, I_KVUP = 4 * 128, I_MOUT = 32 * 32;
    constexpr int I_POOL = I_PIN + 4 * I_PGRP + I_POUT;
    constexpr int NITEMS = 2 * I_POOL + I_CIN + I_COUT + I_MIN + I_QUP + I_KVUP + I_MOUT;
    for (int it = gw; it < NITEMS; it += NGW) {
        int r = it;
        if (r < 2 * I_POOL) { const int j = r / I_POOL; r -= j * I_POOL; unsigned char* wb = ws + (j ? WS_WPOOL1 : WS_WPOOL0);
            if (r < I_PIN) { prep_item(INP(3) + (size_t)j * DM * 4096, 4096, INP(2) + j * DM, (bf16*)(wb + WPOOL_IN), DM, MAP_ID, scr, r, F.lane); continue; } r -= I_PIN;
            if (r < 4 * I_PGRP) { const int g = r / I_PGRP; r -= g * I_PGRP;
                prep_item(INP(4) + ((size_t)j * 4 + g) * 512 * 512, 512, nullptr, (bf16*)(wb + WPOOL_GRP) + (size_t)g * 512 * 512, 512, MAP_ID, scr, r, F.lane); continue; } r -= 4 * I_PGRP;
            prep_item(INP(6) + (size_t)j * EI * DM, DM, nullptr, (bf16*)(wb + WPOOL_OUT), EI, MAP_ID, scr, r, F.lane); continue; }
        r -= 2 * I_POOL;
        if (r < I_CIN) { prep_item(INP(8), 8192, INP(7), (bf16*)(ws + WS_WCONV_IN), DM, MAP_CONV, scr, r, F.lane); continue; } r -= I_CIN;
        if (r < I_COUT) { prep_item(INP(10), DM, nullptr, (bf16*)(ws + WS_WCONV_OUT), EI, MAP_ID, scr, r, F.lane); continue; } r -= I_COUT;
        if (r < I_MIN) { prep_item(INP(12), MLA_IN, INP(11), (bf16*)(ws + WS_WMLA_B1), DM, MAP_MLAIN, scr, r, F.lane); continue; } r -= I_MIN;
        if (r < I_QUP) { prep_item(INP(14), 3072, INP(13), (bf16*)(ws + WS_WMLA_QUP), QL, MAP_QUP, scr, r, F.lane); continue; } r -= I_QUP;
        if (r < I_KVUP) { prep_item(INP(16), 4096, INP(15), (bf16*)(ws + WS_WMLA_KVUP), KVL, MAP_ID, scr, r, F.lane); continue; } r -= I_KVUP;
        prep_item(INP(17), DM, nullptr, (bf16*)(ws + WS_WMLA_OUT), EI, MAP_ID, scr, r, F.lane);
    }
    for (int i = gw * 64 + F.lane; i < 64 * 128; i += NGW * 64) *(GAS v4u*)((bf16*)(ws + WS_WMLA_B1) + (size_t)704 * DM + (size_t)i * 8) = (v4u){0u, 0u, 0u, 0u};
    { const float* x = INP(0); bf16* XB = (bf16*)(ws + WS_XB); float* SSQ = (float*)(ws + WS_SSQ);
      for (int m = gw; m < M; m += NGW) { const GAS f32x4* xr = (const GAS f32x4*)(x + (size_t)m * DM) + F.lane; f32x4 v[4]; float s = 0.f;
#pragma unroll
          for (int j = 0; j < 4; ++j) { v[j] = xr[64 * j]; s += (v[j].x * v[j].x + v[j].y * v[j].y) + (v[j].z * v[j].z + v[j].w * v[j].w); }
          s = wave_sum(s);
          GAS v2u* o8 = (GAS v2u*)(XB + (size_t)m * DM) + F.lane;
#pragma unroll
          for (int j = 0; j < 4; ++j) o8[64 * j] = (v2u){cvt_pk_bf16(v[j].x, v[j].y), cvt_pk_bf16(v[j].z, v[j].w)};
          if (F.lane < 16) SSQ[(size_t)m * 16 + F.lane] = F.lane == 0 ? s : 0.f; } }
    { const int* pos = (const int*)F.ap->in[1]; float* COS = (float*)(ws + WS_COS); float* SIN = (float*)(ws + WS_SIN);
      for (int e = F.vcu * (NWAVES * 64) + F.tid; e < M * 32; e += F.G * NWAVES * 64) { const int row = e >> 5, i = e & 31;
          const float invf = powf(ROPE_BASE, -(float)(2 * i) / (float)RD); const float ang = (float)pos[row] * invf;
          const double a = (double)ang; const double n = __builtin_rint(a * 0.15915494309189535); const float r = (float)__builtin_fma(n, -6.283185307179586, a);
          COS[e] = cosf(r); SIN[e] = sinf(r); } }
}

template <int W>
__device__ __forceinline__ void pool_rows(const v2u (&v)[31], int t0, bf16* out_base) {
    float s[4];
#pragma unroll
    for (int c = 0; c < 4; ++c) s[c] = 0.f;
#pragma unroll
    for (int j = 0; j < W; ++j) { const v2u w = v[15 - j]; s[0] += bflo(w.x); s[1] += bfhi(w.x); s[2] += bflo(w.y); s[3] += bfhi(w.y); }
#pragma unroll
    for (int i = 0; i < 16; ++i) {
        const int t = t0 + i; const float inv = __builtin_amdgcn_rcpf((float)(t + 1 < W ? t + 1 : W));
        const v2u cu = v[15 + i];
        const float o0 = s[0] * inv - bflo(cu.x), o1 = s[1] * inv - bfhi(cu.x), o2 = s[2] * inv - bflo(cu.y), o3 = s[3] * inv - bfhi(cu.y);
        *(GAS v2u*)(out_base + (size_t)i * EI) = (v2u){cvt_pk_bf16(o0, o1), cvt_pk_bf16(o2, o3)};
        if (i < 15) { const v2u a = v[16 + i], d = v[16 + i - W];
            s[0] += bflo(a.x) - bflo(d.x); s[1] += bfhi(a.x) - bfhi(d.x); s[2] += bflo(a.y) - bflo(d.y); s[3] += bfhi(a.y) - bfhi(d.y); }
    }
}
__device__ __forceinline__ void pool_mix_phase(Frame& F, bf16* U, const bf16* HALO) {
    const int cb = F.tid & 31, rb = F.tid >> 5;
    for (int unit = F.vcu; unit < 64 * 16; unit += F.G) {
        const int pm = unit >> 4, cs = unit & 15, col = cs * 128 + cb * 4, g = cs >> 2;
        const int r0 = pm * 256 + rb * 16, t0 = r0 & (SEQ - 1);
        v2u v[31];
#pragma unroll
        for (int i = 0; i < 31; ++i) { const int dr = i - 15;
            if (dr >= 0 || rb > 0) v[i] = *(const GAS v2u*)(U + (size_t)(r0 + dr) * EI + col);
            else if ((pm & 15) == 0) v[i] = (v2u){0u, 0u};
            else v[i] = *(const GAS v2u*)(HALO + ((size_t)(pm - 1) * 16 + (16 + dr)) * EI + col); }
        VM_WAIT(); __syncthreads();
        bf16* ob = U + (size_t)r0 * EI + col;
        if (g == 0) pool_rows<2>(v, t0, ob); else if (g == 1) pool_rows<4>(v, t0, ob); else if (g == 2) pool_rows<8>(v, t0, ob); else pool_rows<16>(v, t0, ob);
    }
}
__device__ __forceinline__ void conv_mix_phase(Frame& F, const bf16* CH, bf16* BZ, const float* cw) {
    const int cb = F.tid & 31, rb = F.tid >> 5;
    for (int unit = F.vcu; unit < 64 * 8; unit += F.G) {
        const int pm = unit >> 3, cs = unit & 7, col = cs * 256 + cb * 8;
        const int r0 = pm * 256 + rb * 16, t0 = r0 & (SEQ - 1);
        float w[3][8];
#pragma unroll
        for (int j = 0; j < 3; ++j) { const f32x4 a = *(const GAS f32x4*)(cw + j * EI + col), b = *(const GAS f32x4*)(cw + j * EI + col + 4);
            w[j][0] = a[0]; w[j][1] = a[1]; w[j][2] = a[2]; w[j][3] = a[3]; w[j][4] = b[0]; w[j][5] = b[1]; w[j][6] = b[2]; w[j][7] = b[3]; }
        v4u c[18];
#pragma unroll
        for (int i = 0; i < 18; ++i) { const int dr = i - 2; if (t0 + dr >= 0) c[i] = *(const GAS v4u*)(CH + (size_t)(r0 + dr) * EI + col); else c[i] = (v4u){0u, 0u, 0u, 0u}; }
#pragma unroll
        for (int i = 0; i < 16; ++i) { bf16* p = BZ + (size_t)(r0 + i) * EI + col; const v4u z = *(const GAS v4u*)p; const v4u x0 = c[i], x1 = c[i + 1], x2 = c[i + 2];
            float o[8];
#define CV(k, X0, X1, X2, Z) o[k] = (Z) * (w[0][k] * (X0) + w[1][k] * (X1) + w[2][k] * (X2))
            CV(0, bflo(x0.x), bflo(x1.x), bflo(x2.x), bflo(z.x)); CV(1, bfhi(x0.x), bfhi(x1.x), bfhi(x2.x), bfhi(z.x));
            CV(2, bflo(x0.y), bflo(x1.y), bflo(x2.y), bflo(z.y)); CV(3, bfhi(x0.y), bfhi(x1.y), bfhi(x2.y), bfhi(z.y));
            CV(4, bflo(x0.z), bflo(x1.z), bflo(x2.z), bflo(z.z)); CV(5, bfhi(x0.z), bfhi(x1.z), bfhi(x2.z), bfhi(z.z));
            CV(6, bflo(x0.w), bflo(x1.w), bflo(x2.w), bflo(z.w)); CV(7, bfhi(x0.w), bfhi(x1.w), bfhi(x2.w), bfhi(z.w));
#undef CV
            *(GAS v4u*)p = (v4u){cvt_pk_bf16(o[0], o[1]), cvt_pk_bf16(o[2], o[3]), cvt_pk_bf16(o[4], o[5]), cvt_pk_bf16(o[6], o[7])}; }
    }
}
__device__ __forceinline__ void final_norm_phase(Frame& F, float* X, const float* gain) {
    const int gw = F.vcu * NWAVES + F.wave, NGW = F.G * NWAVES;
    f32x4 gv[4];
#pragma unroll
    for (int j = 0; j < 4; ++j) gv[j] = *((const GAS f32x4*)gain + F.lane + 64 * j);
    for (int m = gw; m < M; m += NGW) { GAS f32x4* xr = (GAS f32x4*)(X + (size_t)m * DM) + F.lane; f32x4 v[4]; float s = 0.f;
#pragma unroll
        for (int j = 0; j < 4; ++j) { v[j] = xr[64 * j]; s += (v[j].x * v[j].x + v[j].y * v[j].y) + (v[j].z * v[j].z + v[j].w * v[j].w); }
        const float rs = 1.0f / sqrtf(wave_sum(s) * (1.0f / DM) + NORM_EPS);
#pragma unroll
        for (int j = 0; j < 4; ++j) xr[64 * j] = v[j] * rs * gv[j]; }
}

__device__ __forceinline__ void run_phase(Frame& F, int ph) {
    { int t_ = threadIdx.x; asm volatile("" : "+v"(t_)); F.tid = t_; F.lane = t_ & 63; F.wave = __builtin_amdgcn_readfirstlane(t_ >> 6); }
    unsigned char* ws = F.ap->ws; const int bid = (int)blockIdx.x;
    bf16* XB = (bf16*)(ws + WS_XB); bf16* A1 = (bf16*)(ws + WS_A1); bf16* A2 = (bf16*)(ws + WS_A2);
    float* SSQ = (float*)(ws + WS_SSQ); float* X = F.ap->out;
    const float* COS = (const float*)(ws + WS_COS); const float* SIN = (const float*)(ws + WS_SIN);
    LAS unsigned char* ring = F.lds + RING_OFF;
#ifndef MK_PHMASK
#define MK_PHMASK 0xFFFFF
#endif
#define PH_EN(k) ((MK_PHMASK >> (k)) & 1)
    if (PH_EN(0) && ph == 0) { p0_prologue(F); return; }
    if (PH_EN(19) && ph == 19) { final_norm_phase(F, X, INP(18)); return; }
    const bool pool = (ph >= 1 && ph <= 4) || (ph >= 15 && ph <= 18);
    const int j = ph >= 15 ? 1 : 0, pp = pool ? (ph >= 15 ? ph - 15 : ph - 1) : -1;
    unsigned char* wpool = ws + (j ? WS_WPOOL1 : WS_WPOOL0);
    if (PH_EN(1) && pool && pp == 0) {
        pg8::Gemm g{XB, (const bf16*)(wpool + WPOOL_IN), DM, DM, DM, 0, 0}; pg8::StaticOrder S; S.init(M, 4096, F.G, bid);
        epi::EpiPoolIn E{A1, A2, (bf16*)(ws + WS_HALO), SSQ};
        pg8::gemm_phase<epi::EpiPoolIn, pg8::StaticOrder, true>(ring, g, S, E); return; }
    if (PH_EN(2) && pool && pp == 1) { pool_mix_phase(F, A1, (const bf16*)(ws + WS_HALO)); return; }
    if (PH_EN(3) && pool && pp == 2) {
        pg8::Gemm g{A1, (const bf16*)(wpool + WPOOL_GRP), EI, 512, 512, 2, 512}; pg8::StaticOrder S; S.init(M, EI, F.G, bid);
        epi::EpiPoolGrp E{A2, INP(5) + j * EI};
        pg8::gemm_phase<epi::EpiPoolGrp, pg8::StaticOrder, true>(ring, g, S, E); return; }
    if (PH_EN(4) && ((pool && pp == 3) || ph == 7 || ph == 14)) {
        const bf16* Y = ph == 14 ? A1 : A2;
        const bf16* Wt = pool ? (const bf16*)(wpool + WPOOL_OUT) : ph == 7 ? (const bf16*)(ws + WS_WCONV_OUT) : (const bf16*)(ws + WS_WMLA_OUT);
        pg8::Gemm g{Y, Wt, EI, EI, EI, 0, 0}; pg8::StaticOrder S; S.init(M, DM, F.G, bid);
        epi::EpiResid E{ph == 4 ? INP(0) : (const float*)X, X, XB, SSQ};
        pg8::gemm_phase<epi::EpiResid, pg8::StaticOrder, false>(ring, g, S, E); return; }
    if (PH_EN(5) && ph == 5) {
        pg8::Gemm g{XB, (const bf16*)(ws + WS_WCONV_IN), DM, DM, DM, 0, 0}; pg8::StaticOrder S; S.init(M, 8192, F.G, bid);
        epi::EpiConvIn E{A1, A2, SSQ};
        pg8::gemm_phase<epi::EpiConvIn, pg8::StaticOrder, true>(ring, g, S, E); return; }
    if (PH_EN(6) && ph == 6) { conv_mix_phase(F, A1, A2, INP(9)); return; }
    bf16* KVLAT = (bf16*)(ws + WS_KVLAT); bf16* QLAT = (bf16*)(ws + WS_QLAT); bf16* KROPE = (bf16*)(ws + WS_KROPE); bf16* QR = (bf16*)(ws + WS_QR);
    float* SSQQ = (float*)(ws + WS_SSQQ); float* SSQKV = (float*)(ws + WS_SSQKV);
    if (PH_EN(8) && ph == 8) {
        pg8::Gemm g{XB, (const bf16*)(ws + WS_WMLA_B1), DM, DM, DM, 0, 0}; pg8::StaticOrder S; S.init(M, 768, F.G, bid);
        epi::EpiMlaIn E{KVLAT, QLAT, KROPE, SSQKV, SSQQ, SSQ, COS, SIN};
        pg8::gemm_phase<epi::EpiMlaIn, pg8::StaticOrder, false>(ring, g, S, E); return; }
    if (PH_EN(9) && (ph == 9 || ph == 11)) {
        const int hh = ph == 9 ? 0 : 1;
        { pg8::Gemm g{QLAT, (const bf16*)(ws + WS_WMLA_QUP) + (size_t)hh * 1536 * QL, QL, QL, QL, 0, 0}; pg8::StaticOrder S; S.init(M, 1536, F.G, bid);
          epi::EpiQUp E{A1, QR, SSQQ, COS, SIN, hh};
          pg8::gemm_phase<epi::EpiQUp, pg8::StaticOrder, true>(ring, g, S, E); }
        { pg8::Gemm g{KVLAT, (const bf16*)(ws + WS_WMLA_KVUP) + (size_t)hh * 2048 * KVL, KVL, KVL, KVL, 0, 0}; pg8::StaticOrder S; S.init(M, 2048, F.G, F.G - 1 - bid);
          epi::EpiKvUp E{A2, A2 + (size_t)M * 1024, SSQKV};
          pg8::gemm_phase<epi::EpiKvUp, pg8::StaticOrder, true>(ring, g, S, E); }
        return; }
    if (PH_EN(10) && (ph == 10 || ph == 12)) { att::attn_phase((char*)ring, ph == 10 ? 0 : 1, A1, QR, A2, A2 + (size_t)M * 1024, KROPE, A1, bid, F.G); return; }
    if (PH_EN(13) && ph == 13) {
        pg8::Gemm g{XB, (const bf16*)(ws + WS_WMLA_B1) + (size_t)768 * DM, DM, DM, DM, 0, 0}; pg8::StaticOrder S; S.init(M, EI, F.G, bid);
        epi::EpiGate E{A1, SSQ};
        pg8::gemm_phase<epi::EpiGate, pg8::StaticOrder, true>(ring, g, S, E); return; }
}

__global__ void __launch_bounds__(NWAVES * 64, 2) trunk_fwd(Args args) {
    extern __shared__ __attribute__((aligned(16))) unsigned char lds[];
    Frame F;
    F.lds = (LAS unsigned char*)lds; F.ap = &args;
    F.tid = threadIdx.x; F.lane = F.tid & 63; F.wave = __builtin_amdgcn_readfirstlane(F.tid >> 6);
    F.G = gridDim.x; { const int bx = blockIdx.x; F.vcu = (F.G % 8 == 0) ? (bx % 8) * (F.G / 8) + bx / 8 : bx; }
    for (int u = F.tid; u < (LDS_BYTES - LDSCTL_OFF) / 4; u += NWAVES * 64) ((LAS unsigned*)(F.lds + LDSCTL_OFF))[u] = 0u;
    __syncthreads();
    XcdBarrier bar; bar.bar = (unsigned*)(args.ws + WS_CTL) + CW_BAR; bar.x = 0; bar.st = nullptr;
    if (N_LAUNCHES == 1) bar = xcd_barrier_post((unsigned*)(args.ws + WS_CTL) + CW_BAR, (volatile LAS unsigned*)(F.lds + MISC_OFF) + 8);
    const int lo = args.ph_lo, hi = args.ph_hi;
#define PHASE(k) if (lo <= (k) && (k) < hi) { run_phase(F, (k)); if ((k) + 1 < hi) { if (N_LAUNCHES == 1) xcd_barrier(bar); } }
    PHASE(0)
    PHASE(1)
    PHASE(2)
    PHASE(3)
    PHASE(4)
    PHASE(5)
    PHASE(6)
    PHASE(7)
    PHASE(8)
    PHASE(9)
    PHASE(10)
    PHASE(11)
    PHASE(12)
    PHASE(13)
    PHASE(14)
    PHASE(15)
    PHASE(16)
    PHASE(17)
    PHASE(18)
    PHASE(19)
#undef PHASE
}


extern "C" void kernel_launch(void* const* d_in, const int* in_sizes, int n_in, void* d_out, int out_size, void* d_ws, size_t ws_size, hipStream_t stream) {
    static int grid = 0;
    if (grid == 0) {
        if (n_in != 19 || in_sizes[0] != M * DM || out_size != M * DM || ws_size < WS_END) {
            fprintf(stderr, "kernel_launch: built for 19 inputs, x/out of %d floats, >= %zu bytes of workspace; got n_in %d, in0 %d, out %d, ws %zu; nothing launched\n", M * DM, (size_t)WS_END, n_in, n_in > 0 ? in_sizes[0] : -1, out_size, ws_size);
            grid = -1; return; }
        int dev = 0, cus = 0;
        if (hipGetDevice(&dev) != hipSuccess || hipDeviceGetAttribute(&cus, hipDeviceAttributeMultiprocessorCount, dev) != hipSuccess) { fprintf(stderr, "kernel_launch: device query failed\n"); grid = -1; return; }
        if (hipFuncSetAttribute((const void*)trunk_fwd, hipFuncAttributeMaxDynamicSharedMemorySize, LDS_BYTES) != hipSuccess) { fprintf(stderr, "kernel_launch: hipFuncSetAttribute failed\n"); grid = -1; return; }
        int per_cu = 0;
        if (hipOccupancyMaxActiveBlocksPerMultiprocessor(&per_cu, (const void*)trunk_fwd, NWAVES * 64, LDS_BYTES) != hipSuccess || per_cu < 1)
            fprintf(stderr, "kernel_launch: note: occupancy query reports %d workgroups per CU\n", per_cu);
        (void)hipGetLastError();
        grid = cus;
    }
    if (grid < 0) return;
    if (hipMemsetAsync((char*)d_ws + WS_CTL, 0, CTL_ZERO_BYTES, stream) != hipSuccess) { fprintf(stderr, "kernel_launch: hipMemsetAsync failed\n"); return; }
    Args a{};
    for (int i = 0; i < 19; ++i) a.in[i] = d_in[i];
    a.out = (float*)d_out; a.ws = (unsigned char*)d_ws;
#if MK_DEBUG
    dbg_launch_all(a, grid, stream);
#else
    for (int li = 0; li < N_LAUNCHES; ++li) {
        a.ph_lo = (N_LAUNCHES == NPH) ? li : 0; a.ph_hi = (N_LAUNCHES == NPH) ? li + 1 : NPH;
        hipLaunchKernelGGL(trunk_fwd, dim3(grid), dim3(NWAVES * 64), LDS_BYTES, stream, a);
        const hipError_t le = hipPeekAtLastError();
        if (le != hipSuccess) { fprintf(stderr, "kernel_launch: launch %d failed: %s\n", li, hipGetErrorName(le)); break; }
    }
#endif
}
```

```cpp
#include <hip/hip_runtime.h>
#include <cstdio>
#include <cstdint>

#ifndef MK_N_LAUNCHES
#define MK_N_LAUNCHES 1
#endif
#ifndef MK_DEBUG
#define MK_DEBUG 0
#endif

constexpr int NB = 4, SEQ = 4096, DM = 1024, M = NB * SEQ, EI = 2048;
constexpr int QL = 384, KVL = 256, RD = 64, NHEAD = 16, DN = 128, DV = 128;
constexpr int MLA_IN = QL + KVL + RD + EI;
constexpr float NORM_EPS = 1e-6f;
constexpr float ATTN_SCALE = 0.07216878364870322f;
constexpr float ROPE_BASE = 10000.0f;

constexpr size_t MiB = 1u << 20;
constexpr size_t WS_CTL = 0, CTL_ZERO_BYTES = 1 * MiB;
constexpr size_t WS_SSQ = 1 * MiB;
constexpr size_t WS_SSQQ = 2 * MiB;
constexpr size_t WS_SSQKV = 2 * MiB + 512 * 1024;
constexpr size_t WS_DBG = 3 * MiB;
constexpr size_t WS_COS = 4 * MiB, WS_SIN = 6 * MiB;
constexpr size_t WS_HALO = 8 * MiB;
constexpr size_t WS_WCONV_IN = 12 * MiB;
constexpr size_t WS_WCONV_OUT = 28 * MiB;
constexpr size_t WS_WPOOL0 = 32 * MiB, WS_WPOOL1 = 46 * MiB;
constexpr size_t WPOOL_IN = 0, WPOOL_GRP = 8 * MiB, WPOOL_OUT = 10 * MiB;
constexpr size_t WS_WMLA_B1 = 60 * MiB;
constexpr size_t WS_WMLA_BZ = 62 * MiB;
constexpr size_t WS_WMLA_QUP = 66 * MiB;
constexpr size_t WS_WMLA_KVUP = 69 * MiB;
constexpr size_t WS_WMLA_OUT = 71 * MiB;
constexpr size_t WS_XB = 76 * MiB;
constexpr size_t WS_A1 = 108 * MiB;
constexpr size_t WS_A2 = 172 * MiB;
constexpr size_t WS_QLAT = 236 * MiB;
constexpr size_t WS_END = 248 * MiB;
constexpr size_t WS_QR = WS_WCONV_IN;
constexpr size_t WS_KVLAT = WS_WPOOL0;
constexpr size_t WS_KROPE = WS_WPOOL0 + 8 * MiB;

#define GAS __attribute__((address_space(1)))
#define LAS __attribute__((address_space(3)))
typedef unsigned short bf16;
typedef unsigned v4u __attribute__((ext_vector_type(4)));
typedef unsigned v2u __attribute__((ext_vector_type(2)));
typedef float f32x4 __attribute__((ext_vector_type(4)));
typedef float f32x2 __attribute__((ext_vector_type(2)));
typedef float f32x16 __attribute__((ext_vector_type(16)));
typedef short bf16x8 __attribute__((ext_vector_type(8)));
typedef short s16x4 __attribute__((ext_vector_type(4)));
typedef GAS unsigned gu32;
#define RLX_AGENT __ATOMIC_RELAXED, __HIP_MEMORY_SCOPE_AGENT
#define LDS_WAIT() asm volatile("s_waitcnt lgkmcnt(0)" ::: "memory")
#define VM_WAIT() asm volatile("s_waitcnt vmcnt(0)" ::: "memory")

__device__ __forceinline__ unsigned cvt_pk_bf16(float lo, float hi) { unsigned r; asm volatile("v_cvt_pk_bf16_f32 %0, %1, %2" : "=v"(r) : "v"(lo), "v"(hi)); return r; }
__device__ __forceinline__ float bf2f(unsigned short h) { return __uint_as_float((unsigned)h << 16); }
__device__ __forceinline__ float bflo(unsigned w) { return __uint_as_float(w << 16); }
__device__ __forceinline__ float bfhi(unsigned w) { return __uint_as_float(w & 0xffff0000u); }
__device__ __forceinline__ unsigned short f2bf_bits(float f) { return (unsigned short)(cvt_pk_bf16(f, 0.f) & 0xffffu); }
__device__ __forceinline__ v4u pack8(f32x4 a, f32x4 b) { v4u w; w.x = cvt_pk_bf16(a[0], a[1]); w.y = cvt_pk_bf16(a[2], a[3]); w.z = cvt_pk_bf16(b[0], b[1]); w.w = cvt_pk_bf16(b[2], b[3]); return w; }
__device__ __forceinline__ float silu_f(float z) { return z * __builtin_amdgcn_rcpf(1.0f + __builtin_amdgcn_exp2f(-1.4426950408889634f * z)); }
__device__ __forceinline__ f32x4 silu4(f32x4 z) { f32x4 r; r[0] = silu_f(z[0]); r[1] = silu_f(z[1]); r[2] = silu_f(z[2]); r[3] = silu_f(z[3]); return r; }
__device__ __forceinline__ float wave_sum(float v) {
#pragma unroll
    for (int o = 1; o < 64; o <<= 1) v += __shfl_xor(v, o);
    return v;
}
__device__ __forceinline__ float fq_sum(float s) { s += __shfl_xor(s, 16); s += __shfl_xor(s, 32); return s; }

namespace pg8 {
typedef unsigned short bf16_t;
constexpr int BM = 256, BK = 64, HALF = 128, HTB = HALF * BK * 2  , STAGE_BYTES = 8 * HTB, NXCD = 8, WGM = 8;

__host__ __device__ __forceinline__ int lds_byte(int r, int c) { const int st = (r >> 4) * 2 + (c >> 5), rr = r & 15, cc = c & 31, ob = rr * 64 + cc * 2; return st * 1024 + (ob ^ (((ob >> 9) & 1) << 5)); }
__host__ __device__ __forceinline__ void stage_rc(int b, int& R, int& C) { const int st = b / 1024, sb = b % 1024, swz = sb ^ (((sb >> 9) & 1) << 5); R = (st >> 1) * 16 + swz / 64; C = (st & 1) * 32 + (swz % 64) / 2; }
__host__ __device__ __forceinline__ int perm32(int rho) { const int n = rho >> 4, i = rho & 15; return 8 * (i >> 2) + 4 * n + (i & 3); }

struct Unit { int pm, pn; };
struct Gemm { const bf16_t* A; const bf16_t* Bt; int lda, ldb, K, agt, ags; };

struct StaticOrder {
    int nM, nN, nwg, G, c;
    __host__ __device__ void init(int M_, int N_, int G_, int c_) { nM = M_ / BM; nN = N_ / BM; nwg = nM * nN; G = G_; c = c_; }
    __host__ __device__ bool next(int i, Unit& u) const {
        const long L = (long)i * G + c; if (L >= nwg) return false;
        int wgid = (int)L; { const int q = nwg / NXCD, r = nwg % NXCD, xcd = wgid % NXCD, off = wgid / NXCD; wgid = (xcd < r ? xcd * (q + 1) : r * (q + 1) + (xcd - r) * q) + off; }
        const int nig = WGM * nN, gid = wgid / nig, fm = gid * WGM, gsz = (nM - fm) < WGM ? (nM - fm) : WGM;
        u.pm = fm + ((wgid % nig) % gsz); u.pn = (wgid % nig) / gsz; return true;
    }
};

template <class Epi, class Sched, bool ALIGN_EPI = false>
__device__ __forceinline__ void gemm_phase(LAS unsigned char* lds, const Gemm g, const Sched& S, const Epi& E) {
    int tid_ = threadIdx.x; asm volatile("" : "+v"(tid_));
    const int tid = tid_, wid = __builtin_amdgcn_readfirstlane(tid >> 6), lane = tid & 63, wr = wid >> 2, wc = wid & 3, fr = lane & 15, fq = lane >> 4;
    const int K = g.K, nt = K / BK;
    unsigned voffA[2], voffB[2];
#pragma unroll
    for (int i = 0; i < 2; ++i) { int R, C; stage_rc(tid * 16 + i * 8192, R, C); const int Rb = (R & ~31) + perm32(R & 31);
        voffA[i] = (unsigned)(R * g.lda + C) * 2u; voffB[i] = (unsigned)(Rb * g.ldb + C) * 2u; }
    const size_t kstep = (size_t)(BK * 2);
    const size_t hstepA = (size_t)HALF * g.lda * 2, hstepB = (size_t)HALF * g.ldb * 2;
    const unsigned ldsw = (unsigned)wid * 1024u;
    const int aoff = lds_byte(wr * 64 + fr, fq * 8), boff = lds_byte(wc * 32 + fr, fq * 8);
#define PG8_AOF(u) ((const char*)g.A + ((size_t)(u).pm * BM * g.lda + (g.agt ? (size_t)((u).pn / g.agt) * g.ags : (size_t)0)) * 2)
#define PG8_BOF(u) ((const char*)g.Bt + (size_t)(u).pn * BM * g.ldb * 2)
#define PG8_SA(b, h) (((b) * 2 + (h)) * HTB)
#define PG8_SB(b, h) ((4 + (b) * 2 + (h)) * HTB)
#define PG8_STAGE(bufoff, gbase, voff) do { _Pragma("unroll") for (int _i = 0; _i < 2; ++_i) \
        __builtin_amdgcn_global_load_lds((const unsigned*)((const char*)(gbase) + (voff)[_i]), (LAS unsigned*)(lds + (bufoff) + ldsw + _i * 8192), 16, 0, 0); } while (0)
#define PG8_LDA(dst, b, h) do { _Pragma("unroll") for (int m = 0; m < 4; ++m) _Pragma("unroll") for (int k = 0; k < 2; ++k) dst[m][k] = *(const LAS bf16x8*)(lds + PG8_SA(b, h) + aoff + m * 2048 + k * 1024); } while (0)
#define PG8_LDB(dst, b, h) do { _Pragma("unroll") for (int n = 0; n < 2; ++n) _Pragma("unroll") for (int k = 0; k < 2; ++k) dst[n][k] = *(const LAS bf16x8*)(lds + PG8_SB(b, h) + boff + n * 2048 + k * 1024); } while (0)
#define PG8_MMA(ai, bj, At, Bt) do { __builtin_amdgcn_s_setprio(1); _Pragma("unroll") for (int m = 0; m < 4; ++m) _Pragma("unroll") for (int n = 0; n < 2; ++n) _Pragma("unroll") for (int k = 0; k < 2; ++k) \
        acc[ai][bj][m][n] = __builtin_amdgcn_mfma_f32_16x16x32_bf16(Bt[n][k], At[m][k], acc[ai][bj][m][n], 0, 0, 0); __builtin_amdgcn_s_setprio(0); } while (0)
#define PG8_WAIT_V(n) asm volatile("s_waitcnt vmcnt(" #n ")" ::: "memory")
#define PG8_WAIT_L(n) asm volatile("s_waitcnt lgkmcnt(" #n ")" ::: "memory")
#define PG8_BAR __builtin_amdgcn_s_barrier()
#define PG8_SCHED __builtin_amdgcn_sched_barrier(0)
    Unit cur, nxt; int ui = 0;
    if (!S.next(0, cur)) return;
    f32x4 acc[2][2][4][2];
#pragma unroll
    for (int a = 0; a < 2; ++a)
#pragma unroll
        for (int b = 0; b < 2; ++b)
#pragma unroll
            for (int m = 0; m < 4; ++m)
#pragma unroll
                for (int n = 0; n < 2; ++n) acc[a][b][m][n] = (f32x4){0.f, 0.f, 0.f, 0.f};
    bf16x8 At[4][2], B0[2][2], B1[2][2];
    const char* cA = PG8_AOF(cur); const char* cB = PG8_BOF(cur);
    PG8_STAGE(PG8_SB(0, 0), cB, voffB); PG8_STAGE(PG8_SB(0, 1), cB + hstepB, voffB); PG8_STAGE(PG8_SA(0, 0), cA, voffA); PG8_STAGE(PG8_SA(0, 1), cA + hstepA, voffA);
    if (wr == 1) PG8_BAR;
    PG8_WAIT_V(2); PG8_BAR;
    PG8_STAGE(PG8_SB(1, 0), cB + kstep, voffB); PG8_STAGE(PG8_SA(1, 0), cA + kstep, voffA); PG8_STAGE(PG8_SB(1, 1), cB + hstepB + kstep, voffB);
    PG8_WAIT_V(6); PG8_BAR;
    for (;;) {
        const bool has_next = S.next(ui + 1, nxt);
        const char* nA = has_next ? PG8_AOF(nxt) : cA; const char* nB = has_next ? PG8_BOF(nxt) : cB;
#pragma nounroll
        for (int t = 0; t < nt; t += 2) {
            const bool last = (t == nt - 2);
            const char* a1 = cA + (size_t)(t + 1) * kstep;
            const char* a2 = last ? nA : cA + (size_t)(t + 2) * kstep; const char* b2 = last ? nB : cB + (size_t)(t + 2) * kstep;
            const char* a3 = a2 + kstep; const char* b3 = b2 + kstep;
            PG8_LDB(B0, 0, 0); PG8_LDB(B1, 0, 1); PG8_SCHED; PG8_LDA(At, 0, 0); PG8_STAGE(PG8_SA(1, 1), a1 + hstepA, voffA);
            PG8_WAIT_V(8); PG8_WAIT_L(0); PG8_BAR; PG8_MMA(0, 0, At, B0); PG8_MMA(0, 1, At, B1); PG8_BAR; PG8_SCHED;
            PG8_LDA(At, 0, 1); PG8_STAGE(PG8_SB(0, 0), b2, voffB); PG8_STAGE(PG8_SB(0, 1), b2 + hstepB, voffB); PG8_STAGE(PG8_SA(0, 0), a2, voffA);
            PG8_WAIT_V(8); PG8_WAIT_L(0); PG8_BAR; PG8_MMA(1, 0, At, B0); PG8_MMA(1, 1, At, B1); PG8_BAR; PG8_SCHED;
            PG8_LDB(B0, 1, 0); PG8_LDB(B1, 1, 1); PG8_SCHED; PG8_LDA(At, 1, 0); PG8_STAGE(PG8_SA(0, 1), a2 + hstepA, voffA);
            PG8_WAIT_V(8); PG8_WAIT_L(0); PG8_BAR; PG8_MMA(0, 0, At, B0); PG8_MMA(0, 1, At, B1); PG8_BAR; PG8_SCHED;
            PG8_LDA(At, 1, 1); PG8_STAGE(PG8_SB(1, 0), b3, voffB); PG8_STAGE(PG8_SB(1, 1), b3 + hstepB, voffB); PG8_STAGE(PG8_SA(1, 0), a3, voffA);
            PG8_WAIT_V(8); PG8_WAIT_L(0); PG8_BAR; PG8_MMA(1, 0, At, B0); PG8_MMA(1, 1, At, B1); PG8_BAR; PG8_SCHED;
        }
        if constexpr (ALIGN_EPI) { if (wr == 0) PG8_BAR; }
        E(acc, cur, wr, wc, fr, fq);
        if (!has_next) break;
#pragma unroll
        for (int a = 0; a < 2; ++a)
#pragma unroll
            for (int b = 0; b < 2; ++b)
#pragma unroll
                for (int m = 0; m < 4; ++m)
#pragma unroll
                    for (int n = 0; n < 2; ++n) acc[a][b][m][n] = (f32x4){0.f, 0.f, 0.f, 0.f};
        cur = nxt; cA = nA; cB = nB; ++ui;
        if constexpr (ALIGN_EPI) { if (wr == 1) PG8_BAR; }
    }
    PG8_WAIT_V(0);
    if constexpr (!ALIGN_EPI) { if (wr == 0) PG8_BAR; }
    PG8_BAR;
#undef PG8_AOF
#undef PG8_BOF
#undef PG8_SA
#undef PG8_SB
#undef PG8_STAGE
#undef PG8_LDA
#undef PG8_LDB
#undef PG8_MMA
#undef PG8_WAIT_V
#undef PG8_WAIT_L
#undef PG8_BAR
#undef PG8_SCHED
}
}

namespace epi {
using pg8::Unit; using pg8::BM; using pg8::HALF;
typedef f32x4 Acc[2][2][4][2];
__device__ __forceinline__ float sq8(f32x4 a, f32x4 b) { return (a[0] * a[0] + a[1] * a[1]) + (a[2] * a[2] + a[3] * a[3]) + (b[0] * b[0] + b[1] * b[1]) + (b[2] * b[2] + b[3] * b[3]); }
#define EPI_ROW(g) (row0 + ((g) >> 2) * HALF + ((g) & 3) * 16)
__device__ __forceinline__ void rstd16x8(float (&rs)[8], const float* SSQ, int row0, int fq, float inv_n) {
    f32x4 v[8];
#pragma unroll
    for (int g = 0; g < 8; ++g) v[g] = *(const f32x4*)(SSQ + (size_t)EPI_ROW(g) * 16 + fq * 4);
#pragma unroll
    for (int g = 0; g < 8; ++g) rs[g] = 1.0f / sqrtf(fq_sum((v[g][0] + v[g][1]) + (v[g][2] + v[g][3])) * inv_n + NORM_EPS);
}

struct EpiPoolIn {
    bf16* U; bf16* SZ; bf16* HALO; const float* SSQ;
    __device__ __forceinline__ void operator()(const Acc& acc, const Unit& u, int wr, int wc, int fr, int fq) const {
        const int row0 = u.pm * BM + wr * 64 + fr; const bool isz = u.pn >= 8; const int colt = (u.pn & 7) * BM + wc * 32 + 8 * fq;
        float rs[8]; rstd16x8(rs, SSQ, row0, fq, 1.0f / DM);
#pragma unroll
        for (int g = 0; g < 8; ++g) { const int ai = g >> 2, m = g & 3; const int row = EPI_ROW(g);
#pragma unroll
            for (int bj = 0; bj < 2; ++bj) { f32x4 v0 = acc[ai][bj][m][0] * rs[g], v1 = acc[ai][bj][m][1] * rs[g]; const int col = colt + bj * HALF;
                if (isz) { v0 = silu4(v0); v1 = silu4(v1); *(v4u*)(SZ + (size_t)row * EI + col) = pack8(v0, v1); }
                else { const v4u w = pack8(v0, v1); *(v4u*)(U + (size_t)row * EI + col) = w;
                    if (g == 7 && wr == 1) *(v4u*)(HALO + ((size_t)u.pm * 16 + fr) * EI + col) = w; } } }
    }
};
struct EpiPoolGrp {
    bf16* Y; const float* scale;
    __device__ __forceinline__ void operator()(const Acc& acc, const Unit& u, int wr, int wc, int fr, int fq) const {
        const int row0 = u.pm * BM + wr * 64 + fr; const int colt = u.pn * BM + wc * 32 + 8 * fq;
        f32x4 sc[2][2];
#pragma unroll
        for (int bj = 0; bj < 2; ++bj) { sc[bj][0] = *(const f32x4*)(scale + colt + bj * HALF); sc[bj][1] = *(const f32x4*)(scale + colt + bj * HALF + 4); }
#pragma unroll
        for (int ai = 0; ai < 2; ++ai) { v4u s[4][2];
#pragma unroll
            for (int m = 0; m < 4; ++m)
#pragma unroll
                for (int bj = 0; bj < 2; ++bj) s[m][bj] = *(const v4u*)(Y + (size_t)EPI_ROW(4 * ai + m) * EI + colt + bj * HALF);
#pragma unroll
            for (int m = 0; m < 4; ++m)
#pragma unroll
                for (int bj = 0; bj < 2; ++bj) { const v4u z = s[m][bj];
                    f32x4 v0 = acc[ai][bj][m][0] * sc[bj][0], v1 = acc[ai][bj][m][1] * sc[bj][1];
                    v0 = v0 * (f32x4){bflo(z.x), bfhi(z.x), bflo(z.y), bfhi(z.y)}; v1 = v1 * (f32x4){bflo(z.z), bfhi(z.z), bflo(z.w), bfhi(z.w)};
                    *(v4u*)(Y + (size_t)EPI_ROW(4 * ai + m) * EI + colt + bj * HALF) = pack8(v0, v1); }
            asm volatile("" ::: "memory"); }
    }
};
struct EpiResid {
    const float* Xin; float* Xout; bf16* XB; float* SSQ;
    __device__ __forceinline__ void operator()(const Acc& acc, const Unit& u, int wr, int wc, int fr, int fq) const {
        const int row0 = u.pm * BM + wr * 64 + fr; const int colt = u.pn * BM + wc * 32 + 8 * fq;
#pragma unroll
        for (int ai = 0; ai < 2; ++ai) { f32x4 x[4][2][2];
#pragma unroll
            for (int m = 0; m < 4; ++m)
#pragma unroll
                for (int bj = 0; bj < 2; ++bj) { const size_t off = (size_t)EPI_ROW(4 * ai + m) * DM + colt + bj * HALF; x[m][bj][0] = *(const f32x4*)(Xin + off); x[m][bj][1] = *(const f32x4*)(Xin + off + 4); }
#pragma unroll
            for (int m = 0; m < 4; ++m) { const int row = EPI_ROW(4 * ai + m); float ss = 0.f;
#pragma unroll
                for (int bj = 0; bj < 2; ++bj) { const size_t off = (size_t)row * DM + colt + bj * HALF;
                    const f32x4 v0 = x[m][bj][0] + acc[ai][bj][m][0], v1 = x[m][bj][1] + acc[ai][bj][m][1];
                    *(f32x4*)(Xout + off) = v0; *(f32x4*)(Xout + off + 4) = v1; *(v4u*)(XB + off) = pack8(v0, v1); ss += sq8(v0, v1); }
                ss = fq_sum(ss); if (fq == 0) SSQ[(size_t)row * 16 + u.pn * 4 + wc] = ss; }
            asm volatile("" ::: "memory"); }
    }
};
struct EpiConvIn {
    bf16* CH; bf16* BZ; const float* SSQ;
    __device__ __forceinline__ void operator()(const Acc& acc, const Unit& u, int wr, int wc, int fr, int fq) const {
        const int row0 = u.pm * BM + wr * 64 + fr; const int j0 = u.pn * 64 + (wc & 1) * 32 + 8 * fq; const bool isch = wc >= 2;
        float rs[8]; rstd16x8(rs, SSQ, row0, fq, 1.0f / DM);
#pragma unroll
        for (int g = 0; g < 8; ++g) { const int ai = g >> 2, m = g & 3; const int row = EPI_ROW(g); const float r = rs[g];
            const f32x4 p0 = acc[ai][0][m][0] * r, p1 = acc[ai][0][m][1] * r, q0 = acc[ai][1][m][0] * r, q1 = acc[ai][1][m][1] * r;
            if (isch) *(v4u*)(CH + (size_t)row * EI + j0) = pack8(p0 * q0, p1 * q1);
            else *(v4u*)(BZ + (size_t)row * EI + j0) = pack8(p0 * silu4(q0), p1 * silu4(q1)); }
    }
};
__device__ __forceinline__ v4u rope8v(f32x4 x1, f32x4 x2, f32x4 c, f32x4 s) { return pack8(x1 * c - x2 * s, x2 * c + x1 * s); }
struct EpiMlaIn {
    bf16* KVLAT; bf16* QLAT; bf16* KROPE; float* SSQKV; float* SSQQ; const float* SSQ; const float* COS; const float* SIN;
    __device__ __forceinline__ void operator()(const Acc& acc, const Unit& u, int wr, int wc, int fr, int fq) const {
        const int row0 = u.pm * BM + wr * 64 + fr; const int cl = wc * 32 + 8 * fq;
        float rs[8]; rstd16x8(rs, SSQ, row0, fq, 1.0f / DM);
        const bool dorope = u.pn == 2 && wc < 2; const int ii = 16 * (wc & 1) + 4 * fq;
#pragma unroll
        for (int ai = 0; ai < 2; ++ai) { f32x4 cs[4][2];
            if (dorope) {
#pragma unroll
                for (int m = 0; m < 4; ++m) { const size_t ro = (size_t)EPI_ROW(4 * ai + m) * 32 + ii; cs[m][0] = *(const f32x4*)(COS + ro); cs[m][1] = *(const f32x4*)(SIN + ro); } }
#pragma unroll
            for (int m = 0; m < 4; ++m) { const int row = EPI_ROW(4 * ai + m); const float r = rs[4 * ai + m];
                const f32x4 a0 = acc[ai][0][m][0] * r, a1 = acc[ai][0][m][1] * r, b0 = acc[ai][1][m][0] * r, b1 = acc[ai][1][m][1] * r;
                if (u.pn == 0) { *(v4u*)(KVLAT + (size_t)row * KVL + cl) = pack8(a0, a1); *(v4u*)(KVLAT + (size_t)row * KVL + HALF + cl) = pack8(b0, b1);
                    const float ss = fq_sum(sq8(a0, a1) + sq8(b0, b1)); if (fq == 0) SSQKV[(size_t)row * 4 + wc] = ss; }
                else if (u.pn == 1) { *(v4u*)(QLAT + (size_t)row * QL + cl) = pack8(a0, a1); *(v4u*)(QLAT + (size_t)row * QL + HALF + cl) = pack8(b0, b1);
                    const float ss = fq_sum(sq8(a0, a1) + sq8(b0, b1)); if (fq == 0) SSQQ[(size_t)row * 8 + wc] = ss; }
                else { *(v4u*)(QLAT + (size_t)row * QL + 256 + cl) = pack8(a0, a1);
                    const float ss = fq_sum(sq8(a0, a1)); if (fq == 0) SSQQ[(size_t)row * 8 + 4 + wc] = ss;
                    if (dorope) *(v4u*)(KROPE + (size_t)row * RD + cl) = rope8v(b0, b1, cs[m][0], cs[m][1]); } }
            asm volatile("" ::: "memory"); }
    }
};
struct EpiQUp {
    bf16* QN; bf16* QR; const float* SSQQ; const float* COS; const float* SIN; int hh;
    __device__ __forceinline__ void operator()(const Acc& acc, const Unit& u, int wr, int wc, int fr, int fq) const {
        const int row0 = u.pm * BM + wr * 64 + fr; const int cl = wc * 32 + 8 * fq;
        float rs[8];
        { f32x2 pq[8];
#pragma unroll
          for (int g = 0; g < 8; ++g) pq[g] = *(const f32x2*)(SSQQ + (size_t)EPI_ROW(g) * 8 + fq * 2);
#pragma unroll
          for (int g = 0; g < 8; ++g) rs[g] = 1.0f / sqrtf(fq_sum(pq[g][0] + pq[g][1]) * (1.0f / QL) + NORM_EPS); }
        const bool isr = u.pn >= 4; const int ii = 16 * (wc & 1) + 4 * fq;
#pragma unroll
        for (int ai = 0; ai < 2; ++ai) { f32x4 cs[4][2];
            if (isr) {
#pragma unroll
                for (int m = 0; m < 4; ++m) { const size_t ro = (size_t)EPI_ROW(4 * ai + m) * 32 + ii; cs[m][0] = *(const f32x4*)(COS + ro); cs[m][1] = *(const f32x4*)(SIN + ro); } }
#pragma unroll
            for (int m = 0; m < 4; ++m) { const int row = EPI_ROW(4 * ai + m); const float r = rs[4 * ai + m];
#pragma unroll
                for (int bj = 0; bj < 2; ++bj) { const f32x4 v0 = acc[ai][bj][m][0] * r, v1 = acc[ai][bj][m][1] * r;
                    if (!isr) *(v4u*)(QN + (size_t)row * EI + hh * 1024 + u.pn * BM + bj * HALF + cl) = pack8(v0, v1);
                    else { const int hl = (u.pn - 4) * 4 + 2 * bj + (wc >> 1);
                        *(v4u*)(QR + (size_t)row * 512 + hl * RD + 32 * (wc & 1) + 8 * fq) = rope8v(v0, v1, cs[m][0], cs[m][1]); } } }
            asm volatile("" ::: "memory"); }
    }
};
struct EpiKvUp {
    bf16* KN; bf16* V; const float* SSQKV;
    __device__ __forceinline__ void operator()(const Acc& acc, const Unit& u, int wr, int wc, int fr, int fq) const {
        const int row0 = u.pm * BM + wr * 64 + fr; const int cl = u.pn * DN + wc * 32 + 8 * fq;
        float rs[8];
#pragma unroll
        for (int g = 0; g < 8; ++g) rs[g] = SSQKV[(size_t)EPI_ROW(g) * 4 + fq];
#pragma unroll
        for (int g = 0; g < 8; ++g) rs[g] = 1.0f / sqrtf(fq_sum(rs[g]) * (1.0f / KVL) + NORM_EPS);
#pragma unroll
        for (int g = 0; g < 8; ++g) { const int ai = g >> 2, m = g & 3; const int row = EPI_ROW(g);
            *(v4u*)(KN + (size_t)row * 1024 + cl) = pack8(acc[ai][0][m][0] * rs[g], acc[ai][0][m][1] * rs[g]);
            *(v4u*)(V + (size_t)row * 1024 + cl) = pack8(acc[ai][1][m][0] * rs[g], acc[ai][1][m][1] * rs[g]); }
    }
};
struct EpiGate {
    bf16* Y; const float* SSQ;
    __device__ __forceinline__ void operator()(const Acc& acc, const Unit& u, int wr, int wc, int fr, int fq) const {
        const int row0 = u.pm * BM + wr * 64 + fr; const int colt = u.pn * BM + wc * 32 + 8 * fq;
        float rs[8]; rstd16x8(rs, SSQ, row0, fq, 1.0f / DM);
#pragma unroll
        for (int ai = 0; ai < 2; ++ai) { v4u s[4][2];
#pragma unroll
            for (int m = 0; m < 4; ++m)
#pragma unroll
                for (int bj = 0; bj < 2; ++bj) s[m][bj] = *(const v4u*)(Y + (size_t)EPI_ROW(4 * ai + m) * EI + colt + bj * HALF);
#pragma unroll
            for (int m = 0; m < 4; ++m)
#pragma unroll
                for (int bj = 0; bj < 2; ++bj) { const v4u z = s[m][bj]; const float r = rs[4 * ai + m];
                    const f32x4 v0 = silu4(acc[ai][bj][m][0] * r) * (f32x4){bflo(z.x), bfhi(z.x), bflo(z.y), bfhi(z.y)};
                    const f32x4 v1 = silu4(acc[ai][bj][m][1] * r) * (f32x4){bflo(z.z), bfhi(z.z), bflo(z.w), bfhi(z.w)};
                    *(v4u*)(Y + (size_t)EPI_ROW(4 * ai + m) * EI + colt + bj * HALF) = pack8(v0, v1); }
            asm volatile("" ::: "memory"); }
    }
};
#undef EPI_ROW
}

namespace att {
constexpr int NW = 8, QBLK = 32, KVBLK = 64, QB = NW * QBLK, D = 128;
constexpr int PQN = 2048, PQR = 512, PKV = 1024, PKR = 64;
constexpr int SHM_V = KVBLK * D * 2, SHM_K = KVBLK * D * 2, KR_ROWB = 144, SHM_KR = KVBLK * KR_ROWB;
constexpr int OFF_K = 2 * SHM_V, OFF_KR = 2 * SHM_V + 2 * SHM_K, OFF_WS = OFF_KR + 2 * SHM_KR;
constexpr int OFF_QRL = OFF_WS + NW * 64 * 4;
constexpr int NQREG = 4;
constexpr int QRL_WAVE = (12 - NQREG) * 1024;
constexpr int LDS_BYTES = OFF_QRL + NW * QRL_WAVE;
constexpr float SCALE = ATTN_SCALE;
constexpr float THR = 8.f;
#define KSWZ(row, colB) ((row) * 256 + ((colB) ^ (((row) & 7) << 4)))
#define SBAR() __builtin_amdgcn_sched_barrier(0)
__device__ __forceinline__ int v_st(int k, int c) { const int kk = (k & ~0xC) | ((k & 4) << 1) | ((k & 8) >> 1); return ((kk >> 3) * 4 + (c >> 5)) * 512 + ((kk & 7) * 32 + (c & 31)) * 2; }
__device__ __forceinline__ int v_rd_base(int lane) { return ((lane & 3) << 3) | (((lane >> 2) & 3) << 6) | (((lane >> 4) & 1) << 5) | (((lane >> 5) & 1) << 8); }
constexpr int v_rd_off(int d0, int ks, int half) { return d0 * 512 + ks * 4096 + half * 2048; }
__device__ __forceinline__ int crow(int r, int hi) { return (r & 3) + 8 * (r >> 2) + 4 * hi; }
__device__ __forceinline__ unsigned cvtpk(float lo, float hi) { unsigned r; asm volatile("v_cvt_pk_bf16_f32 %0, %1, %2" : "=v"(r) : "v"(lo), "v"(hi)); return r; }
__device__ __forceinline__ bf16x8 load8(const bf16* p) { return *reinterpret_cast<const bf16x8*>(p); }
__device__ __forceinline__ void mask_tile(f32x16& p0, f32x16& p1, int dq) {
    const float NEG = -__builtin_inff();
#pragma unroll
    for (int r = 0; r < 16; ++r) {
        const int c = (r & 3) + 8 * (r >> 2);
        if (dq - c < 0) p0[r] = NEG;
        if (dq - c - 32 < 0) p1[r] = NEG;
    }
}
__device__ __forceinline__ void partialSM(f32x16& p0, f32x16& p1, float& m_reg, float& mn, float& alpha) {
    float pmax = p0[0]; for (int r = 1; r < 16; ++r) pmax = fmaxf(pmax, p0[r]); for (int r = 0; r < 16; ++r) pmax = fmaxf(pmax, p1[r]);
    { auto rr = __builtin_amdgcn_permlane32_swap(__float_as_uint(pmax), __float_as_uint(pmax), false, false);
      pmax = fmaxf(__uint_as_float(rr[0]), __uint_as_float(rr[1])); }
    constexpr float C2 = 1.4426950408889634f * SCALE;
    if (__builtin_expect(__all((pmax - m_reg) * SCALE <= THR), 1)) { mn = m_reg; alpha = 1.f; }
    else { mn = fmaxf(m_reg, pmax); alpha = __builtin_amdgcn_exp2f((m_reg - mn) * C2); m_reg = mn; }
    const float mnL = -mn * C2;
    for (int r = 0; r < 16; ++r) p0[r] = fmaf(p0[r], C2, mnL); for (int r = 0; r < 16; ++r) p1[r] = fmaf(p1[r], C2, mnL);
    for (int r = 0; r < 16; ++r) p0[r] = __builtin_amdgcn_exp2f(p0[r]);
}
__device__ __forceinline__ void finishSM(f32x16& p0, f32x16& p1, float alpha, float& l_reg, bf16x8& pa0, bf16x8& pa1, bf16x8& pa2, bf16x8& pa3) {
    for (int r = 0; r < 16; ++r) p1[r] = __builtin_amdgcn_exp2f(p1[r]);
    float ps = 0; for (int r = 0; r < 16; ++r) ps += p0[r]; for (int r = 0; r < 16; ++r) ps += p1[r];
    { auto rr = __builtin_amdgcn_permlane32_swap(__float_as_uint(ps), __float_as_uint(ps), false, false);
      ps = __uint_as_float(rr[0]) + __uint_as_float(rr[1]); }
    l_reg = l_reg * alpha + ps;
#define PK4(P, B_, OUT) do { unsigned a0 = cvtpk(P[B_+0], P[B_+1]), a1 = cvtpk(P[B_+2], P[B_+3]);                          \
        unsigned b0 = cvtpk(P[B_+4], P[B_+5]), b1 = cvtpk(P[B_+6], P[B_+7]);                                             \
        auto r0 = __builtin_amdgcn_permlane32_swap(a0, b0, false, false); auto r1 = __builtin_amdgcn_permlane32_swap(a1, b1, false, false); \
        v4u w = {r0[0], r1[0], r0[1], r1[1]}; OUT = *reinterpret_cast<bf16x8*>(&w); } while (0)
    PK4(p0, 0, pa0); PK4(p0, 8, pa1); PK4(p1, 0, pa2); PK4(p1, 8, pa3);
#undef PK4
}
template <int KB>
__device__ __forceinline__ void qkt(f32x16& p0, f32x16& p1, const char* lds, int r32, int hi, const bf16x8* qr, const char* qrl) {
    p0 = f32x16{}; p1 = f32x16{};
    const char* kb[4];
#pragma unroll
    for (int dd = 0; dd < 4; ++dd) kb[dd] = lds + OFF_K + KB * SHM_K + KSWZ(r32, (dd * 16 + hi * 8) * 2);
#pragma unroll
    for (int d0 = 0; d0 < 8; ++d0) { const char* a = kb[d0 & 3] + (d0 >> 2) * 128;
        bf16x8 b0 = *reinterpret_cast<const bf16x8*>(a);
        bf16x8 b1 = *reinterpret_cast<const bf16x8*>(a + 32 * 256);
        bf16x8 qf; if (d0 < NQREG) qf = qr[d0]; else qf = *reinterpret_cast<const bf16x8*>(qrl + (4 + d0 - NQREG) * 1024);
        p0 = __builtin_amdgcn_mfma_f32_32x32x16_bf16(b0, qf, p0, 0, 0, 0);
        p1 = __builtin_amdgcn_mfma_f32_32x32x16_bf16(b1, qf, p1, 0, 0, 0); }
    const char* kr = lds + OFF_KR + KB * SHM_KR + r32 * KR_ROWB + hi * 16;
#pragma unroll
    for (int d0 = 0; d0 < 4; ++d0) {
        bf16x8 b0 = *reinterpret_cast<const bf16x8*>(kr + d0 * 32);
        bf16x8 b1 = *reinterpret_cast<const bf16x8*>(kr + d0 * 32 + 32 * KR_ROWB);
        const bf16x8 qf = *reinterpret_cast<const bf16x8*>(qrl + d0 * 1024);
        p0 = __builtin_amdgcn_mfma_f32_32x32x16_bf16(b0, qf, p0, 0, 0, 0);
        p1 = __builtin_amdgcn_mfma_f32_32x32x16_bf16(b1, qf, p1, 0, 0, 0); }
}
template <int VB>
__device__ __forceinline__ void pv_tile(f32x16* o, int vb0, bf16x8 pa0, bf16x8 pa1, bf16x8 pa2, bf16x8 pa3) {
#define TRRD(dst, off) asm volatile("ds_read_b64_tr_b16 %0, %1 offset:%2" : "=&v"(dst) : "v"(vb0), "i"(off) : "memory")
#define PV_D0(d0) do { s16x4 l0, l1, l2, l3, h0, h1, h2, h3; constexpr int b_ = VB * SHM_V + v_rd_off(d0, 0, 0); \
        TRRD(l0, b_); TRRD(h0, b_ + 2048); TRRD(l1, b_ + 4096); TRRD(h1, b_ + 6144); TRRD(l2, b_ + 8192); TRRD(h2, b_ + 10240); TRRD(l3, b_ + 12288); TRRD(h3, b_ + 14336); \
        asm volatile("s_waitcnt lgkmcnt(0)" ::: "memory"); SBAR();   \
        o[d0] = __builtin_amdgcn_mfma_f32_32x32x16_bf16(pa0, (bf16x8){l0[0], l0[1], l0[2], l0[3], h0[0], h0[1], h0[2], h0[3]}, o[d0], 0, 0, 0);   \
        o[d0] = __builtin_amdgcn_mfma_f32_32x32x16_bf16(pa1, (bf16x8){l1[0], l1[1], l1[2], l1[3], h1[0], h1[1], h1[2], h1[3]}, o[d0], 0, 0, 0);   \
        o[d0] = __builtin_amdgcn_mfma_f32_32x32x16_bf16(pa2, (bf16x8){l2[0], l2[1], l2[2], l2[3], h2[0], h2[1], h2[2], h2[3]}, o[d0], 0, 0, 0);   \
        o[d0] = __builtin_amdgcn_mfma_f32_32x32x16_bf16(pa3, (bf16x8){l3[0], l3[1], l3[2], l3[3], h3[0], h3[1], h3[2], h3[3]}, o[d0], 0, 0, 0); } while (0)
    PV_D0(0); PV_D0(1); PV_D0(2); PV_D0(3);
#undef PV_D0
#undef TRRD
}
struct BlockRef { const bf16* Q; const bf16* QR; const bf16* K; const bf16* V; const bf16* KR; bf16* O; int P0; };
struct Seam { bf16x8 qr[NQREG]; bf16x8 st_v0, st_v1, st_k0, st_k1, st_kr; };
#define ROWKV(p, k0, rr) ((p) + (size_t)((k0) + (rr)) * PKV + sc)
#define VMW() asm volatile("s_waitcnt vmcnt(0)" ::: "memory")
#define VMWN(n) asm volatile("s_waitcnt vmcnt(%0)" :: "i"(n) : "memory")
#define SLOAD_H(Kp, Vp, KRp, k0) do { S.st_v0 = load8(ROWKV(Vp, k0, sr)); S.st_v1 = load8(ROWKV(Vp, k0, 32 + sr));              \
                         S.st_k0 = load8(ROWKV(Kp, k0, sr)); S.st_k1 = load8(ROWKV(Kp, k0, 32 + sr)); S.st_kr = load8((KRp) + (size_t)((k0) + krr) * PKR + krc); } while (0)
#define SWRITE_HK(bf) do { *(bf16x8*)(K_lds + (bf) * SHM_K + kws) = S.st_k0; *(bf16x8*)(K_lds + (bf) * SHM_K + kws + 32 * 256) = S.st_k1; *(bf16x8*)(KR_lds + (bf) * SHM_KR + krws) = S.st_kr; } while (0)
#define SWRITE_HV(bf) do { *(bf16x8*)(V_lds + (bf) * SHM_V + vst0) = S.st_v0; *(bf16x8*)(V_lds + (bf) * SHM_V + vst1) = S.st_v1; } while (0)
#define SWRITE_H(bf) do { SWRITE_HV(bf); SWRITE_HK(bf); } while (0)
#define QLOAD(R) do { _Pragma("unroll") for (int d0 = 0; d0 < NQREG; ++d0) S.qr[d0] = load8((R).Q + (size_t)(wid * QBLK + r32) * PQN + d0 * 16 + hi * 8); } while (0)
#define QRLOAD(R) do { _Pragma("unroll") for (int d0 = 0; d0 < 4; ++d0) *(bf16x8*)(qrl + d0 * 1024) = load8((R).QR + (size_t)(wid * QBLK + r32) * PQR + d0 * 16 + hi * 8); \
                       _Pragma("unroll") for (int d0 = NQREG; d0 < 8; ++d0) *(bf16x8*)(qrl + (4 + d0 - NQREG) * 1024) = load8((R).Q + (size_t)(wid * QBLK + r32) * PQN + d0 * 16 + hi * 8); } while (0)
__device__ __forceinline__ void attn_prime(const BlockRef& cur, char* lds, Seam& S) {
    int tid_ = threadIdx.x; asm volatile("" : "+v"(tid_));
    const int tid = tid_, wid = __builtin_amdgcn_readfirstlane(tid >> 6), lane = tid & 63, r32 = lane & 31, hi = lane >> 5;
    const int sr = tid >> 4, sc = (tid & 15) * 8, kws = KSWZ(sr, sc * 2); char* K_lds = lds + OFF_K; char* KR_lds = lds + OFF_KR;
    const int krr = tid >> 3, krc = (tid & 7) * 8, krws = krr * KR_ROWB + krc * 2;
    char* qrl = lds + OFF_QRL + wid * QRL_WAVE + lane * 16;
    QLOAD(cur); QRLOAD(cur);
    SLOAD_H(cur.K, cur.V, cur.KR, 0); VMW(); SWRITE_HK(0);
    __syncthreads();
}
__device__ __forceinline__ void attn_block(const BlockRef& cur, const BlockRef& nxt, char* lds, Seam& S) {
    int tid_ = threadIdx.x; asm volatile("" : "+v"(tid_));
    const int tid = tid_, wid = __builtin_amdgcn_readfirstlane(tid >> 6), lane = tid & 63, r32 = lane & 31, hi = lane >> 5;
    const int NT = (cur.P0 + QB) / KVBLK;
    const int qlo = cur.P0 + wid * QBLK, qm = qlo + r32 - 4 * hi;
    char* V_lds = lds; char* K_lds = lds + OFF_K; char* KR_lds = lds + OFF_KR;
    float* ws = (float*)(lds + OFF_WS) + wid * 64; float* li_l = ws, * al_l = ws + 32;
    float m_reg = -1e30f, l_reg = 0; f32x16 o[4] = {};
    const int sr = tid >> 4, sc = (tid & 15) * 8, vst0 = v_st(sr, sc), vst1 = v_st(32 + sr, sc), kws = KSWZ(sr, sc * 2);
    const int krr = tid >> 3, krc = (tid & 7) * 8, krws = krr * KR_ROWB + krc * 2;
    const int vb0 = (int)(uintptr_t)V_lds + v_rd_base(lane);
    char* qrl = lds + OFF_QRL + wid * QRL_WAVE + lane * 16;
    const bf16* Kh = cur.K; const bf16* Vh = cur.V; const bf16* KRh = cur.KR;
#define RESC(a) do { if (__any((a) < 1.f)) { if (hi == 0) al_l[r32] = (a); asm volatile("s_waitcnt lgkmcnt(0)" ::: "memory");              \
                     for (int d_ = 0; d_ < 4; ++d_) for (int r = 0; r < 16; ++r) o[d_][r] *= al_l[crow(r, hi)]; } } while (0)
#define KBASE(t) ((t) * KVBLK)
#define MASKT(P0_, P1_, t) do { const int kb_ = KBASE(t); if (kb_ + KVBLK - 1 > qlo) mask_tile(P0_, P1_, qm - kb_); } while (0)
    constexpr int NQL = NQREG;
#define SEAM_K0() do { VMWN(NQL); SWRITE_HK(0); SBAR(); } while (0)
    f32x16 pA0, pA1, pB0, pB1; float mnA, mnB, alA, alB; bf16x8 pa0, pa1, pa2, pa3;
    SWRITE_HV(0); SBAR();
    if (NT > 1) { SLOAD_H(Kh, Vh, KRh, KBASE(1)); }
    SBAR(); qkt<0>(pA0, pA1, lds, r32, hi, S.qr, qrl);
    MASKT(pA0, pA1, 0); partialSM(pA0, pA1, m_reg, mnA, alA);
    if (NT > 1) { VMW(); SWRITE_H(1); }
    __syncthreads();
#define HALF_STEP(PX0, PX1, mnX, alX, PY0, PY1, alY, t, KB, VB, SB) do {                                                      \
        SBAR(); qkt<KB>(PX0, PX1, lds, r32, hi, S.qr, qrl);                                             \
        finishSM(PY0, PY1, alY, l_reg, pa0, pa1, pa2, pa3); SBAR();                                                           \
        if ((t) + 1 < NT) { SLOAD_H(Kh, Vh, KRh, KBASE((t) + 1)); SBAR(); }                                               \
        pv_tile<VB>(o, vb0, pa0, pa1, pa2, pa3); MASKT(PX0, PX1, (t)); partialSM(PX0, PX1, m_reg, mnX, alX);                                        \
        __syncthreads();                                                                                                      \
        if ((t) + 1 < NT) { VMW(); SWRITE_H(SB); }                                                                          \
        RESC(alX); __syncthreads(); } while (0)
    for (int t = 1; t + 1 < NT; t += 2) {
        HALF_STEP(pB0, pB1, mnB, alB, pA0, pA1, alA, t, 1, 0, 0);
        HALF_STEP(pA0, pA1, mnA, alA, pB0, pB1, alB, t + 1, 0, 1, 1);
    }
    const bool even = (NT & 1) == 0;
    if (even) { SBAR(); qkt<1>(pB0, pB1, lds, r32, hi, S.qr, qrl); SBAR(); }
    SLOAD_H(nxt.K, nxt.V, nxt.KR, 0); SBAR();
    QLOAD(nxt);
    SBAR();
    finishSM(pA0, pA1, alA, l_reg, pa0, pa1, pa2, pa3); SBAR();
    pv_tile<0>(o, vb0, pa0, pa1, pa2, pa3);
    if (even) { MASKT(pB0, pB1, NT - 1); partialSM(pB0, pB1, m_reg, mnB, alB); __syncthreads(); RESC(alB);
        finishSM(pB0, pB1, alB, l_reg, pa0, pa1, pa2, pa3); SBAR(); pv_tile<1>(o, vb0, pa0, pa1, pa2, pa3); }
    SBAR(); SEAM_K0();
    if (hi == 0) li_l[r32] = l_reg; asm volatile("s_waitcnt lgkmcnt(0)" ::: "memory");
    float rli[16];
#pragma unroll
    for (int r = 0; r < 16; ++r) rli[r] = __builtin_amdgcn_rcpf(li_l[crow(r, hi)]);
    int hio = hi; asm volatile("" : "+v"(hio));
    bf16* Ow = cur.O + (size_t)(wid * QBLK + 4 * hio) * PQN + r32;
#pragma unroll
    for (int r = 0; r < 16; ++r) { const int orow = (r & 3) + 8 * (r >> 2);
#pragma unroll
        for (int d0 = 0; d0 < 4; ++d0) { const float v = o[d0][r] * rli[r];
            const float vn = __shfl_xor(v, 1);
            if ((r32 & 1) == 0) *(unsigned*)(Ow + (size_t)orow * PQN + d0 * 32) = cvtpk(v, vn); }
        if ((r & 3) == 3) asm volatile("" ::: "memory"); }
    QRLOAD(nxt);
    __syncthreads();
#undef RESC
#undef KBASE
#undef MASKT
#undef SEAM_K0
#undef HALF_STEP
}
#undef ROWKV
#undef VMW
#undef VMWN
#undef SLOAD_H
#undef SWRITE_HK
#undef SWRITE_HV
#undef SWRITE_H
#undef QLOAD
#undef QRLOAD
#undef KSWZ
#undef SBAR
__device__ __forceinline__ BlockRef block_ref(int L, int pass, int hh, const bf16* QN, const bf16* QR, const bf16* KN, const bf16* V, const bf16* KR, bf16* O) {
    const int x = L & 7, k = L >> 3, bh = x * 4 + (k >> 3), y = k & 7, b = bh >> 3, h8 = bh & 7, qb = pass ? 15 - y : y;
    const size_t row0 = (size_t)b * SEQ + (size_t)qb * QB, rowb = (size_t)b * SEQ;
    BlockRef r;
    r.Q = QN + row0 * PQN + (hh * 8 + h8) * DN; r.O = O + row0 * PQN + (hh * 8 + h8) * DN; r.QR = QR + row0 * PQR + h8 * RD;
    r.K = KN + rowb * PKV + h8 * DN; r.V = V + rowb * PKV + h8 * DV; r.KR = KR + rowb * PKR; r.P0 = qb * QB;
    return r;
}
__device__ __forceinline__ void attn_phase(char* lds, int hh, const bf16* QN, const bf16* QR, const bf16* KN, const bf16* V, const bf16* KR, bf16* O, int bid, int G) {
    int L = bid; if (L >= 256) return;
    int pass = 0;
    BlockRef cur = block_ref(L, 0, hh, QN, QR, KN, V, KR, O);
    Seam S;
    attn_prime(cur, lds, S);
    for (;;) {
        const bool more_pass = pass == 0, more_item = L + G < 256, last = !more_pass && !more_item;
        int passn = pass + 1, Ln = L;
        if (!more_pass) { passn = 0; Ln = more_item ? L + G : L; }
        const BlockRef nxt = last ? cur : block_ref(Ln, passn, hh, QN, QR, KN, V, KR, O);
        attn_block(cur, nxt, lds, S);
        if (last) break;
        cur = nxt; pass = passn; L = Ln;
    }
}
}

constexpr int NWAVES = 8;
constexpr int NPH = 20;
constexpr int N_LAUNCHES = MK_N_LAUNCHES;
static_assert(N_LAUNCHES == 1 || N_LAUNCHES == NPH, "MK_N_LAUNCHES is 1 or NPH");
constexpr int CW_BAR = 4096;
constexpr int RING_OFF = 0, RING_BYTES = 155648;
constexpr int LDSCTL_OFF = RING_BYTES, MISC_OFF = LDSCTL_OFF + 320;
constexpr int LDS_BYTES = RING_BYTES + 1024;
static_assert(att::LDS_BYTES <= RING_BYTES, "attention LDS");

#define XB_TMO      128
#define XB_XCNT(j)  (256  + 64 * (j))
#define XB_XSUB(j)  (1280 + 64 * (j))
#define XB_XGEN(j)  (2304 + 64 * (j))
#define XB_TOP      3328
#define XB_TOPGEN   3392
#define XCD_BAR_WORDS 3456
#define XB_SPIN_CAP (1u << 18)
__device__ __forceinline__ unsigned xb_ld(unsigned* p)              { return __hip_atomic_load(p, __ATOMIC_RELAXED, __HIP_MEMORY_SCOPE_AGENT); }
__device__ __forceinline__ unsigned xb_add(unsigned* p, unsigned v) { return __hip_atomic_fetch_add(p, v, __ATOMIC_RELAXED, __HIP_MEMORY_SCOPE_AGENT); }
__device__ __forceinline__ unsigned xb_xcc_id() { return (unsigned)__builtin_amdgcn_s_getreg((3 << 11) | 20) & 0xFu; }
#define XB_SPIN(cond, bar) do { unsigned _sp = 0; while (cond) { __builtin_amdgcn_s_sleep(1); \
    if ((++_sp & 255u) == 0u) { if (xb_ld(&(bar)[XB_TMO])) break; if (_sp > XB_SPIN_CAP) { atomicAdd(&(bar)[XB_TMO], 1u); break; } } } } while (0)
struct XcdBarrier { unsigned* bar; unsigned x; volatile LAS unsigned* st; };
__device__ __forceinline__ XcdBarrier xcd_barrier_post(unsigned* bar, volatile LAS unsigned* st) {
    XcdBarrier b; b.bar = bar; b.x = xb_xcc_id(); b.st = st;
    if (threadIdx.x == 0) (void)xb_add(&bar[XB_XCNT(b.x)], 1u);
    return b;
}
__device__ __forceinline__ void xcd_barrier_complete(unsigned* bar, unsigned x, unsigned& nloc, unsigned& nx) {
    const unsigned G = gridDim.x * gridDim.y * gridDim.z;
    unsigned sum, cnt, mine, sp = 0u;
    for (;;) {
        sum = 0u; cnt = 0u; mine = 0u;
#pragma unroll
        for (unsigned j = 0; j < 16; ++j) { const unsigned c = xb_ld(&bar[XB_XCNT(j)]); sum += c; cnt += (c > 0u) ? 1u : 0u; mine = (j == x) ? c : mine; }
        if (sum == G) break;
        __builtin_amdgcn_s_sleep(1);
        if ((++sp & 255u) == 0u) { if (xb_ld(&bar[XB_TMO])) break; if (sp > XB_SPIN_CAP) { atomicAdd(&bar[XB_TMO], 1u); break; } }
    }
    nloc = mine > 0u ? mine : 1u; nx = cnt > 0u ? cnt : 1u;
}
__device__ __forceinline__ void xcd_barrier(const XcdBarrier& b) {
    asm volatile("s_waitcnt vmcnt(0)" ::: "memory");
    __syncthreads();
    if (threadIdx.x == 0) {
        unsigned* bar = b.bar;
        __builtin_amdgcn_s_waitcnt(0);
        unsigned nloc = b.st[0], nx = b.st[1];
        if (nloc == 0u) { xcd_barrier_complete(bar, b.x, nloc, nx); b.st[0] = nloc; b.st[1] = nx; }
        const unsigned old = xb_add(&bar[XB_XSUB(b.x)], 1u);
        const unsigned gen = old / nloc;
        if (old + 1u == (gen + 1u) * nloc) {
            __builtin_amdgcn_fence(__ATOMIC_RELEASE, "agent");
            asm volatile("s_waitcnt vmcnt(0)" ::: "memory");
            const unsigned og = xb_add(&bar[XB_TOP], 1u);
            const unsigned tg = og / nx;
            if (og + 1u == (tg + 1u) * nx) xb_add(&bar[XB_TOPGEN], 1u);
            else XB_SPIN(xb_ld(&bar[XB_TOPGEN]) == tg, bar);
            __builtin_amdgcn_fence(__ATOMIC_ACQUIRE, "agent");
            xb_add(&bar[XB_XGEN(b.x)], 1u);
            asm volatile("s_waitcnt vmcnt(0)" ::: "memory");
        } else {
            XB_SPIN(xb_ld(&bar[XB_XGEN(b.x)]) == gen, bar);
            __builtin_amdgcn_fence(__ATOMIC_ACQUIRE, "agent");
            asm volatile("s_waitcnt vmcnt(0)" ::: "memory");
        }
    }
    __syncthreads();
}

struct Args { const void* in[19]; float* out; unsigned char* ws; int ph_lo, ph_hi; };
static_assert(sizeof(Args) == 19 * 8 + 8 + 8 + 8, "Args has no padding");

struct Frame { LAS unsigned char* lds; int tid, lane, wave, vcu, G; const Args* ap; };

enum { MAP_ID = 0, MAP_CONV = 1, MAP_MLAIN = 2, MAP_QUP = 3 };
__device__ __forceinline__ int map_row(int mapid, int s) {
    if (mapid == MAP_ID) return s;
    if (mapid == MAP_CONV) { const int kind = s >> 11, j = s & 2047, pn = j >> 6, jl = j & 63;
        const int wchi = (kind == 1 || kind == 2) ? 1 : 0, bj = (kind >= 2) ? 1 : 0;
        return pn * 256 + bj * 128 + (wchi * 2 + (jl >> 5)) * 32 + (jl & 31); }
    if (mapid == MAP_MLAIN) {
        if (s < QL) return 256 + s;
        if (s < QL + KVL) return s - QL;
        if (s < QL + KVL + RD) { const int e = s - (QL + KVL), half = e >> 5, ii = e & 31; return 640 + 32 * (ii >> 4) + 8 * ((ii >> 2) & 3) + 4 * half + (ii & 3); }
        return 768 + (s - (QL + KVL + RD)); }
    { const int h = s / 192, d = s % 192, hh = h >> 3, h8 = h & 7;
        if (d < DN) return hh * 1536 + h8 * DN + d;
        const int e = d - DN, half = e >> 5, ii = e & 31, tr = h8 >> 2, hl = h8 & 3, bj = hl >> 1, wc = (hl & 1) * 2 + (ii >> 4);
        return hh * 1536 + 1024 + tr * 256 + bj * 128 + wc * 32 + 8 * ((ii >> 2) & 3) + 4 * half + (ii & 3); }
}
struct PrepItem { const float* src; const float* gk; bf16* dst; int Nsrc, ldd, mapid, n0; };
__device__ __forceinline__ PrepItem prep_decode(const Args* ap, int it) {
    unsigned char* ws = ap->ws;
#define AIN(i) ((const float*)ap->in[i])
    constexpr int I_PIN = 16 * 128, I_PGRP = 8 * 16, I_POUT = 32 * 32, I_CIN = 16 * 256, I_COUT = 32 * 32, I_MIN = 16 * 86, I_QUP = 6 * 96, I_KVUP = 4 * 128;
    constexpr int I_POOL = I_PIN + 4 * I_PGRP + I_POUT;
    const float* W; const float* gk = nullptr; bf16* WT; int Nsrc, ldd, mapid = MAP_ID; int r = it;
    if (r < 2 * I_POOL) { const int j = r / I_POOL; r -= j * I_POOL; unsigned char* wb = ws + (j ? WS_WPOOL1 : WS_WPOOL0);
        if (r < I_PIN) { W = AIN(3) + (size_t)j * DM * 4096; Nsrc = 4096; gk = AIN(2) + j * DM; WT = (bf16*)(wb + WPOOL_IN); ldd = DM; }
        else if (r < I_PIN + 4 * I_PGRP) { r -= I_PIN; const int g = r / I_PGRP; r -= g * I_PGRP; W = AIN(4) + ((size_t)j * 4 + g) * 512 * 512; Nsrc = 512; WT = (bf16*)(wb + WPOOL_GRP) + (size_t)g * 512 * 512; ldd = 512; }
        else { r -= I_PIN + 4 * I_PGRP; W = AIN(6) + (size_t)j * EI * DM; Nsrc = DM; WT = (bf16*)(wb + WPOOL_OUT); ldd = EI; } }
    else { r -= 2 * I_POOL;
        if (r < I_CIN) { W = AIN(8); Nsrc = 8192; gk = AIN(7); WT = (bf16*)(ws + WS_WCONV_IN); ldd = DM; mapid = MAP_CONV; }
        else if (r < I_CIN + I_COUT) { r -= I_CIN; W = AIN(10); Nsrc = DM; WT = (bf16*)(ws + WS_WCONV_OUT); ldd = EI; }
        else if (r < I_CIN + I_COUT + I_MIN) { r -= I_CIN + I_COUT; W = AIN(12); Nsrc = MLA_IN; gk = AIN(11); WT = (bf16*)(ws + WS_WMLA_B1); ldd = DM; mapid = MAP_MLAIN; }
        else if (r < I_CIN + I_COUT + I_MIN + I_QUP) { r -= I_CIN + I_COUT + I_MIN; W = AIN(14); Nsrc = 3072; gk = AIN(13); WT = (bf16*)(ws + WS_WMLA_QUP); ldd = QL; mapid = MAP_QUP; }
        else if (r < I_CIN + I_COUT + I_MIN + I_QUP + I_KVUP) { r -= I_CIN + I_COUT + I_MIN + I_QUP; W = AIN(16); Nsrc = 4096; gk = AIN(15); WT = (bf16*)(ws + WS_WMLA_KVUP); ldd = KVL; }
        else { r -= I_CIN + I_COUT + I_MIN + I_QUP + I_KVUP; W = AIN(17); Nsrc = DM; WT = (bf16*)(ws + WS_WMLA_OUT); ldd = EI; } }
#undef AIN
    const int nblk = Nsrc / 32, kb = r / nblk, nb = r % nblk, k0 = 64 * kb, n0 = 32 * nb;
    PrepItem d; d.src = W + (size_t)k0 * Nsrc + n0; d.gk = gk ? gk + k0 : nullptr; d.dst = WT + k0; d.Nsrc = Nsrc; d.ldd = ldd; d.mapid = mapid; d.n0 = n0;
    return d;
}
__device__ __forceinline__ void prep_load(const PrepItem& d, float (&v)[32], int lane) {
    const float* p = d.src + (size_t)(lane >> 5) * d.Nsrc + (lane & 31);
#pragma unroll
    for (int i = 0; i < 32; ++i) v[i] = p[(size_t)(2 * i) * d.Nsrc];
}
__device__ __forceinline__ void prep_store(const PrepItem& d, const float (&v)[32], LAS float* scr, int lane) {
    const int c = lane & 7;
    f32x4 g0 = (f32x4){1.f, 1.f, 1.f, 1.f}, g1 = g0;
    if (d.gk) { g0 = *(const f32x4*)(d.gk + 8 * c); g1 = *(const f32x4*)(d.gk + 8 * c + 4); }
#pragma unroll
    for (int i = 0; i < 32; ++i) scr[(2 * i + (lane >> 5)) * 33 + (lane & 31)] = v[i];
    LDS_WAIT(); asm volatile("" ::: "memory");
#pragma unroll
    for (int j = 0; j < 4; ++j) { const int n = (lane >> 3) + 8 * j; const LAS float* s = scr + (8 * c) * 33 + n;
        v4u o; o.x = cvt_pk_bf16(s[0 * 33] * g0[0], s[1 * 33] * g0[1]); o.y = cvt_pk_bf16(s[2 * 33] * g0[2], s[3 * 33] * g0[3]);
        o.z = cvt_pk_bf16(s[4 * 33] * g1[0], s[5 * 33] * g1[1]); o.w = cvt_pk_bf16(s[6 * 33] * g1[2], s[7 * 33] * g1[3]);
        *(GAS v4u*)(d.dst + (size_t)map_row(d.mapid, d.n0 + n) * d.ldd + 8 * c) = o; }
    LDS_WAIT(); asm volatile("" ::: "memory");
}
#define INP(i) ((const float*)F.ap->in[i])
__device__ __forceinline__ void p0_prologue(Frame& F) {
    unsigned char* ws = F.ap->ws;
    LAS float* scr = (LAS float*)(F.lds + RING_OFF + F.wave * 16384);
    const int gw = F.vcu * NWAVES + F.wave, NGW = F.G * NWAVES;
    constexpr int NITEMS = 2 * (16 * 128 + 4 * 8 * 16 + 32 * 32) + 16 * 256 + 32 * 32 + 16 * 86 + 6 * 96 + 4 * 128 + 32 * 32;
    { int it = gw; float va[32], vb[32]; PrepItem da, db;
      if (it < NITEMS) { da = prep_decode(F.ap, it); prep_load(da, va, F.lane); }
      while (it < NITEMS) {
          const int itb = it + NGW; if (itb < NITEMS) { db = prep_decode(F.ap, itb); prep_load(db, vb, F.lane); }
          prep_store(da, va, scr, F.lane);
          if (itb >= NITEMS) break;
          const int ita = itb + NGW; if (ita < NITEMS) { da = prep_decode(F.ap, ita); prep_load(da, va, F.lane); }
          prep_store(db, vb, scr, F.lane);
          it = ita; } }
    for (int i = gw * 64 + F.lane; i < 64 * 128; i += NGW * 64) *(GAS v4u*)((bf16*)(ws + WS_WMLA_B1) + (size_t)704 * DM + (size_t)i * 8) = (v4u){0u, 0u, 0u, 0u};
    { const float* x = INP(0); bf16* XB = (bf16*)(ws + WS_XB); float* SSQ = (float*)(ws + WS_SSQ);
      for (int m = gw; m < M; m += 2 * NGW) { const int m2 = m + NGW; const bool two = m2 < M;
          const GAS f32x4* xr = (const GAS f32x4*)(x + (size_t)m * DM) + F.lane; const GAS f32x4* xr2 = (const GAS f32x4*)(x + (size_t)(two ? m2 : m) * DM) + F.lane; f32x4 v[4], w[4];
#pragma unroll
          for (int j = 0; j < 4; ++j) v[j] = xr[64 * j];
#pragma unroll
          for (int j = 0; j < 4; ++j) w[j] = xr2[64 * j];
          float s = 0.f, s2 = 0.f;
#pragma unroll
          for (int j = 0; j < 4; ++j) { s += (v[j].x * v[j].x + v[j].y * v[j].y) + (v[j].z * v[j].z + v[j].w * v[j].w); s2 += (w[j].x * w[j].x + w[j].y * w[j].y) + (w[j].z * w[j].z + w[j].w * w[j].w); }
          s = wave_sum(s); s2 = wave_sum(s2);
          GAS v2u* o8 = (GAS v2u*)(XB + (size_t)m * DM) + F.lane;
#pragma unroll
          for (int j = 0; j < 4; ++j) o8[64 * j] = (v2u){cvt_pk_bf16(v[j].x, v[j].y), cvt_pk_bf16(v[j].z, v[j].w)};
          if (F.lane < 16) SSQ[(size_t)m * 16 + F.lane] = F.lane == 0 ? s : 0.f;
          if (two) { GAS v2u* p8 = (GAS v2u*)(XB + (size_t)m2 * DM) + F.lane;
#pragma unroll
              for (int j = 0; j < 4; ++j) p8[64 * j] = (v2u){cvt_pk_bf16(w[j].x, w[j].y), cvt_pk_bf16(w[j].z, w[j].w)};
              if (F.lane < 16) SSQ[(size_t)m2 * 16 + F.lane] = F.lane == 0 ? s2 : 0.f; } } }
    { const int* pos = (const int*)F.ap->in[1]; float* COS = (float*)(ws + WS_COS); float* SIN = (float*)(ws + WS_SIN);
      for (int e = F.vcu * (NWAVES * 64) + F.tid; e < M * 32; e += F.G * NWAVES * 64) { const int row = e >> 5, i = e & 31;
          const float invf = powf(ROPE_BASE, -(float)(2 * i) / (float)RD); const float ang = (float)pos[row] * invf;
          const double a = (double)ang; const double n = __builtin_rint(a * 0.15915494309189535); const float r = (float)__builtin_fma(n, -6.283185307179586, a);
          COS[e] = cosf(r); SIN[e] = sinf(r); } }
}

template <int W>
__device__ __forceinline__ void pool_rows(const v2u (&v)[31], int t0, bf16* out_base) {
    float s[4];
#pragma unroll
    for (int c = 0; c < 4; ++c) s[c] = 0.f;
#pragma unroll
    for (int j = 0; j < W; ++j) { const v2u w = v[15 - j]; s[0] += bflo(w.x); s[1] += bfhi(w.x); s[2] += bflo(w.y); s[3] += bfhi(w.y); }
#pragma unroll
    for (int i = 0; i < 16; ++i) {
        const int t = t0 + i; const float inv = __builtin_amdgcn_rcpf((float)(t + 1 < W ? t + 1 : W));
        const v2u cu = v[15 + i];
        const float o0 = s[0] * inv - bflo(cu.x), o1 = s[1] * inv - bfhi(cu.x), o2 = s[2] * inv - bflo(cu.y), o3 = s[3] * inv - bfhi(cu.y);
        *(GAS v2u*)(out_base + (size_t)i * EI) = (v2u){cvt_pk_bf16(o0, o1), cvt_pk_bf16(o2, o3)};
        if (i < 15) { const v2u a = v[16 + i], d = v[16 + i - W];
            s[0] += bflo(a.x) - bflo(d.x); s[1] += bfhi(a.x) - bfhi(d.x); s[2] += bflo(a.y) - bflo(d.y); s[3] += bfhi(a.y) - bfhi(d.y); }
    }
}
__device__ __forceinline__ void pool_mix_phase(Frame& F, bf16* U, const bf16* HALO) {
    const int cb = F.tid & 31, rb = F.tid >> 5;
    for (int unit = F.vcu; unit < 64 * 16; unit += F.G) {
        const int pm = unit >> 4, cs = unit & 15, col = cs * 128 + cb * 4, g = cs >> 2;
        const int r0 = pm * 256 + rb * 16, t0 = r0 & (SEQ - 1);
        v2u v[31];
#pragma unroll
        for (int i = 0; i < 31; ++i) { const int dr = i - 15;
            if (dr >= 0 || rb > 0) v[i] = *(const GAS v2u*)(U + (size_t)(r0 + dr) * EI + col);
            else if ((pm & 15) == 0) v[i] = (v2u){0u, 0u};
            else v[i] = *(const GAS v2u*)(HALO + ((size_t)(pm - 1) * 16 + (16 + dr)) * EI + col); }
        VM_WAIT(); __syncthreads();
        bf16* ob = U + (size_t)r0 * EI + col;
        if (g == 0) pool_rows<2>(v, t0, ob); else if (g == 1) pool_rows<4>(v, t0, ob); else if (g == 2) pool_rows<8>(v, t0, ob); else pool_rows<16>(v, t0, ob);
    }
}
__device__ __forceinline__ void conv_mix_phase(Frame& F, const bf16* CH, bf16* BZ, const float* cw) {
    const int cb = F.tid & 31, rb = F.tid >> 5;
    for (int unit = F.vcu; unit < 64 * 8; unit += F.G) {
        const int pm = unit >> 3, cs = unit & 7, col = cs * 256 + cb * 8;
        const int r0 = pm * 256 + rb * 16, t0 = r0 & (SEQ - 1);
        float w[3][8];
#pragma unroll
        for (int j = 0; j < 3; ++j) { const f32x4 a = *(const GAS f32x4*)(cw + j * EI + col), b = *(const GAS f32x4*)(cw + j * EI + col + 4);
            w[j][0] = a[0]; w[j][1] = a[1]; w[j][2] = a[2]; w[j][3] = a[3]; w[j][4] = b[0]; w[j][5] = b[1]; w[j][6] = b[2]; w[j][7] = b[3]; }
        v4u c[18];
#pragma unroll
        for (int i = 0; i < 18; ++i) { const int dr = i - 2; if (t0 + dr >= 0) c[i] = *(const GAS v4u*)(CH + (size_t)(r0 + dr) * EI + col); else c[i] = (v4u){0u, 0u, 0u, 0u}; }
#pragma unroll
        for (int i = 0; i < 16; ++i) { bf16* p = BZ + (size_t)(r0 + i) * EI + col; const v4u z = *(const GAS v4u*)p; const v4u x0 = c[i], x1 = c[i + 1], x2 = c[i + 2];
            float o[8];
#define CV(k, X0, X1, X2, Z) o[k] = (Z) * (w[0][k] * (X0) + w[1][k] * (X1) + w[2][k] * (X2))
            CV(0, bflo(x0.x), bflo(x1.x), bflo(x2.x), bflo(z.x)); CV(1, bfhi(x0.x), bfhi(x1.x), bfhi(x2.x), bfhi(z.x));
            CV(2, bflo(x0.y), bflo(x1.y), bflo(x2.y), bflo(z.y)); CV(3, bfhi(x0.y), bfhi(x1.y), bfhi(x2.y), bfhi(z.y));
            CV(4, bflo(x0.z), bflo(x1.z), bflo(x2.z), bflo(z.z)); CV(5, bfhi(x0.z), bfhi(x1.z), bfhi(x2.z), bfhi(z.z));
            CV(6, bflo(x0.w), bflo(x1.w), bflo(x2.w), bflo(z.w)); CV(7, bfhi(x0.w), bfhi(x1.w), bfhi(x2.w), bfhi(z.w));
#undef CV
            *(GAS v4u*)p = (v4u){cvt_pk_bf16(o[0], o[1]), cvt_pk_bf16(o[2], o[3]), cvt_pk_bf16(o[4], o[5]), cvt_pk_bf16(o[6], o[7])}; }
    }
}
__device__ __forceinline__ void final_norm_phase(Frame& F, float* X, const float* gain) {
    const int gw = F.vcu * NWAVES + F.wave, NGW = F.G * NWAVES;
    f32x4 gv[4];
#pragma unroll
    for (int j = 0; j < 4; ++j) gv[j] = *((const GAS f32x4*)gain + F.lane + 64 * j);
    for (int m = gw; m < M; m += NGW) { GAS f32x4* xr = (GAS f32x4*)(X + (size_t)m * DM) + F.lane; f32x4 v[4]; float s = 0.f;
#pragma unroll
        for (int j = 0; j < 4; ++j) { v[j] = xr[64 * j]; s += (v[j].x * v[j].x + v[j].y * v[j].y) + (v[j].z * v[j].z + v[j].w * v[j].w); }
        const float rs = 1.0f / sqrtf(wave_sum(s) * (1.0f / DM) + NORM_EPS);
#pragma unroll
        for (int j = 0; j < 4; ++j) xr[64 * j] = v[j] * rs * gv[j]; }
}

__device__ __forceinline__ void run_phase(Frame& F, int ph) {
    { int t_ = threadIdx.x; asm volatile("" : "+v"(t_)); F.tid = t_; F.lane = t_ & 63; F.wave = __builtin_amdgcn_readfirstlane(t_ >> 6); }
    unsigned char* ws = F.ap->ws; const int bid = (int)blockIdx.x;
    bf16* XB = (bf16*)(ws + WS_XB); bf16* A1 = (bf16*)(ws + WS_A1); bf16* A2 = (bf16*)(ws + WS_A2);
    float* SSQ = (float*)(ws + WS_SSQ); float* X = F.ap->out;
    const float* COS = (const float*)(ws + WS_COS); const float* SIN = (const float*)(ws + WS_SIN);
    LAS unsigned char* ring = F.lds + RING_OFF;
#ifndef MK_PHMASK
#define MK_PHMASK 0xFFFFF
#endif
#define PH_EN(k) ((MK_PHMASK >> (k)) & 1)
    if (PH_EN(0) && ph == 0) { p0_prologue(F); return; }
    if (PH_EN(19) && ph == 19) { final_norm_phase(F, X, INP(18)); return; }
    const bool pool = (ph >= 1 && ph <= 4) || (ph >= 15 && ph <= 18);
    const int j = ph >= 15 ? 1 : 0, pp = pool ? (ph >= 15 ? ph - 15 : ph - 1) : -1;
    unsigned char* wpool = ws + (j ? WS_WPOOL1 : WS_WPOOL0);
    if (PH_EN(1) && pool && pp == 0) {
        pg8::Gemm g{XB, (const bf16*)(wpool + WPOOL_IN), DM, DM, DM, 0, 0}; pg8::StaticOrder S; S.init(M, 4096, F.G, bid);
        epi::EpiPoolIn E{A1, A2, (bf16*)(ws + WS_HALO), SSQ};
        pg8::gemm_phase<epi::EpiPoolIn, pg8::StaticOrder, true>(ring, g, S, E); return; }
    if (PH_EN(2) && pool && pp == 1) { pool_mix_phase(F, A1, (const bf16*)(ws + WS_HALO)); return; }
    if (PH_EN(3) && pool && pp == 2) {
        pg8::Gemm g{A1, (const bf16*)(wpool + WPOOL_GRP), EI, 512, 512, 2, 512}; pg8::StaticOrder S; S.init(M, EI, F.G, bid);
        epi::EpiPoolGrp E{A2, INP(5) + j * EI};
        pg8::gemm_phase<epi::EpiPoolGrp, pg8::StaticOrder, true>(ring, g, S, E); return; }
    if (PH_EN(4) && ((pool && pp == 3) || ph == 7 || ph == 14)) {
        const bf16* Y = ph == 14 ? A1 : A2;
        const bf16* Wt = pool ? (const bf16*)(wpool + WPOOL_OUT) : ph == 7 ? (const bf16*)(ws + WS_WCONV_OUT) : (const bf16*)(ws + WS_WMLA_OUT);
        pg8::Gemm g{Y, Wt, EI, EI, EI, 0, 0}; pg8::StaticOrder S; S.init(M, DM, F.G, bid);
        epi::EpiResid E{ph == 4 ? INP(0) : (const float*)X, X, XB, SSQ};
        pg8::gemm_phase<epi::EpiResid, pg8::StaticOrder, false>(ring, g, S, E); return; }
    if (PH_EN(5) && ph == 5) {
        pg8::Gemm g{XB, (const bf16*)(ws + WS_WCONV_IN), DM, DM, DM, 0, 0}; pg8::StaticOrder S; S.init(M, 8192, F.G, bid);
        epi::EpiConvIn E{A1, A2, SSQ};
        pg8::gemm_phase<epi::EpiConvIn, pg8::StaticOrder, true>(ring, g, S, E); return; }
    if (PH_EN(6) && ph == 6) { conv_mix_phase(F, A1, A2, INP(9)); return; }
    bf16* KVLAT = (bf16*)(ws + WS_KVLAT); bf16* QLAT = (bf16*)(ws + WS_QLAT); bf16* KROPE = (bf16*)(ws + WS_KROPE); bf16* QR = (bf16*)(ws + WS_QR);
    float* SSQQ = (float*)(ws + WS_SSQQ); float* SSQKV = (float*)(ws + WS_SSQKV);
    if (PH_EN(8) && ph == 8) {
        pg8::Gemm g{XB, (const bf16*)(ws + WS_WMLA_B1), DM, DM, DM, 0, 0}; pg8::StaticOrder S; S.init(M, 768, F.G, bid);
        epi::EpiMlaIn E{KVLAT, QLAT, KROPE, SSQKV, SSQQ, SSQ, COS, SIN};
        pg8::gemm_phase<epi::EpiMlaIn, pg8::StaticOrder, false>(ring, g, S, E); return; }
    if (PH_EN(9) && (ph == 9 || ph == 11)) {
        const int hh = ph == 9 ? 0 : 1;
        { pg8::Gemm g{QLAT, (const bf16*)(ws + WS_WMLA_QUP) + (size_t)hh * 1536 * QL, QL, QL, QL, 0, 0}; pg8::StaticOrder S; S.init(M, 1536, F.G, bid);
          epi::EpiQUp E{A1, QR, SSQQ, COS, SIN, hh};
          pg8::gemm_phase<epi::EpiQUp, pg8::StaticOrder, true>(ring, g, S, E); }
        { pg8::Gemm g{KVLAT, (const bf16*)(ws + WS_WMLA_KVUP) + (size_t)hh * 2048 * KVL, KVL, KVL, KVL, 0, 0}; pg8::StaticOrder S; S.init(M, 2048, F.G, F.G - 1 - bid);
          epi::EpiKvUp E{A2, A2 + (size_t)M * 1024, SSQKV};
          pg8::gemm_phase<epi::EpiKvUp, pg8::StaticOrder, true>(ring, g, S, E); }
        return; }
    if (PH_EN(10) && (ph == 10 || ph == 12)) { att::attn_phase((char*)ring, ph == 10 ? 0 : 1, A1, QR, A2, A2 + (size_t)M * 1024, KROPE, A1, bid, F.G); return; }
    if (PH_EN(13) && ph == 13) {
        pg8::Gemm g{XB, (const bf16*)(ws + WS_WMLA_B1) + (size_t)768 * DM, DM, DM, DM, 0, 0}; pg8::StaticOrder S; S.init(M, EI, F.G, bid);
        epi::EpiGate E{A1, SSQ};
        pg8::gemm_phase<epi::EpiGate, pg8::StaticOrder, true>(ring, g, S, E); return; }
}

__global__ void __launch_bounds__(NWAVES * 64, 2) trunk_fwd(Args args) {
    extern __shared__ __attribute__((aligned(16))) unsigned char lds[];
    Frame F;
    F.lds = (LAS unsigned char*)lds; F.ap = &args;
    F.tid = threadIdx.x; F.lane = F.tid & 63; F.wave = __builtin_amdgcn_readfirstlane(F.tid >> 6);
    F.G = gridDim.x; { const int bx = blockIdx.x; F.vcu = (F.G % 8 == 0) ? (bx % 8) * (F.G / 8) + bx / 8 : bx; }
    for (int u = F.tid; u < (LDS_BYTES - LDSCTL_OFF) / 4; u += NWAVES * 64) ((LAS unsigned*)(F.lds + LDSCTL_OFF))[u] = 0u;
    __syncthreads();
    XcdBarrier bar; bar.bar = (unsigned*)(args.ws + WS_CTL) + CW_BAR; bar.x = 0; bar.st = nullptr;
    if (N_LAUNCHES == 1) bar = xcd_barrier_post((unsigned*)(args.ws + WS_CTL) + CW_BAR, (volatile LAS unsigned*)(F.lds + MISC_OFF) + 8);
    const int lo = args.ph_lo, hi = args.ph_hi;
#define PHASE(k) if (lo <= (k) && (k) < hi) { run_phase(F, (k)); if ((k) + 1 < hi) { if (N_LAUNCHES == 1) xcd_barrier(bar); } }
    PHASE(0)
    PHASE(1)
    PHASE(2)
    PHASE(3)
    PHASE(4)
    PHASE(5)
    PHASE(6)
    PHASE(7)
    PHASE(8)
    PHASE(9)
    PHASE(10)
    PHASE(11)
    PHASE(12)
    PHASE(13)
    PHASE(14)
    PHASE(15)
    PHASE(16)
    PHASE(17)
    PHASE(18)
    PHASE(19)
#undef PHASE
}


extern "C" void kernel_launch(void* const* d_in, const int* in_sizes, int n_in, void* d_out, int out_size, void* d_ws, size_t ws_size, hipStream_t stream) {
    static int grid = 0;
    if (grid == 0) {
        if (n_in != 19 || in_sizes[0] != M * DM || out_size != M * DM || ws_size < WS_END) {
            fprintf(stderr, "kernel_launch: built for 19 inputs, x/out of %d floats, >= %zu bytes of workspace; got n_in %d, in0 %d, out %d, ws %zu; nothing launched\n", M * DM, (size_t)WS_END, n_in, n_in > 0 ? in_sizes[0] : -1, out_size, ws_size);
            grid = -1; return; }
        int dev = 0, cus = 0;
        if (hipGetDevice(&dev) != hipSuccess || hipDeviceGetAttribute(&cus, hipDeviceAttributeMultiprocessorCount, dev) != hipSuccess) { fprintf(stderr, "kernel_launch: device query failed\n"); grid = -1; return; }
        if (hipFuncSetAttribute((const void*)trunk_fwd, hipFuncAttributeMaxDynamicSharedMemorySize, LDS_BYTES) != hipSuccess) { fprintf(stderr, "kernel_launch: hipFuncSetAttribute failed\n"); grid = -1; return; }
        int per_cu = 0;
        if (hipOccupancyMaxActiveBlocksPerMultiprocessor(&per_cu, (const void*)trunk_fwd, NWAVES * 64, LDS_BYTES) != hipSuccess || per_cu < 1)
            fprintf(stderr, "kernel_launch: note: occupancy query reports %d workgroups per CU\n", per_cu);
        (void)hipGetLastError();
        grid = cus;
    }
    if (grid < 0) return;
    if (hipMemsetAsync((char*)d_ws + WS_CTL, 0, CTL_ZERO_BYTES, stream) != hipSuccess) { fprintf(stderr, "kernel_launch: hipMemsetAsync failed\n"); return; }
    Args a{};
    for (int i = 0; i < 19; ++i) a.in[i] = d_in[i];
    a.out = (float*)d_out; a.ws = (unsigned char*)d_ws;
#if MK_DEBUG
    dbg_launch_all(a, grid, stream);
#else
    for (int li = 0; li < N_LAUNCHES; ++li) {
        a.ph_lo = (N_LAUNCHES == NPH) ? li : 0; a.ph_hi = (N_LAUNCHES == NPH) ? li + 1 : NPH;
        hipLaunchKernelGGL(trunk_fwd, dim3(grid), dim3(NWAVES * 64), LDS_BYTES, stream, a);
        const hipError_t le = hipPeekAtLastError();
        if (le != hipSuccess) { fprintf(stderr, "kernel_launch: launch %d failed: %s\n", li, hipGetErrorName(le)); break; }
    }
#endif
}
```

```cpp
#include <hip/hip_runtime.h>
#include <cstdio>
#include <cstdint>

#ifndef MK_N_LAUNCHES
#define MK_N_LAUNCHES 1
#endif
#ifndef MK_DEBUG
#define MK_DEBUG 0
#endif

constexpr int NB = 4, SEQ = 4096, DM = 1024, M = NB * SEQ, EI = 2048;
constexpr int QL = 384, KVL = 256, RD = 64, NHEAD = 16, DN = 128, DV = 128;
constexpr int MLA_IN = QL + KVL + RD + EI;
constexpr float NORM_EPS = 1e-6f;
constexpr float ATTN_SCALE = 0.07216878364870322f;
constexpr float ROPE_BASE = 10000.0f;

constexpr size_t MiB = 1u << 20;
constexpr size_t WS_CTL = 0, CTL_ZERO_BYTES = 1 * MiB;
constexpr size_t WS_SSQ = 1 * MiB;
constexpr size_t WS_SSQQ = 2 * MiB;
constexpr size_t WS_SSQKV = 2 * MiB + 512 * 1024;
constexpr size_t WS_DBG = 3 * MiB;
constexpr size_t WS_COS = 4 * MiB, WS_SIN = 6 * MiB;
constexpr size_t WS_HALO = 8 * MiB;
constexpr size_t WS_WCONV_IN = 12 * MiB;
constexpr size_t WS_WCONV_OUT = 28 * MiB;
constexpr size_t WS_WPOOL0 = 32 * MiB, WS_WPOOL1 = 46 * MiB;
constexpr size_t WPOOL_IN = 0, WPOOL_GRP = 8 * MiB, WPOOL_OUT = 10 * MiB;
constexpr size_t WS_WMLA_B1 = 60 * MiB;
constexpr size_t WS_WMLA_BZ = 62 * MiB;
constexpr size_t WS_WMLA_QUP = 66 * MiB;
constexpr size_t WS_WMLA_KVUP = 69 * MiB;
constexpr size_t WS_WMLA_OUT = 71 * MiB;
constexpr size_t WS_XB = 76 * MiB;
constexpr size_t WS_A1 = 108 * MiB;
constexpr size_t WS_A2 = 172 * MiB;
constexpr size_t WS_QLAT = 236 * MiB;
constexpr size_t WS_KVLAT = 248 * MiB;
constexpr size_t WS_END = 256 * MiB;
constexpr size_t WS_QR = WS_WCONV_IN;
constexpr size_t WS_KROPE = 44 * MiB;

#define GAS __attribute__((address_space(1)))
#define LAS __attribute__((address_space(3)))
typedef unsigned short bf16;
typedef unsigned v4u __attribute__((ext_vector_type(4)));
typedef unsigned v2u __attribute__((ext_vector_type(2)));
typedef float f32x4 __attribute__((ext_vector_type(4)));
typedef float f32x2 __attribute__((ext_vector_type(2)));
typedef float f32x16 __attribute__((ext_vector_type(16)));
typedef short bf16x8 __attribute__((ext_vector_type(8)));
typedef short s16x4 __attribute__((ext_vector_type(4)));
typedef GAS unsigned gu32;
#define RLX_AGENT __ATOMIC_RELAXED, __HIP_MEMORY_SCOPE_AGENT
#define LDS_WAIT() asm volatile("s_waitcnt lgkmcnt(0)" ::: "memory")
#define VM_WAIT() asm volatile("s_waitcnt vmcnt(0)" ::: "memory")

__device__ __forceinline__ unsigned cvt_pk_bf16(float lo, float hi) { unsigned r; asm volatile("v_cvt_pk_bf16_f32 %0, %1, %2" : "=v"(r) : "v"(lo), "v"(hi)); return r; }
__device__ __forceinline__ float bf2f(unsigned short h) { return __uint_as_float((unsigned)h << 16); }
__device__ __forceinline__ float bflo(unsigned w) { return __uint_as_float(w << 16); }
__device__ __forceinline__ float bfhi(unsigned w) { return __uint_as_float(w & 0xffff0000u); }
__device__ __forceinline__ unsigned short f2bf_bits(float f) { return (unsigned short)(cvt_pk_bf16(f, 0.f) & 0xffffu); }
__device__ __forceinline__ v4u pack8(f32x4 a, f32x4 b) { v4u w; w.x = cvt_pk_bf16(a[0], a[1]); w.y = cvt_pk_bf16(a[2], a[3]); w.z = cvt_pk_bf16(b[0], b[1]); w.w = cvt_pk_bf16(b[2], b[3]); return w; }
__device__ __forceinline__ float silu_f(float z) { return z * __builtin_amdgcn_rcpf(1.0f + __builtin_amdgcn_exp2f(-1.4426950408889634f * z)); }
__device__ __forceinline__ f32x4 silu4(f32x4 z) { f32x4 r; r[0] = silu_f(z[0]); r[1] = silu_f(z[1]); r[2] = silu_f(z[2]); r[3] = silu_f(z[3]); return r; }
__device__ __forceinline__ float wave_sum(float v) {
#pragma unroll
    for (int o = 1; o < 64; o <<= 1) v += __shfl_xor(v, o);
    return v;
}
__device__ __forceinline__ float fq_sum(float s) { s += __shfl_xor(s, 16); s += __shfl_xor(s, 32); return s; }

namespace pg8 {
typedef unsigned short bf16_t;
constexpr int BM = 256, BK = 64, HALF = 128, HTB = HALF * BK * 2  , STAGE_BYTES = 8 * HTB, NXCD = 8, WGM = 8;

__host__ __device__ __forceinline__ int lds_byte(int r, int c) { const int st = (r >> 4) * 2 + (c >> 5), rr = r & 15, cc = c & 31, ob = rr * 64 + cc * 2; return st * 1024 + (ob ^ (((ob >> 9) & 1) << 5)); }
__host__ __device__ __forceinline__ void stage_rc(int b, int& R, int& C) { const int st = b / 1024, sb = b % 1024, swz = sb ^ (((sb >> 9) & 1) << 5); R = (st >> 1) * 16 + swz / 64; C = (st & 1) * 32 + (swz % 64) / 2; }
__host__ __device__ __forceinline__ int perm32(int rho) { const int n = rho >> 4, i = rho & 15; return 8 * (i >> 2) + 4 * n + (i & 3); }

struct Unit { int pm, pn; };
struct Gemm { const bf16_t* A; const bf16_t* Bt; int lda, ldb, K, agt, ags; };

struct StaticOrder {
    int nM, nN, nwg, G, c;
    __host__ __device__ void init(int M_, int N_, int G_, int c_) { nM = M_ / BM; nN = N_ / BM; nwg = nM * nN; G = G_; c = c_; }
    __host__ __device__ bool next(int i, Unit& u) const {
        const long L = (long)i * G + c; if (L >= nwg) return false;
        int wgid = (int)L; { const int q = nwg / NXCD, r = nwg % NXCD, xcd = wgid % NXCD, off = wgid / NXCD; wgid = (xcd < r ? xcd * (q + 1) : r * (q + 1) + (xcd - r) * q) + off; }
        const int nig = WGM * nN, gid = wgid / nig, fm = gid * WGM, gsz = (nM - fm) < WGM ? (nM - fm) : WGM;
        u.pm = fm + ((wgid % nig) % gsz); u.pn = (wgid % nig) / gsz; return true;
    }
};

template <class Epi, class Sched, bool ALIGN_EPI = false>
__device__ __forceinline__ void gemm_phase(LAS unsigned char* lds, const Gemm g, const Sched& S, const Epi& E) {
    int tid_ = threadIdx.x; asm volatile("" : "+v"(tid_));
    const int tid = tid_, wid = __builtin_amdgcn_readfirstlane(tid >> 6), lane = tid & 63, wr = wid >> 2, wc = wid & 3, fr = lane & 15, fq = lane >> 4;
    const int K = g.K, nt = K / BK;
    unsigned voffA[2], voffB[2];
#pragma unroll
    for (int i = 0; i < 2; ++i) { int R, C; stage_rc(tid * 16 + i * 8192, R, C); const int Rb = (R & ~31) + perm32(R & 31);
        voffA[i] = (unsigned)(R * g.lda + C) * 2u; voffB[i] = (unsigned)(Rb * g.ldb + C) * 2u; }
    const size_t kstep = (size_t)(BK * 2);
    const size_t hstepA = (size_t)HALF * g.lda * 2, hstepB = (size_t)HALF * g.ldb * 2;
    const unsigned ldsw = (unsigned)wid * 1024u;
    const int aoff = lds_byte(wr * 64 + fr, fq * 8), boff = lds_byte(wc * 32 + fr, fq * 8);
#define PG8_AOF(u) ((const char*)g.A + ((size_t)(u).pm * BM * g.lda + (g.agt ? (size_t)((u).pn / g.agt) * g.ags : (size_t)0)) * 2)
#define PG8_BOF(u) ((const char*)g.Bt + (size_t)(u).pn * BM * g.ldb * 2)
#define PG8_SA(b, h) (((b) * 2 + (h)) * HTB)
#define PG8_SB(b, h) ((4 + (b) * 2 + (h)) * HTB)
#define PG8_STAGE(bufoff, gbase, voff) do { _Pragma("unroll") for (int _i = 0; _i < 2; ++_i) \
        __builtin_amdgcn_global_load_lds((const unsigned*)((const char*)(gbase) + (voff)[_i]), (LAS unsigned*)(lds + (bufoff) + ldsw + _i * 8192), 16, 0, 0); } while (0)
#define PG8_LDA(dst, b, h) do { _Pragma("unroll") for (int m = 0; m < 4; ++m) _Pragma("unroll") for (int k = 0; k < 2; ++k) dst[m][k] = *(const LAS bf16x8*)(lds + PG8_SA(b, h) + aoff + m * 2048 + k * 1024); } while (0)
#define PG8_LDB(dst, b, h) do { _Pragma("unroll") for (int n = 0; n < 2; ++n) _Pragma("unroll") for (int k = 0; k < 2; ++k) dst[n][k] = *(const LAS bf16x8*)(lds + PG8_SB(b, h) + boff + n * 2048 + k * 1024); } while (0)
#define PG8_MMA(ai, bj, At, Bt) do { __builtin_amdgcn_s_setprio(1); _Pragma("unroll") for (int m = 0; m < 4; ++m) _Pragma("unroll") for (int n = 0; n < 2; ++n) _Pragma("unroll") for (int k = 0; k < 2; ++k) \
        acc[ai][bj][m][n] = __builtin_amdgcn_mfma_f32_16x16x32_bf16(Bt[n][k], At[m][k], acc[ai][bj][m][n], 0, 0, 0); __builtin_amdgcn_s_setprio(0); } while (0)
#define PG8_WAIT_V(n) asm volatile("s_waitcnt vmcnt(" #n ")" ::: "memory")
#define PG8_WAIT_L(n) asm volatile("s_waitcnt lgkmcnt(" #n ")" ::: "memory")
#define PG8_BAR __builtin_amdgcn_s_barrier()
#define PG8_SCHED __builtin_amdgcn_sched_barrier(0)
    Unit cur, nxt; int ui = 0;
    if (!S.next(0, cur)) return;
    f32x4 acc[2][2][4][2];
#pragma unroll
    for (int a = 0; a < 2; ++a)
#pragma unroll
        for (int b = 0; b < 2; ++b)
#pragma unroll
            for (int m = 0; m < 4; ++m)
#pragma unroll
                for (int n = 0; n < 2; ++n) acc[a][b][m][n] = (f32x4){0.f, 0.f, 0.f, 0.f};
    bf16x8 At[4][2], B0[2][2], B1[2][2];
    const char* cA = PG8_AOF(cur); const char* cB = PG8_BOF(cur);
    PG8_STAGE(PG8_SB(0, 0), cB, voffB); PG8_STAGE(PG8_SB(0, 1), cB + hstepB, voffB); PG8_STAGE(PG8_SA(0, 0), cA, voffA); PG8_STAGE(PG8_SA(0, 1), cA + hstepA, voffA);
    if (wr == 1) PG8_BAR;
    PG8_WAIT_V(2); PG8_BAR;
    PG8_STAGE(PG8_SB(1, 0), cB + kstep, voffB); PG8_STAGE(PG8_SA(1, 0), cA + kstep, voffA); PG8_STAGE(PG8_SB(1, 1), cB + hstepB + kstep, voffB);
    PG8_WAIT_V(6); PG8_BAR;
    for (;;) {
        const bool has_next = S.next(ui + 1, nxt);
        const char* nA = has_next ? PG8_AOF(nxt) : cA; const char* nB = has_next ? PG8_BOF(nxt) : cB;
#pragma nounroll
        for (int t = 0; t < nt; t += 2) {
            const bool last = (t == nt - 2);
            const char* a1 = cA + (size_t)(t + 1) * kstep;
            const char* a2 = last ? nA : cA + (size_t)(t + 2) * kstep; const char* b2 = last ? nB : cB + (size_t)(t + 2) * kstep;
            const char* a3 = a2 + kstep; const char* b3 = b2 + kstep;
            PG8_LDB(B0, 0, 0); PG8_LDB(B1, 0, 1); PG8_SCHED; PG8_LDA(At, 0, 0); PG8_STAGE(PG8_SA(1, 1), a1 + hstepA, voffA);
            PG8_WAIT_V(8); PG8_WAIT_L(0); PG8_BAR; PG8_MMA(0, 0, At, B0); PG8_MMA(0, 1, At, B1); PG8_BAR; PG8_SCHED;
            PG8_LDA(At, 0, 1); PG8_STAGE(PG8_SB(0, 0), b2, voffB); PG8_STAGE(PG8_SB(0, 1), b2 + hstepB, voffB); PG8_STAGE(PG8_SA(0, 0), a2, voffA);
            PG8_WAIT_V(8); PG8_WAIT_L(0); PG8_BAR; PG8_MMA(1, 0, At, B0); PG8_MMA(1, 1, At, B1); PG8_BAR; PG8_SCHED;
            PG8_LDB(B0, 1, 0); PG8_LDB(B1, 1, 1); PG8_SCHED; PG8_LDA(At, 1, 0); PG8_STAGE(PG8_SA(0, 1), a2 + hstepA, voffA);
            PG8_WAIT_V(8); PG8_WAIT_L(0); PG8_BAR; PG8_MMA(0, 0, At, B0); PG8_MMA(0, 1, At, B1); PG8_BAR; PG8_SCHED;
            PG8_LDA(At, 1, 1); PG8_STAGE(PG8_SB(1, 0), b3, voffB); PG8_STAGE(PG8_SB(1, 1), b3 + hstepB, voffB); PG8_STAGE(PG8_SA(1, 0), a3, voffA);
            PG8_WAIT_V(8); PG8_WAIT_L(0); PG8_BAR; PG8_MMA(1, 0, At, B0); PG8_MMA(1, 1, At, B1); PG8_BAR; PG8_SCHED;
        }
        if constexpr (ALIGN_EPI) { if (wr == 0) PG8_BAR; }
        E(acc, cur, wr, wc, fr, fq);
        if (!has_next) break;
#pragma unroll
        for (int a = 0; a < 2; ++a)
#pragma unroll
            for (int b = 0; b < 2; ++b)
#pragma unroll
                for (int m = 0; m < 4; ++m)
#pragma unroll
                    for (int n = 0; n < 2; ++n) acc[a][b][m][n] = (f32x4){0.f, 0.f, 0.f, 0.f};
        cur = nxt; cA = nA; cB = nB; ++ui;
        if constexpr (ALIGN_EPI) { if (wr == 1) PG8_BAR; }
    }
    PG8_WAIT_V(0);
    if constexpr (!ALIGN_EPI) { if (wr == 0) PG8_BAR; }
    PG8_BAR;
#undef PG8_AOF
#undef PG8_BOF
#undef PG8_SA
#undef PG8_SB
#undef PG8_STAGE
#undef PG8_LDA
#undef PG8_LDB
#undef PG8_MMA
#undef PG8_WAIT_V
#undef PG8_WAIT_L
#undef PG8_BAR
#undef PG8_SCHED
}
}

namespace epi {
using pg8::Unit; using pg8::BM; using pg8::HALF;
typedef f32x4 Acc[2][2][4][2];
__device__ __forceinline__ float sq8(f32x4 a, f32x4 b) { return (a[0] * a[0] + a[1] * a[1]) + (a[2] * a[2] + a[3] * a[3]) + (b[0] * b[0] + b[1] * b[1]) + (b[2] * b[2] + b[3] * b[3]); }
#define EPI_ROW(g) (row0 + ((g) >> 2) * HALF + ((g) & 3) * 16)
__device__ __forceinline__ void rstd16x8(float (&rs)[8], const float* SSQ, int row0, int fq, float inv_n) {
    f32x4 v[8];
#pragma unroll
    for (int g = 0; g < 8; ++g) v[g] = *(const f32x4*)(SSQ + (size_t)EPI_ROW(g) * 16 + fq * 4);
#pragma unroll
    for (int g = 0; g < 8; ++g) rs[g] = 1.0f / sqrtf(fq_sum((v[g][0] + v[g][1]) + (v[g][2] + v[g][3])) * inv_n + NORM_EPS);
}

struct EpiPoolIn {
    bf16* U; bf16* SZ; bf16* HALO; const float* SSQ;
    __device__ __forceinline__ void operator()(const Acc& acc, const Unit& u, int wr, int wc, int fr, int fq) const {
        const int row0 = u.pm * BM + wr * 64 + fr; const bool isz = u.pn >= 8; const int colt = (u.pn & 7) * BM + wc * 32 + 8 * fq;
        float rs[8]; rstd16x8(rs, SSQ, row0, fq, 1.0f / DM);
#pragma unroll
        for (int g = 0; g < 8; ++g) { const int ai = g >> 2, m = g & 3; const int row = EPI_ROW(g);
#pragma unroll
            for (int bj = 0; bj < 2; ++bj) { f32x4 v0 = acc[ai][bj][m][0] * rs[g], v1 = acc[ai][bj][m][1] * rs[g]; const int col = colt + bj * HALF;
                if (isz) { v0 = silu4(v0); v1 = silu4(v1); *(v4u*)(SZ + (size_t)row * EI + col) = pack8(v0, v1); }
                else { const v4u w = pack8(v0, v1); *(v4u*)(U + (size_t)row * EI + col) = w;
                    if (g == 7 && wr == 1) *(v4u*)(HALO + ((size_t)u.pm * 16 + fr) * EI + col) = w; } } }
    }
};
struct EpiPoolGrp {
    bf16* Y; const float* scale;
    __device__ __forceinline__ void operator()(const Acc& acc, const Unit& u, int wr, int wc, int fr, int fq) const {
        const int row0 = u.pm * BM + wr * 64 + fr; const int colt = u.pn * BM + wc * 32 + 8 * fq;
        f32x4 sc[2][2];
#pragma unroll
        for (int bj = 0; bj < 2; ++bj) { sc[bj][0] = *(const f32x4*)(scale + colt + bj * HALF); sc[bj][1] = *(const f32x4*)(scale + colt + bj * HALF + 4); }
#pragma unroll
        for (int ai = 0; ai < 2; ++ai) { v4u s[4][2];
#pragma unroll
            for (int m = 0; m < 4; ++m)
#pragma unroll
                for (int bj = 0; bj < 2; ++bj) s[m][bj] = *(const v4u*)(Y + (size_t)EPI_ROW(4 * ai + m) * EI + colt + bj * HALF);
#pragma unroll
            for (int m = 0; m < 4; ++m)
#pragma unroll
                for (int bj = 0; bj < 2; ++bj) { const v4u z = s[m][bj];
                    f32x4 v0 = acc[ai][bj][m][0] * sc[bj][0], v1 = acc[ai][bj][m][1] * sc[bj][1];
                    v0 = v0 * (f32x4){bflo(z.x), bfhi(z.x), bflo(z.y), bfhi(z.y)}; v1 = v1 * (f32x4){bflo(z.z), bfhi(z.z), bflo(z.w), bfhi(z.w)};
                    *(v4u*)(Y + (size_t)EPI_ROW(4 * ai + m) * EI + colt + bj * HALF) = pack8(v0, v1); }
            asm volatile("" ::: "memory"); }
    }
};
template <bool IN_F32, bool OUT_F32>
struct EpiResid {
    const float* Xin; float* Xout; bf16* XB; float* SSQ;
    __device__ __forceinline__ void operator()(const Acc& acc, const Unit& u, int wr, int wc, int fr, int fq) const {
        const int row0 = u.pm * BM + wr * 64 + fr; const int colt = u.pn * BM + wc * 32 + 8 * fq;
#pragma unroll
        for (int ai = 0; ai < 2; ++ai) { f32x4 x[4][2][2];
#pragma unroll
            for (int m = 0; m < 4; ++m)
#pragma unroll
                for (int bj = 0; bj < 2; ++bj) { const size_t off = (size_t)EPI_ROW(4 * ai + m) * DM + colt + bj * HALF;
                    if (IN_F32) { x[m][bj][0] = *(const f32x4*)(Xin + off); x[m][bj][1] = *(const f32x4*)(Xin + off + 4); }
                    else { const v4u z = *(const v4u*)(XB + off); x[m][bj][0] = (f32x4){bflo(z.x), bfhi(z.x), bflo(z.y), bfhi(z.y)}; x[m][bj][1] = (f32x4){bflo(z.z), bfhi(z.z), bflo(z.w), bfhi(z.w)}; } }
#pragma unroll
            for (int m = 0; m < 4; ++m) { const int row = EPI_ROW(4 * ai + m); float ss = 0.f;
#pragma unroll
                for (int bj = 0; bj < 2; ++bj) { const size_t off = (size_t)row * DM + colt + bj * HALF;
                    const f32x4 v0 = x[m][bj][0] + acc[ai][bj][m][0], v1 = x[m][bj][1] + acc[ai][bj][m][1];
                    if (OUT_F32) { *(f32x4*)(Xout + off) = v0; *(f32x4*)(Xout + off + 4) = v1; }
                    else { const v4u w = pack8(v0, v1); *(v4u*)(XB + off) = w;
                        ss += sq8((f32x4){bflo(w.x), bfhi(w.x), bflo(w.y), bfhi(w.y)}, (f32x4){bflo(w.z), bfhi(w.z), bflo(w.w), bfhi(w.w)}); } }
                if (!OUT_F32) { ss = fq_sum(ss); if (fq == 0) SSQ[(size_t)row * 16 + u.pn * 4 + wc] = ss; } }
            asm volatile("" ::: "memory"); }
    }
};
struct EpiConvIn {
    bf16* CH; bf16* BZ; const float* SSQ;
    __device__ __forceinline__ void operator()(const Acc& acc, const Unit& u, int wr, int wc, int fr, int fq) const {
        const int row0 = u.pm * BM + wr * 64 + fr; const int j0 = u.pn * 64 + (wc & 1) * 32 + 8 * fq; const bool isch = wc >= 2;
        float rs[8]; rstd16x8(rs, SSQ, row0, fq, 1.0f / DM);
#pragma unroll
        for (int g = 0; g < 8; ++g) { const int ai = g >> 2, m = g & 3; const int row = EPI_ROW(g); const float r = rs[g];
            const f32x4 p0 = acc[ai][0][m][0] * r, p1 = acc[ai][0][m][1] * r, q0 = acc[ai][1][m][0] * r, q1 = acc[ai][1][m][1] * r;
            if (isch) *(v4u*)(CH + (size_t)row * EI + j0) = pack8(p0 * q0, p1 * q1);
            else *(v4u*)(BZ + (size_t)row * EI + j0) = pack8(p0 * silu4(q0), p1 * silu4(q1)); }
    }
};
__device__ __forceinline__ v4u rope8v(f32x4 x1, f32x4 x2, f32x4 c, f32x4 s) { return pack8(x1 * c - x2 * s, x2 * c + x1 * s); }
struct EpiMlaIn {
    bf16* KVLAT; bf16* QLAT; bf16* KROPE; float* SSQKV; float* SSQQ; const float* SSQ; const float* COS; const float* SIN;
    __device__ __forceinline__ void operator()(const Acc& acc, const Unit& u, int wr, int wc, int fr, int fq) const {
        const int row0 = u.pm * BM + wr * 64 + fr; const int cl = wc * 32 + 8 * fq;
        float rs[8]; rstd16x8(rs, SSQ, row0, fq, 1.0f / DM);
        const bool dorope = u.pn == 2 && wc < 2; const int ii = 16 * (wc & 1) + 4 * fq;
#pragma unroll
        for (int ai = 0; ai < 2; ++ai) { f32x4 cs[4][2];
            if (dorope) {
#pragma unroll
                for (int m = 0; m < 4; ++m) { const size_t ro = (size_t)EPI_ROW(4 * ai + m) * 32 + ii; cs[m][0] = *(const f32x4*)(COS + ro); cs[m][1] = *(const f32x4*)(SIN + ro); } }
#pragma unroll
            for (int m = 0; m < 4; ++m) { const int row = EPI_ROW(4 * ai + m); const float r = rs[4 * ai + m];
                const f32x4 a0 = acc[ai][0][m][0] * r, a1 = acc[ai][0][m][1] * r, b0 = acc[ai][1][m][0] * r, b1 = acc[ai][1][m][1] * r;
                if (u.pn == 0) { *(v4u*)(KVLAT + (size_t)row * KVL + cl) = pack8(a0, a1); *(v4u*)(KVLAT + (size_t)row * KVL + HALF + cl) = pack8(b0, b1);
                    const float ss = fq_sum(sq8(a0, a1) + sq8(b0, b1)); if (fq == 0) SSQKV[(size_t)row * 4 + wc] = ss; }
                else if (u.pn == 1) { *(v4u*)(QLAT + (size_t)row * QL + cl) = pack8(a0, a1); *(v4u*)(QLAT + (size_t)row * QL + HALF + cl) = pack8(b0, b1);
                    const float ss = fq_sum(sq8(a0, a1) + sq8(b0, b1)); if (fq == 0) SSQQ[(size_t)row * 8 + wc] = ss; }
                else { *(v4u*)(QLAT + (size_t)row * QL + 256 + cl) = pack8(a0, a1);
                    const float ss = fq_sum(sq8(a0, a1)); if (fq == 0) SSQQ[(size_t)row * 8 + 4 + wc] = ss;
                    if (dorope) *(v4u*)(KROPE + (size_t)row * RD + cl) = rope8v(b0, b1, cs[m][0], cs[m][1]); } }
            asm volatile("" ::: "memory"); }
    }
};
struct EpiQUp {
    bf16* QN; bf16* QR; const float* SSQQ; const float* COS; const float* SIN;
    __device__ __forceinline__ void operator()(const Acc& acc, const Unit& u, int wr, int wc, int fr, int fq) const {
        const int row0 = u.pm * BM + wr * 64 + fr; const int cl = wc * 32 + 8 * fq;
        float rs[8];
        { f32x2 pq[8];
#pragma unroll
          for (int g = 0; g < 8; ++g) pq[g] = *(const f32x2*)(SSQQ + (size_t)EPI_ROW(g) * 8 + fq * 2);
#pragma unroll
          for (int g = 0; g < 8; ++g) rs[g] = 1.0f / sqrtf(fq_sum(pq[g][0] + pq[g][1]) * (1.0f / QL) + NORM_EPS); }
        const int hh = u.pn >= 6 ? 1 : 0, pnl = u.pn - 6 * hh; const bool isr = pnl >= 4; const int ii = 16 * (wc & 1) + 4 * fq;
#pragma unroll
        for (int ai = 0; ai < 2; ++ai) { f32x4 cs[4][2];
            if (isr) {
#pragma unroll
                for (int m = 0; m < 4; ++m) { const size_t ro = (size_t)EPI_ROW(4 * ai + m) * 32 + ii; cs[m][0] = *(const f32x4*)(COS + ro); cs[m][1] = *(const f32x4*)(SIN + ro); } }
#pragma unroll
            for (int m = 0; m < 4; ++m) { const int row = EPI_ROW(4 * ai + m); const float r = rs[4 * ai + m];
#pragma unroll
                for (int bj = 0; bj < 2; ++bj) { const f32x4 v0 = acc[ai][bj][m][0] * r, v1 = acc[ai][bj][m][1] * r;
                    if (!isr) *(v4u*)(QN + (size_t)row * EI + hh * 1024 + pnl * BM + bj * HALF + cl) = pack8(v0, v1);
                    else { const int hl = hh * 8 + (pnl - 4) * 4 + 2 * bj + (wc >> 1);
                        *(v4u*)(QR + (size_t)row * 1024 + hl * RD + 32 * (wc & 1) + 8 * fq) = rope8v(v0, v1, cs[m][0], cs[m][1]); } } }
            asm volatile("" ::: "memory"); }
    }
};
struct EpiKvUp {
    bf16* KV0; bf16* KV1; const float* SSQKV;
    __device__ __forceinline__ void operator()(const Acc& acc, const Unit& u, int wr, int wc, int fr, int fq) const {
        const int row0 = u.pm * BM + wr * 64 + fr; const int cl = (u.pn & 7) * DN + wc * 32 + 8 * fq; bf16* KN = u.pn >= 8 ? KV1 : KV0; bf16* V = KN + (size_t)M * 1024;
        float rs[8];
#pragma unroll
        for (int g = 0; g < 8; ++g) rs[g] = SSQKV[(size_t)EPI_ROW(g) * 4 + fq];
#pragma unroll
        for (int g = 0; g < 8; ++g) rs[g] = 1.0f / sqrtf(fq_sum(rs[g]) * (1.0f / KVL) + NORM_EPS);
#pragma unroll
        for (int g = 0; g < 8; ++g) { const int ai = g >> 2, m = g & 3; const int row = EPI_ROW(g);
            *(v4u*)(KN + (size_t)row * 1024 + cl) = pack8(acc[ai][0][m][0] * rs[g], acc[ai][0][m][1] * rs[g]);
            *(v4u*)(V + (size_t)row * 1024 + cl) = pack8(acc[ai][1][m][0] * rs[g], acc[ai][1][m][1] * rs[g]); }
    }
};
struct EpiGate {
    bf16* Y; const float* SSQ;
    __device__ __forceinline__ void operator()(const Acc& acc, const Unit& u, int wr, int wc, int fr, int fq) const {
        const int row0 = u.pm * BM + wr * 64 + fr; const int colt = u.pn * BM + wc * 32 + 8 * fq;
        float rs[8]; rstd16x8(rs, SSQ, row0, fq, 1.0f / DM);
#pragma unroll
        for (int ai = 0; ai < 2; ++ai) { v4u s[4][2];
#pragma unroll
            for (int m = 0; m < 4; ++m)
#pragma unroll
                for (int bj = 0; bj < 2; ++bj) s[m][bj] = *(const v4u*)(Y + (size_t)EPI_ROW(4 * ai + m) * EI + colt + bj * HALF);
#pragma unroll
            for (int m = 0; m < 4; ++m)
#pragma unroll
                for (int bj = 0; bj < 2; ++bj) { const v4u z = s[m][bj]; const float r = rs[4 * ai + m];
                    const f32x4 v0 = silu4(acc[ai][bj][m][0] * r) * (f32x4){bflo(z.x), bfhi(z.x), bflo(z.y), bfhi(z.y)};
                    const f32x4 v1 = silu4(acc[ai][bj][m][1] * r) * (f32x4){bflo(z.z), bfhi(z.z), bflo(z.w), bfhi(z.w)};
                    *(v4u*)(Y + (size_t)EPI_ROW(4 * ai + m) * EI + colt + bj * HALF) = pack8(v0, v1); }
            asm volatile("" ::: "memory"); }
    }
};
#undef EPI_ROW
}

namespace att {
constexpr int NW = 8, QBLK = 32, KVBLK = 64, QB = NW * QBLK, D = 128;
constexpr int PQN = 2048, PQR = 1024, PKV = 1024, PKR = 64;
constexpr int SHM_V = KVBLK * D * 2, SHM_K = KVBLK * D * 2, KR_ROWB = 144, SHM_KR = KVBLK * KR_ROWB;
constexpr int OFF_K = 2 * SHM_V, OFF_KR = 2 * SHM_V + 2 * SHM_K, OFF_WS = OFF_KR + 2 * SHM_KR;
constexpr int OFF_QRL = OFF_WS + NW * 64 * 4;
constexpr int NQREG = 4;
constexpr int QRL_WAVE = (12 - NQREG) * 1024;
constexpr int LDS_BYTES = OFF_QRL + NW * QRL_WAVE;
constexpr float SCALE = ATTN_SCALE;
constexpr float THR = 8.f;
#define KSWZ(row, colB) ((row) * 256 + ((colB) ^ (((row) & 7) << 4)))
#define SBAR() __builtin_amdgcn_sched_barrier(0)
__device__ __forceinline__ int v_st(int k, int c) { const int kk = (k & ~0xC) | ((k & 4) << 1) | ((k & 8) >> 1); return ((kk >> 3) * 4 + (c >> 5)) * 512 + ((kk & 7) * 32 + (c & 31)) * 2; }
__device__ __forceinline__ int v_rd_base(int lane) { return ((lane & 3) << 3) | (((lane >> 2) & 3) << 6) | (((lane >> 4) & 1) << 5) | (((lane >> 5) & 1) << 8); }
constexpr int v_rd_off(int d0, int ks, int half) { return d0 * 512 + ks * 4096 + half * 2048; }
__device__ __forceinline__ int crow(int r, int hi) { return (r & 3) + 8 * (r >> 2) + 4 * hi; }
__device__ __forceinline__ unsigned cvtpk(float lo, float hi) { unsigned r; asm volatile("v_cvt_pk_bf16_f32 %0, %1, %2" : "=v"(r) : "v"(lo), "v"(hi)); return r; }
__device__ __forceinline__ bf16x8 load8(const bf16* p) { return *reinterpret_cast<const bf16x8*>(p); }
__device__ __forceinline__ void mask_tile(f32x16& p0, f32x16& p1, int dq) {
    const float NEG = -__builtin_inff();
#pragma unroll
    for (int r = 0; r < 16; ++r) {
        const int c = (r & 3) + 8 * (r >> 2);
        if (dq - c < 0) p0[r] = NEG;
        if (dq - c - 32 < 0) p1[r] = NEG;
    }
}
__device__ __forceinline__ void partialSM(f32x16& p0, f32x16& p1, float& m_reg, float& mn, float& alpha) {
    float pmax = p0[0]; for (int r = 1; r < 16; ++r) pmax = fmaxf(pmax, p0[r]); for (int r = 0; r < 16; ++r) pmax = fmaxf(pmax, p1[r]);
    { auto rr = __builtin_amdgcn_permlane32_swap(__float_as_uint(pmax), __float_as_uint(pmax), false, false);
      pmax = fmaxf(__uint_as_float(rr[0]), __uint_as_float(rr[1])); }
    constexpr float C2 = 1.4426950408889634f * SCALE;
    if (__builtin_expect(__all((pmax - m_reg) * SCALE <= THR), 1)) { mn = m_reg; alpha = 1.f; }
    else { mn = fmaxf(m_reg, pmax); alpha = __builtin_amdgcn_exp2f((m_reg - mn) * C2); m_reg = mn; }
    const float mnL = -mn * C2;
    for (int r = 0; r < 16; ++r) p0[r] = fmaf(p0[r], C2, mnL); for (int r = 0; r < 16; ++r) p1[r] = fmaf(p1[r], C2, mnL);
    for (int r = 0; r < 16; ++r) p0[r] = __builtin_amdgcn_exp2f(p0[r]);
}
__device__ __forceinline__ void finishSM(f32x16& p0, f32x16& p1, float alpha, float& l_reg, bf16x8& pa0, bf16x8& pa1, bf16x8& pa2, bf16x8& pa3) {
    for (int r = 0; r < 16; ++r) p1[r] = __builtin_amdgcn_exp2f(p1[r]);
    float ps = 0; for (int r = 0; r < 16; ++r) ps += p0[r]; for (int r = 0; r < 16; ++r) ps += p1[r];
    { auto rr = __builtin_amdgcn_permlane32_swap(__float_as_uint(ps), __float_as_uint(ps), false, false);
      ps = __uint_as_float(rr[0]) + __uint_as_float(rr[1]); }
    l_reg = l_reg * alpha + ps;
#define PK4(P, B_, OUT) do { unsigned a0 = cvtpk(P[B_+0], P[B_+1]), a1 = cvtpk(P[B_+2], P[B_+3]);                          \
        unsigned b0 = cvtpk(P[B_+4], P[B_+5]), b1 = cvtpk(P[B_+6], P[B_+7]);                                             \
        auto r0 = __builtin_amdgcn_permlane32_swap(a0, b0, false, false); auto r1 = __builtin_amdgcn_permlane32_swap(a1, b1, false, false); \
        v4u w = {r0[0], r1[0], r0[1], r1[1]}; OUT = *reinterpret_cast<bf16x8*>(&w); } while (0)
    PK4(p0, 0, pa0); PK4(p0, 8, pa1); PK4(p1, 0, pa2); PK4(p1, 8, pa3);
#undef PK4
}
template <int KB>
__device__ __forceinline__ void qkt(f32x16& p0, f32x16& p1, const char* lds, int r32, int hi, const bf16x8* qr, const char* qrl) {
    p0 = f32x16{}; p1 = f32x16{};
    const char* kb[4];
#pragma unroll
    for (int dd = 0; dd < 4; ++dd) kb[dd] = lds + OFF_K + KB * SHM_K + KSWZ(r32, (dd * 16 + hi * 8) * 2);
#pragma unroll
    for (int d0 = 0; d0 < 8; ++d0) { const char* a = kb[d0 & 3] + (d0 >> 2) * 128;
        bf16x8 b0 = *reinterpret_cast<const bf16x8*>(a);
        bf16x8 b1 = *reinterpret_cast<const bf16x8*>(a + 32 * 256);
        bf16x8 qf; if (d0 < NQREG) qf = qr[d0]; else qf = *reinterpret_cast<const bf16x8*>(qrl + (4 + d0 - NQREG) * 1024);
        p0 = __builtin_amdgcn_mfma_f32_32x32x16_bf16(b0, qf, p0, 0, 0, 0);
        p1 = __builtin_amdgcn_mfma_f32_32x32x16_bf16(b1, qf, p1, 0, 0, 0); }
    const char* kr = lds + OFF_KR + KB * SHM_KR + r32 * KR_ROWB + hi * 16;
#pragma unroll
    for (int d0 = 0; d0 < 4; ++d0) {
        bf16x8 b0 = *reinterpret_cast<const bf16x8*>(kr + d0 * 32);
        bf16x8 b1 = *reinterpret_cast<const bf16x8*>(kr + d0 * 32 + 32 * KR_ROWB);
        const bf16x8 qf = *reinterpret_cast<const bf16x8*>(qrl + d0 * 1024);
        p0 = __builtin_amdgcn_mfma_f32_32x32x16_bf16(b0, qf, p0, 0, 0, 0);
        p1 = __builtin_amdgcn_mfma_f32_32x32x16_bf16(b1, qf, p1, 0, 0, 0); }
}
template <int VB>
__device__ __forceinline__ void pv_tile(f32x16* o, int vb0, bf16x8 pa0, bf16x8 pa1, bf16x8 pa2, bf16x8 pa3) {
#define TRRD(dst, off) asm volatile("ds_read_b64_tr_b16 %0, %1 offset:%2" : "=&v"(dst) : "v"(vb0), "i"(off) : "memory")
#define PV_D0(d0) do { s16x4 l0, l1, l2, l3, h0, h1, h2, h3; constexpr int b_ = VB * SHM_V + v_rd_off(d0, 0, 0); \
        TRRD(l0, b_); TRRD(h0, b_ + 2048); TRRD(l1, b_ + 4096); TRRD(h1, b_ + 6144); TRRD(l2, b_ + 8192); TRRD(h2, b_ + 10240); TRRD(l3, b_ + 12288); TRRD(h3, b_ + 14336); \
        asm volatile("s_waitcnt lgkmcnt(0)" ::: "memory"); SBAR();   \
        o[d0] = __builtin_amdgcn_mfma_f32_32x32x16_bf16(pa0, (bf16x8){l0[0], l0[1], l0[2], l0[3], h0[0], h0[1], h0[2], h0[3]}, o[d0], 0, 0, 0);   \
        o[d0] = __builtin_amdgcn_mfma_f32_32x32x16_bf16(pa1, (bf16x8){l1[0], l1[1], l1[2], l1[3], h1[0], h1[1], h1[2], h1[3]}, o[d0], 0, 0, 0);   \
        o[d0] = __builtin_amdgcn_mfma_f32_32x32x16_bf16(pa2, (bf16x8){l2[0], l2[1], l2[2], l2[3], h2[0], h2[1], h2[2], h2[3]}, o[d0], 0, 0, 0);   \
        o[d0] = __builtin_amdgcn_mfma_f32_32x32x16_bf16(pa3, (bf16x8){l3[0], l3[1], l3[2], l3[3], h3[0], h3[1], h3[2], h3[3]}, o[d0], 0, 0, 0); } while (0)
    PV_D0(0); PV_D0(1); PV_D0(2); PV_D0(3);
#undef PV_D0
#undef TRRD
}
struct BlockRef { const bf16* Q; const bf16* QR; const bf16* K; const bf16* V; const bf16* KR; bf16* O; int P0; };
struct Seam { bf16x8 qr[NQREG]; bf16x8 st_v0, st_v1, st_k0, st_k1, st_kr; };
#define ROWKV(p, k0, rr) ((p) + (size_t)((k0) + (rr)) * PKV + sc)
#define VMW() asm volatile("s_waitcnt vmcnt(0)" ::: "memory")
#define VMWN(n) asm volatile("s_waitcnt vmcnt(%0)" :: "i"(n) : "memory")
#define SLOAD_H(Kp, Vp, KRp, k0) do { S.st_v0 = load8(ROWKV(Vp, k0, sr)); S.st_v1 = load8(ROWKV(Vp, k0, 32 + sr));              \
                         S.st_k0 = load8(ROWKV(Kp, k0, sr)); S.st_k1 = load8(ROWKV(Kp, k0, 32 + sr)); S.st_kr = load8((KRp) + (size_t)((k0) + krr) * PKR + krc); } while (0)
#define SWRITE_HK(bf) do { *(bf16x8*)(K_lds + (bf) * SHM_K + kws) = S.st_k0; *(bf16x8*)(K_lds + (bf) * SHM_K + kws + 32 * 256) = S.st_k1; *(bf16x8*)(KR_lds + (bf) * SHM_KR + krws) = S.st_kr; } while (0)
#define SWRITE_HV(bf) do { *(bf16x8*)(V_lds + (bf) * SHM_V + vst0) = S.st_v0; *(bf16x8*)(V_lds + (bf) * SHM_V + vst1) = S.st_v1; } while (0)
#define SWRITE_H(bf) do { SWRITE_HV(bf); SWRITE_HK(bf); } while (0)
#define QLOAD(R) do { _Pragma("unroll") for (int d0 = 0; d0 < NQREG; ++d0) S.qr[d0] = load8((R).Q + (size_t)(wid * QBLK + r32) * PQN + d0 * 16 + hi * 8); } while (0)
#define QRLOAD(R) do { _Pragma("unroll") for (int d0 = 0; d0 < 4; ++d0) *(bf16x8*)(qrl + d0 * 1024) = load8((R).QR + (size_t)(wid * QBLK + r32) * PQR + d0 * 16 + hi * 8); \
                       _Pragma("unroll") for (int d0 = NQREG; d0 < 8; ++d0) *(bf16x8*)(qrl + (4 + d0 - NQREG) * 1024) = load8((R).Q + (size_t)(wid * QBLK + r32) * PQN + d0 * 16 + hi * 8); } while (0)
__device__ __forceinline__ void attn_prime(const BlockRef& cur, char* lds, Seam& S) {
    int tid_ = threadIdx.x; asm volatile("" : "+v"(tid_));
    const int tid = tid_, wid = __builtin_amdgcn_readfirstlane(tid >> 6), lane = tid & 63, r32 = lane & 31, hi = lane >> 5;
    const int sr = tid >> 4, sc = (tid & 15) * 8, kws = KSWZ(sr, sc * 2); char* K_lds = lds + OFF_K; char* KR_lds = lds + OFF_KR;
    const int krr = tid >> 3, krc = (tid & 7) * 8, krws = krr * KR_ROWB + krc * 2;
    char* qrl = lds + OFF_QRL + wid * QRL_WAVE + lane * 16;
    QLOAD(cur); QRLOAD(cur);
    SLOAD_H(cur.K, cur.V, cur.KR, 0); VMW(); SWRITE_HK(0);
    __syncthreads();
}
__device__ __forceinline__ void attn_block(const BlockRef& cur, const BlockRef& nxt, char* lds, Seam& S) {
    int tid_ = threadIdx.x; asm volatile("" : "+v"(tid_));
    const int tid = tid_, wid = __builtin_amdgcn_readfirstlane(tid >> 6), lane = tid & 63, r32 = lane & 31, hi = lane >> 5;
    const int NT = (cur.P0 + QB) / KVBLK;
    const int qlo = cur.P0 + wid * QBLK, qm = qlo + r32 - 4 * hi;
    char* V_lds = lds; char* K_lds = lds + OFF_K; char* KR_lds = lds + OFF_KR;
    float* ws = (float*)(lds + OFF_WS) + wid * 64; float* li_l = ws, * al_l = ws + 32;
    float m_reg = -1e30f, l_reg = 0; f32x16 o[4] = {};
    const int sr = tid >> 4, sc = (tid & 15) * 8, vst0 = v_st(sr, sc), vst1 = v_st(32 + sr, sc), kws = KSWZ(sr, sc * 2);
    const int krr = tid >> 3, krc = (tid & 7) * 8, krws = krr * KR_ROWB + krc * 2;
    const int vb0 = (int)(uintptr_t)V_lds + v_rd_base(lane);
    char* qrl = lds + OFF_QRL + wid * QRL_WAVE + lane * 16;
    const bf16* Kh = cur.K; const bf16* Vh = cur.V; const bf16* KRh = cur.KR;
#define RESC(a) do { if (__any((a) < 1.f)) { if (hi == 0) al_l[r32] = (a); asm volatile("s_waitcnt lgkmcnt(0)" ::: "memory");              \
                     for (int d_ = 0; d_ < 4; ++d_) for (int r = 0; r < 16; ++r) o[d_][r] *= al_l[crow(r, hi)]; } } while (0)
#define KBASE(t) ((t) * KVBLK)
#define MASKT(P0_, P1_, t) do { const int kb_ = KBASE(t); if (kb_ + KVBLK - 1 > qlo) mask_tile(P0_, P1_, qm - kb_); } while (0)
    constexpr int NQL = NQREG;
#define SEAM_K0() do { VMWN(NQL); SWRITE_HK(0); SBAR(); } while (0)
    f32x16 pA0, pA1, pB0, pB1; float mnA, mnB, alA, alB; bf16x8 pa0, pa1, pa2, pa3;
    SWRITE_HV(0); SBAR();
    if (NT > 1) { SLOAD_H(Kh, Vh, KRh, KBASE(1)); }
    SBAR(); qkt<0>(pA0, pA1, lds, r32, hi, S.qr, qrl);
    MASKT(pA0, pA1, 0); partialSM(pA0, pA1, m_reg, mnA, alA);
    if (NT > 1) { VMW(); SWRITE_H(1); }
    __syncthreads();
#define HALF_STEP(PX0, PX1, mnX, alX, PY0, PY1, alY, t, KB, VB, SB) do {                                                      \
        SBAR(); qkt<KB>(PX0, PX1, lds, r32, hi, S.qr, qrl);                                             \
        finishSM(PY0, PY1, alY, l_reg, pa0, pa1, pa2, pa3); SBAR();                                                           \
        if ((t) + 1 < NT) { SLOAD_H(Kh, Vh, KRh, KBASE((t) + 1)); SBAR(); }                                               \
        pv_tile<VB>(o, vb0, pa0, pa1, pa2, pa3); MASKT(PX0, PX1, (t)); partialSM(PX0, PX1, m_reg, mnX, alX);                                        \
        __syncthreads();                                                                                                      \
        if ((t) + 1 < NT) { VMW(); SWRITE_H(SB); }                                                                          \
        RESC(alX); __syncthreads(); } while (0)
    for (int t = 1; t + 1 < NT; t += 2) {
        HALF_STEP(pB0, pB1, mnB, alB, pA0, pA1, alA, t, 1, 0, 0);
        HALF_STEP(pA0, pA1, mnA, alA, pB0, pB1, alB, t + 1, 0, 1, 1);
    }
    const bool even = (NT & 1) == 0;
    if (even) { SBAR(); qkt<1>(pB0, pB1, lds, r32, hi, S.qr, qrl); SBAR(); }
    SLOAD_H(nxt.K, nxt.V, nxt.KR, 0); SBAR();
    QLOAD(nxt);
    SBAR();
    finishSM(pA0, pA1, alA, l_reg, pa0, pa1, pa2, pa3); SBAR();
    pv_tile<0>(o, vb0, pa0, pa1, pa2, pa3);
    if (even) { MASKT(pB0, pB1, NT - 1); partialSM(pB0, pB1, m_reg, mnB, alB); __syncthreads(); RESC(alB);
        finishSM(pB0, pB1, alB, l_reg, pa0, pa1, pa2, pa3); SBAR(); pv_tile<1>(o, vb0, pa0, pa1, pa2, pa3); }
    SBAR(); SEAM_K0();
    if (hi == 0) li_l[r32] = l_reg; asm volatile("s_waitcnt lgkmcnt(0)" ::: "memory");
    float rli[16];
#pragma unroll
    for (int r = 0; r < 16; ++r) rli[r] = __builtin_amdgcn_rcpf(li_l[crow(r, hi)]);
    int hio = hi; asm volatile("" : "+v"(hio));
    bf16* Ow = cur.O + (size_t)(wid * QBLK + 4 * hio) * PQN + r32;
#pragma unroll
    for (int r = 0; r < 16; ++r) { const int orow = (r & 3) + 8 * (r >> 2);
#pragma unroll
        for (int d0 = 0; d0 < 4; ++d0) { const float v = o[d0][r] * rli[r];
            const float vn = __shfl_xor(v, 1);
            if ((r32 & 1) == 0) *(unsigned*)(Ow + (size_t)orow * PQN + d0 * 32) = cvtpk(v, vn); }
        if ((r & 3) == 3) asm volatile("" ::: "memory"); }
    QRLOAD(nxt);
    __syncthreads();
#undef RESC
#undef KBASE
#undef MASKT
#undef SEAM_K0
#undef HALF_STEP
}
#undef ROWKV
#undef VMW
#undef VMWN
#undef SLOAD_H
#undef SWRITE_HK
#undef SWRITE_HV
#undef SWRITE_H
#undef QLOAD
#undef QRLOAD
#undef KSWZ
#undef SBAR
__device__ __forceinline__ BlockRef block_ref(int L, int pass, const bf16* QN, const bf16* QR, const bf16* KV0, const bf16* KV1, const bf16* KR, bf16* O) {
    const int hh = L >> 8, Ll = L & 255, x = Ll & 7, k = Ll >> 3, bh = x * 4 + (k >> 3), y = k & 7, b = bh >> 3, h8 = bh & 7, qb = pass ? 15 - y : y;
    const size_t row0 = (size_t)b * SEQ + (size_t)qb * QB, rowb = (size_t)b * SEQ;
    const bf16* KN = hh ? KV1 : KV0; const bf16* V = KN + (size_t)M * 1024;
    BlockRef r;
    r.Q = QN + row0 * PQN + (hh * 8 + h8) * DN; r.O = O + row0 * PQN + (hh * 8 + h8) * DN; r.QR = QR + row0 * PQR + (hh * 8 + h8) * RD;
    r.K = KN + rowb * PKV + h8 * DN; r.V = V + rowb * PKV + h8 * DV; r.KR = KR + rowb * PKR; r.P0 = qb * QB;
    return r;
}
__device__ __forceinline__ void attn_phase(char* lds, const bf16* QN, const bf16* QR, const bf16* KV0, const bf16* KV1, const bf16* KR, bf16* O, int bid, int G) {
    constexpr int NITEM = 512;
    int L = bid; if (L >= NITEM) return;
    int pass = 0;
    BlockRef cur = block_ref(L, 0, QN, QR, KV0, KV1, KR, O);
    Seam S;
    attn_prime(cur, lds, S);
    for (;;) {
        const bool more_pass = pass == 0, more_item = L + G < NITEM, last = !more_pass && !more_item;
        int passn = pass + 1, Ln = L;
        if (!more_pass) { passn = 0; Ln = more_item ? L + G : L; }
        const BlockRef nxt = last ? cur : block_ref(Ln, passn, QN, QR, KV0, KV1, KR, O);
        attn_block(cur, nxt, lds, S);
        if (last) break;
        cur = nxt; pass = passn; L = Ln;
    }
}
}

constexpr int NWAVES = 8;
constexpr int NPH = 18;
constexpr int N_LAUNCHES = MK_N_LAUNCHES;
static_assert(N_LAUNCHES == 1 || N_LAUNCHES == NPH, "MK_N_LAUNCHES is 1 or NPH");
constexpr int CW_BAR = 4096;
constexpr int RING_OFF = 0, RING_BYTES = 155648;
constexpr int LDSCTL_OFF = RING_BYTES, MISC_OFF = LDSCTL_OFF + 320;
constexpr int LDS_BYTES = RING_BYTES + 1024;
static_assert(att::LDS_BYTES <= RING_BYTES, "attention LDS");

#define XB_TMO      128
#define XB_XCNT(j)  (256  + 64 * (j))
#define XB_XSUB(j)  (1280 + 64 * (j))
#define XB_XGEN(j)  (2304 + 64 * (j))
#define XB_TOP      3328
#define XB_TOPGEN   3392
#define XCD_BAR_WORDS 3456
#define XB_SPIN_CAP (1u << 18)
__device__ __forceinline__ unsigned xb_ld(unsigned* p)              { return __hip_atomic_load(p, __ATOMIC_RELAXED, __HIP_MEMORY_SCOPE_AGENT); }
__device__ __forceinline__ unsigned xb_add(unsigned* p, unsigned v) { return __hip_atomic_fetch_add(p, v, __ATOMIC_RELAXED, __HIP_MEMORY_SCOPE_AGENT); }
__device__ __forceinline__ unsigned xb_xcc_id() { return (unsigned)__builtin_amdgcn_s_getreg((3 << 11) | 20) & 0xFu; }
#define XB_SPIN(cond, bar) do { unsigned _sp = 0; while (cond) { __builtin_amdgcn_s_sleep(1); \
    if ((++_sp & 255u) == 0u) { if (xb_ld(&(bar)[XB_TMO])) break; if (_sp > XB_SPIN_CAP) { atomicAdd(&(bar)[XB_TMO], 1u); break; } } } } while (0)
struct XcdBarrier { unsigned* bar; unsigned x; volatile LAS unsigned* st; };
__device__ __forceinline__ XcdBarrier xcd_barrier_post(unsigned* bar, volatile LAS unsigned* st) {
    XcdBarrier b; b.bar = bar; b.x = xb_xcc_id(); b.st = st;
    if (threadIdx.x == 0) (void)xb_add(&bar[XB_XCNT(b.x)], 1u);
    return b;
}
__device__ __forceinline__ void xcd_barrier_complete(unsigned* bar, unsigned x, unsigned& nloc, unsigned& nx) {
    const unsigned G = gridDim.x * gridDim.y * gridDim.z;
    unsigned sum, cnt, mine, sp = 0u;
    for (;;) {
        sum = 0u; cnt = 0u; mine = 0u;
#pragma unroll
        for (unsigned j = 0; j < 16; ++j) { const unsigned c = xb_ld(&bar[XB_XCNT(j)]); sum += c; cnt += (c > 0u) ? 1u : 0u; mine = (j == x) ? c : mine; }
        if (sum == G) break;
        __builtin_amdgcn_s_sleep(1);
        if ((++sp & 255u) == 0u) { if (xb_ld(&bar[XB_TMO])) break; if (sp > XB_SPIN_CAP) { atomicAdd(&bar[XB_TMO], 1u); break; } }
    }
    nloc = mine > 0u ? mine : 1u; nx = cnt > 0u ? cnt : 1u;
}
__device__ __forceinline__ void xcd_barrier(const XcdBarrier& b) {
    asm volatile("s_waitcnt vmcnt(0)" ::: "memory");
    __syncthreads();
    if (threadIdx.x == 0) {
        unsigned* bar = b.bar;
        __builtin_amdgcn_s_waitcnt(0);
        unsigned nloc = b.st[0], nx = b.st[1];
        if (nloc == 0u) { xcd_barrier_complete(bar, b.x, nloc, nx); b.st[0] = nloc; b.st[1] = nx; }
        const unsigned old = xb_add(&bar[XB_XSUB(b.x)], 1u);
        const unsigned gen = old / nloc;
        if (old + 1u == (gen + 1u) * nloc) {
            __builtin_amdgcn_fence(__ATOMIC_RELEASE, "agent");
            asm volatile("s_waitcnt vmcnt(0)" ::: "memory");
            const unsigned og = xb_add(&bar[XB_TOP], 1u);
            const unsigned tg = og / nx;
            if (og + 1u == (tg + 1u) * nx) xb_add(&bar[XB_TOPGEN], 1u);
            else XB_SPIN(xb_ld(&bar[XB_TOPGEN]) == tg, bar);
            __builtin_amdgcn_fence(__ATOMIC_ACQUIRE, "agent");
            xb_add(&bar[XB_XGEN(b.x)], 1u);
            asm volatile("s_waitcnt vmcnt(0)" ::: "memory");
        } else {
            XB_SPIN(xb_ld(&bar[XB_XGEN(b.x)]) == gen, bar);
            __builtin_amdgcn_fence(__ATOMIC_ACQUIRE, "agent");
            asm volatile("s_waitcnt vmcnt(0)" ::: "memory");
        }
    }
    __syncthreads();
}

struct Args { const void* in[19]; float* out; unsigned char* ws; int ph_lo, ph_hi; };
static_assert(sizeof(Args) == 19 * 8 + 8 + 8 + 8, "Args has no padding");

struct Frame { LAS unsigned char* lds; int tid, lane, wave, vcu, G; const Args* ap; };

enum { MAP_ID = 0, MAP_CONV = 1, MAP_MLAIN = 2, MAP_QUP = 3 };
__device__ __forceinline__ int map_row(int mapid, int s) {
    if (mapid == MAP_ID) return s;
    if (mapid == MAP_CONV) { const int kind = s >> 11, j = s & 2047, pn = j >> 6, jl = j & 63;
        const int wchi = (kind == 1 || kind == 2) ? 1 : 0, bj = (kind >= 2) ? 1 : 0;
        return pn * 256 + bj * 128 + (wchi * 2 + (jl >> 5)) * 32 + (jl & 31); }
    if (mapid == MAP_MLAIN) {
        if (s < QL) return 256 + s;
        if (s < QL + KVL) return s - QL;
        if (s < QL + KVL + RD) { const int e = s - (QL + KVL), half = e >> 5, ii = e & 31; return 640 + 32 * (ii >> 4) + 8 * ((ii >> 2) & 3) + 4 * half + (ii & 3); }
        return 768 + (s - (QL + KVL + RD)); }
    { const int h = s / 192, d = s % 192, hh = h >> 3, h8 = h & 7;
        if (d < DN) return hh * 1536 + h8 * DN + d;
        const int e = d - DN, half = e >> 5, ii = e & 31, tr = h8 >> 2, hl = h8 & 3, bj = hl >> 1, wc = (hl & 1) * 2 + (ii >> 4);
        return hh * 1536 + 1024 + tr * 256 + bj * 128 + wc * 32 + 8 * ((ii >> 2) & 3) + 4 * half + (ii & 3); }
}
struct PrepItem { const float* src; const float* gk; bf16* dst; int Nsrc, ldd, mapid, n0; };
__device__ __forceinline__ PrepItem prep_decode(const Args* ap, int it) {
    unsigned char* ws = ap->ws;
#define AIN(i) ((const float*)ap->in[i])
    constexpr int I_PIN = 16 * 128, I_PGRP = 8 * 16, I_POUT = 32 * 32, I_CIN = 16 * 256, I_COUT = 32 * 32, I_MIN = 16 * 86, I_QUP = 6 * 96, I_KVUP = 4 * 128;
    constexpr int I_POOL = I_PIN + 4 * I_PGRP + I_POUT;
    const float* W; const float* gk = nullptr; bf16* WT; int Nsrc, ldd, mapid = MAP_ID; int r = it;
    if (r < 2 * I_POOL) { const int j = r / I_POOL; r -= j * I_POOL; unsigned char* wb = ws + (j ? WS_WPOOL1 : WS_WPOOL0);
        if (r < I_PIN) { W = AIN(3) + (size_t)j * DM * 4096; Nsrc = 4096; gk = AIN(2) + j * DM; WT = (bf16*)(wb + WPOOL_IN); ldd = DM; }
        else if (r < I_PIN + 4 * I_PGRP) { r -= I_PIN; const int g = r / I_PGRP; r -= g * I_PGRP; W = AIN(4) + ((size_t)j * 4 + g) * 512 * 512; Nsrc = 512; WT = (bf16*)(wb + WPOOL_GRP) + (size_t)g * 512 * 512; ldd = 512; }
        else { r -= I_PIN + 4 * I_PGRP; W = AIN(6) + (size_t)j * EI * DM; Nsrc = DM; WT = (bf16*)(wb + WPOOL_OUT); ldd = EI; } }
    else { r -= 2 * I_POOL;
        if (r < I_CIN) { W = AIN(8); Nsrc = 8192; gk = AIN(7); WT = (bf16*)(ws + WS_WCONV_IN); ldd = DM; mapid = MAP_CONV; }
        else if (r < I_CIN + I_COUT) { r -= I_CIN; W = AIN(10); Nsrc = DM; WT = (bf16*)(ws + WS_WCONV_OUT); ldd = EI; }
        else if (r < I_CIN + I_COUT + I_MIN) { r -= I_CIN + I_COUT; W = AIN(12); Nsrc = MLA_IN; gk = AIN(11); WT = (bf16*)(ws + WS_WMLA_B1); ldd = DM; mapid = MAP_MLAIN; }
        else if (r < I_CIN + I_COUT + I_MIN + I_QUP) { r -= I_CIN + I_COUT + I_MIN; W = AIN(14); Nsrc = 3072; gk = AIN(13); WT = (bf16*)(ws + WS_WMLA_QUP); ldd = QL; mapid = MAP_QUP; }
        else if (r < I_CIN + I_COUT + I_MIN + I_QUP + I_KVUP) { r -= I_CIN + I_COUT + I_MIN + I_QUP; W = AIN(16); Nsrc = 4096; gk = AIN(15); WT = (bf16*)(ws + WS_WMLA_KVUP); ldd = KVL; }
        else { r -= I_CIN + I_COUT + I_MIN + I_QUP + I_KVUP; W = AIN(17); Nsrc = DM; WT = (bf16*)(ws + WS_WMLA_OUT); ldd = EI; } }
#undef AIN
    const int nblk = Nsrc / 32, kb = r / nblk, nb = r % nblk, k0 = 64 * kb, n0 = 32 * nb;
    PrepItem d; d.src = W + (size_t)k0 * Nsrc + n0; d.gk = gk ? gk + k0 : nullptr; d.dst = WT + k0; d.Nsrc = Nsrc; d.ldd = ldd; d.mapid = mapid; d.n0 = n0;
    return d;
}
__device__ __forceinline__ void prep_load(const PrepItem& d, float (&v)[32], int lane) {
    const float* p = d.src + (size_t)(lane >> 5) * d.Nsrc + (lane & 31);
#pragma unroll
    for (int i = 0; i < 32; ++i) v[i] = p[(size_t)(2 * i) * d.Nsrc];
}
__device__ __forceinline__ void prep_store(const PrepItem& d, const float (&v)[32], LAS float* scr, int lane) {
    const int c = lane & 7;
    f32x4 g0 = (f32x4){1.f, 1.f, 1.f, 1.f}, g1 = g0;
    if (d.gk) { g0 = *(const f32x4*)(d.gk + 8 * c); g1 = *(const f32x4*)(d.gk + 8 * c + 4); }
#pragma unroll
    for (int i = 0; i < 32; ++i) scr[(2 * i + (lane >> 5)) * 33 + (lane & 31)] = v[i];
    LDS_WAIT(); asm volatile("" ::: "memory");
#pragma unroll
    for (int j = 0; j < 4; ++j) { const int n = (lane >> 3) + 8 * j; const LAS float* s = scr + (8 * c) * 33 + n;
        v4u o; o.x = cvt_pk_bf16(s[0 * 33] * g0[0], s[1 * 33] * g0[1]); o.y = cvt_pk_bf16(s[2 * 33] * g0[2], s[3 * 33] * g0[3]);
        o.z = cvt_pk_bf16(s[4 * 33] * g1[0], s[5 * 33] * g1[1]); o.w = cvt_pk_bf16(s[6 * 33] * g1[2], s[7 * 33] * g1[3]);
        *(GAS v4u*)(d.dst + (size_t)map_row(d.mapid, d.n0 + n) * d.ldd + 8 * c) = o; }
    LDS_WAIT(); asm volatile("" ::: "memory");
}
#define INP(i) ((const float*)F.ap->in[i])
__device__ __forceinline__ void p0_prologue(Frame& F) {
    unsigned char* ws = F.ap->ws;
    LAS float* scr = (LAS float*)(F.lds + RING_OFF + F.wave * 16384);
    const int gw = F.vcu * NWAVES + F.wave, NGW = F.G * NWAVES;
    constexpr int NITEMS = 2 * (16 * 128 + 4 * 8 * 16 + 32 * 32) + 16 * 256 + 32 * 32 + 16 * 86 + 6 * 96 + 4 * 128 + 32 * 32;
    { int it = gw; float va[32], vb[32]; PrepItem da, db;
      if (it < NITEMS) { da = prep_decode(F.ap, it); prep_load(da, va, F.lane); }
      while (it < NITEMS) {
          const int itb = it + NGW; if (itb < NITEMS) { db = prep_decode(F.ap, itb); prep_load(db, vb, F.lane); }
          prep_store(da, va, scr, F.lane);
          if (itb >= NITEMS) break;
          const int ita = itb + NGW; if (ita < NITEMS) { da = prep_decode(F.ap, ita); prep_load(da, va, F.lane); }
          prep_store(db, vb, scr, F.lane);
          it = ita; } }
    for (int i = gw * 64 + F.lane; i < 64 * 128; i += NGW * 64) *(GAS v4u*)((bf16*)(ws + WS_WMLA_B1) + (size_t)704 * DM + (size_t)i * 8) = (v4u){0u, 0u, 0u, 0u};
    { const float* x = INP(0); bf16* XB = (bf16*)(ws + WS_XB); float* SSQ = (float*)(ws + WS_SSQ);
      for (int m = gw; m < M; m += 2 * NGW) { const int m2 = m + NGW; const bool two = m2 < M;
          const GAS f32x4* xr = (const GAS f32x4*)(x + (size_t)m * DM) + F.lane; const GAS f32x4* xr2 = (const GAS f32x4*)(x + (size_t)(two ? m2 : m) * DM) + F.lane; f32x4 v[4], w[4];
#pragma unroll
          for (int j = 0; j < 4; ++j) v[j] = xr[64 * j];
#pragma unroll
          for (int j = 0; j < 4; ++j) w[j] = xr2[64 * j];
          float s = 0.f, s2 = 0.f;
#pragma unroll
          for (int j = 0; j < 4; ++j) { s += (v[j].x * v[j].x + v[j].y * v[j].y) + (v[j].z * v[j].z + v[j].w * v[j].w); s2 += (w[j].x * w[j].x + w[j].y * w[j].y) + (w[j].z * w[j].z + w[j].w * w[j].w); }
          s = wave_sum(s); s2 = wave_sum(s2);
          GAS v2u* o8 = (GAS v2u*)(XB + (size_t)m * DM) + F.lane;
#pragma unroll
          for (int j = 0; j < 4; ++j) o8[64 * j] = (v2u){cvt_pk_bf16(v[j].x, v[j].y), cvt_pk_bf16(v[j].z, v[j].w)};
          if (F.lane < 16) SSQ[(size_t)m * 16 + F.lane] = F.lane == 0 ? s : 0.f;
          if (two) { GAS v2u* p8 = (GAS v2u*)(XB + (size_t)m2 * DM) + F.lane;
#pragma unroll
              for (int j = 0; j < 4; ++j) p8[64 * j] = (v2u){cvt_pk_bf16(w[j].x, w[j].y), cvt_pk_bf16(w[j].z, w[j].w)};
              if (F.lane < 16) SSQ[(size_t)m2 * 16 + F.lane] = F.lane == 0 ? s2 : 0.f; } } }
    { const int* pos = (const int*)F.ap->in[1]; float* COS = (float*)(ws + WS_COS); float* SIN = (float*)(ws + WS_SIN);
      for (int e = F.vcu * (NWAVES * 64) + F.tid; e < M * 32; e += F.G * NWAVES * 64) { const int row = e >> 5, i = e & 31;
          const float invf = powf(ROPE_BASE, -(float)(2 * i) / (float)RD); const float ang = (float)pos[row] * invf;
          const double a = (double)ang; const double n = __builtin_rint(a * 0.15915494309189535); const float r = (float)__builtin_fma(n, -6.283185307179586, a);
          COS[e] = cosf(r); SIN[e] = sinf(r); } }
}

template <int W>
__device__ __forceinline__ void pool_rows(const v2u (&v)[31], int t0, bf16* out_base) {
    float s[4];
#pragma unroll
    for (int c = 0; c < 4; ++c) s[c] = 0.f;
#pragma unroll
    for (int j = 0; j < W; ++j) { const v2u w = v[15 - j]; s[0] += bflo(w.x); s[1] += bfhi(w.x); s[2] += bflo(w.y); s[3] += bfhi(w.y); }
#pragma unroll
    for (int i = 0; i < 16; ++i) {
        const int t = t0 + i; const float inv = __builtin_amdgcn_rcpf((float)(t + 1 < W ? t + 1 : W));
        const v2u cu = v[15 + i];
        const float o0 = s[0] * inv - bflo(cu.x), o1 = s[1] * inv - bfhi(cu.x), o2 = s[2] * inv - bflo(cu.y), o3 = s[3] * inv - bfhi(cu.y);
        *(GAS v2u*)(out_base + (size_t)i * EI) = (v2u){cvt_pk_bf16(o0, o1), cvt_pk_bf16(o2, o3)};
        if (i < 15) { const v2u a = v[16 + i], d = v[16 + i - W];
            s[0] += bflo(a.x) - bflo(d.x); s[1] += bfhi(a.x) - bfhi(d.x); s[2] += bflo(a.y) - bflo(d.y); s[3] += bfhi(a.y) - bfhi(d.y); }
    }
}
__device__ __forceinline__ void pool_mix_phase(Frame& F, bf16* U, const bf16* HALO) {
    const int cb = F.tid & 31, rb = F.tid >> 5;
    for (int unit = F.vcu; unit < 64 * 16; unit += F.G) {
        const int pm = unit >> 4, cs = unit & 15, col = cs * 128 + cb * 4, g = cs >> 2;
        const int r0 = pm * 256 + rb * 16, t0 = r0 & (SEQ - 1);
        v2u v[31];
#pragma unroll
        for (int i = 0; i < 31; ++i) { const int dr = i - 15;
            if (dr >= 0 || rb > 0) v[i] = *(const GAS v2u*)(U + (size_t)(r0 + dr) * EI + col);
            else if ((pm & 15) == 0) v[i] = (v2u){0u, 0u};
            else v[i] = *(const GAS v2u*)(HALO + ((size_t)(pm - 1) * 16 + (16 + dr)) * EI + col); }
        VM_WAIT(); __syncthreads();
        bf16* ob = U + (size_t)r0 * EI + col;
        if (g == 0) pool_rows<2>(v, t0, ob); else if (g == 1) pool_rows<4>(v, t0, ob); else if (g == 2) pool_rows<8>(v, t0, ob); else pool_rows<16>(v, t0, ob);
    }
}
__device__ __forceinline__ void conv_mix_phase(Frame& F, const bf16* CH, bf16* BZ, const float* cw) {
    const int cb = F.tid & 31, rb = F.tid >> 5;
    for (int unit = F.vcu; unit < 64 * 8; unit += F.G) {
        const int pm = unit >> 3, cs = unit & 7, col = cs * 256 + cb * 8;
        const int r0 = pm * 256 + rb * 16, t0 = r0 & (SEQ - 1);
        float w[3][8];
#pragma unroll
        for (int j = 0; j < 3; ++j) { const f32x4 a = *(const GAS f32x4*)(cw + j * EI + col), b = *(const GAS f32x4*)(cw + j * EI + col + 4);
            w[j][0] = a[0]; w[j][1] = a[1]; w[j][2] = a[2]; w[j][3] = a[3]; w[j][4] = b[0]; w[j][5] = b[1]; w[j][6] = b[2]; w[j][7] = b[3]; }
        v4u c[18];
#pragma unroll
        for (int i = 0; i < 18; ++i) { const int dr = i - 2; if (t0 + dr >= 0) c[i] = *(const GAS v4u*)(CH + (size_t)(r0 + dr) * EI + col); else c[i] = (v4u){0u, 0u, 0u, 0u}; }
#pragma unroll
        for (int i = 0; i < 16; ++i) { bf16* p = BZ + (size_t)(r0 + i) * EI + col; const v4u z = *(const GAS v4u*)p; const v4u x0 = c[i], x1 = c[i + 1], x2 = c[i + 2];
            float o[8];
#define CV(k, X0, X1, X2, Z) o[k] = (Z) * (w[0][k] * (X0) + w[1][k] * (X1) + w[2][k] * (X2))
            CV(0, bflo(x0.x), bflo(x1.x), bflo(x2.x), bflo(z.x)); CV(1, bfhi(x0.x), bfhi(x1.x), bfhi(x2.x), bfhi(z.x));
            CV(2, bflo(x0.y), bflo(x1.y), bflo(x2.y), bflo(z.y)); CV(3, bfhi(x0.y), bfhi(x1.y), bfhi(x2.y), bfhi(z.y));
            CV(4, bflo(x0.z), bflo(x1.z), bflo(x2.z), bflo(z.z)); CV(5, bfhi(x0.z), bfhi(x1.z), bfhi(x2.z), bfhi(z.z));
            CV(6, bflo(x0.w), bflo(x1.w), bflo(x2.w), bflo(z.w)); CV(7, bfhi(x0.w), bfhi(x1.w), bfhi(x2.w), bfhi(z.w));
#undef CV
            *(GAS v4u*)p = (v4u){cvt_pk_bf16(o[0], o[1]), cvt_pk_bf16(o[2], o[3]), cvt_pk_bf16(o[4], o[5]), cvt_pk_bf16(o[6], o[7])}; }
    }
}
__device__ __forceinline__ void final_norm_phase(Frame& F, float* X, const float* gain) {
    const int gw = F.vcu * NWAVES + F.wave, NGW = F.G * NWAVES;
    f32x4 gv[4];
#pragma unroll
    for (int j = 0; j < 4; ++j) gv[j] = *((const GAS f32x4*)gain + F.lane + 64 * j);
    for (int m = gw; m < M; m += NGW) { GAS f32x4* xr = (GAS f32x4*)(X + (size_t)m * DM) + F.lane; f32x4 v[4]; float s = 0.f;
#pragma unroll
        for (int j = 0; j < 4; ++j) { v[j] = xr[64 * j]; s += (v[j].x * v[j].x + v[j].y * v[j].y) + (v[j].z * v[j].z + v[j].w * v[j].w); }
        const float rs = 1.0f / sqrtf(wave_sum(s) * (1.0f / DM) + NORM_EPS);
#pragma unroll
        for (int j = 0; j < 4; ++j) xr[64 * j] = v[j] * rs * gv[j]; }
}

__device__ __forceinline__ void run_phase(Frame& F, int ph) {
    { int t_ = threadIdx.x; asm volatile("" : "+v"(t_)); F.tid = t_; F.lane = t_ & 63; F.wave = __builtin_amdgcn_readfirstlane(t_ >> 6); }
    unsigned char* ws = F.ap->ws; const int bid = (int)blockIdx.x;
    bf16* XB = (bf16*)(ws + WS_XB); bf16* A1 = (bf16*)(ws + WS_A1); bf16* A2 = (bf16*)(ws + WS_A2);
    float* SSQ = (float*)(ws + WS_SSQ); float* X = F.ap->out;
    const float* COS = (const float*)(ws + WS_COS); const float* SIN = (const float*)(ws + WS_SIN);
    LAS unsigned char* ring = F.lds + RING_OFF;
    if (ph == 0) { p0_prologue(F); return; }
    if (ph == 17) { final_norm_phase(F, X, INP(18)); return; }
    const bool pool = (ph >= 1 && ph <= 4) || (ph >= 13 && ph <= 16);
    const int j = ph >= 13 ? 1 : 0, pp = pool ? (ph >= 13 ? ph - 13 : ph - 1) : -1;
    unsigned char* wpool = ws + (j ? WS_WPOOL1 : WS_WPOOL0);
    if (pool && pp == 0) {
        pg8::Gemm g{XB, (const bf16*)(wpool + WPOOL_IN), DM, DM, DM, 0, 0}; pg8::StaticOrder S; S.init(M, 4096, F.G, bid);
        epi::EpiPoolIn E{A1, A2, (bf16*)(ws + WS_HALO), SSQ};
        pg8::gemm_phase<epi::EpiPoolIn, pg8::StaticOrder, true>(ring, g, S, E); return; }
    if (pool && pp == 1) { pool_mix_phase(F, A1, (const bf16*)(ws + WS_HALO)); return; }
    if (pool && pp == 2) {
        pg8::Gemm g{A1, (const bf16*)(wpool + WPOOL_GRP), EI, 512, 512, 2, 512}; pg8::StaticOrder S; S.init(M, EI, F.G, bid);
        epi::EpiPoolGrp E{A2, INP(5) + j * EI};
        pg8::gemm_phase<epi::EpiPoolGrp, pg8::StaticOrder, true>(ring, g, S, E); return; }
    if ((pool && pp == 3) || ph == 7 || ph == 12) {
        const bf16* Y = ph == 12 ? A1 : A2;
        const bf16* Wt = pool ? (const bf16*)(wpool + WPOOL_OUT) : ph == 7 ? (const bf16*)(ws + WS_WCONV_OUT) : (const bf16*)(ws + WS_WMLA_OUT);
        pg8::Gemm g{Y, Wt, EI, EI, EI, 0, 0}; pg8::StaticOrder S; S.init(M, DM, F.G, bid);
        if (ph == 4) { epi::EpiResid<true, false> E{INP(0), nullptr, XB, SSQ}; pg8::gemm_phase<epi::EpiResid<true, false>, pg8::StaticOrder, false>(ring, g, S, E); }
        else if (ph == 16) { epi::EpiResid<false, true> E{nullptr, X, XB, SSQ}; pg8::gemm_phase<epi::EpiResid<false, true>, pg8::StaticOrder, false>(ring, g, S, E); }
        else { epi::EpiResid<false, false> E{nullptr, nullptr, XB, SSQ}; pg8::gemm_phase<epi::EpiResid<false, false>, pg8::StaticOrder, false>(ring, g, S, E); }
        return; }
    if (ph == 5) {
        pg8::Gemm g{XB, (const bf16*)(ws + WS_WCONV_IN), DM, DM, DM, 0, 0}; pg8::StaticOrder S; S.init(M, 8192, F.G, bid);
        epi::EpiConvIn E{A1, A2, SSQ};
        pg8::gemm_phase<epi::EpiConvIn, pg8::StaticOrder, true>(ring, g, S, E); return; }
    if (ph == 6) { conv_mix_phase(F, A1, A2, INP(9)); return; }
    bf16* KVLAT = (bf16*)(ws + WS_KVLAT); bf16* QLAT = (bf16*)(ws + WS_QLAT); bf16* KROPE = (bf16*)(ws + WS_KROPE); bf16* QR = (bf16*)(ws + WS_QR);
    float* SSQQ = (float*)(ws + WS_SSQQ); float* SSQKV = (float*)(ws + WS_SSQKV);
    bf16* KV1 = (bf16*)X;
    if (ph == 8) {
        pg8::Gemm g{XB, (const bf16*)(ws + WS_WMLA_B1), DM, DM, DM, 0, 0}; pg8::StaticOrder S; S.init(M, 768, F.G, bid);
        epi::EpiMlaIn E{KVLAT, QLAT, KROPE, SSQKV, SSQQ, SSQ, COS, SIN};
        pg8::gemm_phase<epi::EpiMlaIn, pg8::StaticOrder, false>(ring, g, S, E); return; }
    if (ph == 9) {
        { pg8::Gemm g{QLAT, (const bf16*)(ws + WS_WMLA_QUP), QL, QL, QL, 0, 0}; pg8::StaticOrder S; S.init(M, 3072, F.G, bid);
          epi::EpiQUp E{A1, QR, SSQQ, COS, SIN};
          pg8::gemm_phase<epi::EpiQUp, pg8::StaticOrder, true>(ring, g, S, E); }
        { pg8::Gemm g{KVLAT, (const bf16*)(ws + WS_WMLA_KVUP), KVL, KVL, KVL, 0, 0}; pg8::StaticOrder S; S.init(M, 4096, F.G, bid);
          epi::EpiKvUp E{A2, KV1, SSQKV};
          pg8::gemm_phase<epi::EpiKvUp, pg8::StaticOrder, true>(ring, g, S, E); }
        return; }
    if (ph == 10) { att::attn_phase((char*)ring, A1, QR, A2, KV1, KROPE, A1, bid, F.G); return; }
    if (ph == 11) {
        pg8::Gemm g{XB, (const bf16*)(ws + WS_WMLA_B1) + (size_t)768 * DM, DM, DM, DM, 0, 0}; pg8::StaticOrder S; S.init(M, EI, F.G, bid);
        epi::EpiGate E{A1, SSQ};
        pg8::gemm_phase<epi::EpiGate, pg8::StaticOrder, true>(ring, g, S, E); return; }
}

__global__ void __launch_bounds__(NWAVES * 64, 2) trunk_fwd(Args args) {
    extern __shared__ __attribute__((aligned(16))) unsigned char lds[];
    Frame F;
    F.lds = (LAS unsigned char*)lds; F.ap = &args;
    F.tid = threadIdx.x; F.lane = F.tid & 63; F.wave = __builtin_amdgcn_readfirstlane(F.tid >> 6);
    F.G = gridDim.x; { const int bx = blockIdx.x; F.vcu = (F.G % 8 == 0) ? (bx % 8) * (F.G / 8) + bx / 8 : bx; }
    for (int u = F.tid; u < (LDS_BYTES - LDSCTL_OFF) / 4; u += NWAVES * 64) ((LAS unsigned*)(F.lds + LDSCTL_OFF))[u] = 0u;
    __syncthreads();
    XcdBarrier bar; bar.bar = (unsigned*)(args.ws + WS_CTL) + CW_BAR; bar.x = 0; bar.st = nullptr;
    if (N_LAUNCHES == 1) bar = xcd_barrier_post((unsigned*)(args.ws + WS_CTL) + CW_BAR, (volatile LAS unsigned*)(F.lds + MISC_OFF) + 8);
    const int lo = args.ph_lo, hi = args.ph_hi;
#define PHASE(k) if (lo <= (k) && (k) < hi) { run_phase(F, (k)); if ((k) + 1 < hi) { if (N_LAUNCHES == 1) xcd_barrier(bar); } }
    PHASE(0)
    PHASE(1)
    PHASE(2)
    PHASE(3)
    PHASE(4)
    PHASE(5)
    PHASE(6)
    PHASE(7)
    PHASE(8)
    PHASE(9)
    PHASE(10)
    PHASE(11)
    PHASE(12)
    PHASE(13)
    PHASE(14)
    PHASE(15)
    PHASE(16)
    PHASE(17)
#undef PHASE
}


extern "C" void kernel_launch(void* const* d_in, const int* in_sizes, int n_in, void* d_out, int out_size, void* d_ws, size_t ws_size, hipStream_t stream) {
    static int grid = 0;
    if (grid == 0) {
        if (n_in != 19 || in_sizes[0] != M * DM || out_size != M * DM || ws_size < WS_END) {
            fprintf(stderr, "kernel_launch: built for 19 inputs, x/out of %d floats, >= %zu bytes of workspace; got n_in %d, in0 %d, out %d, ws %zu; nothing launched\n", M * DM, (size_t)WS_END, n_in, n_in > 0 ? in_sizes[0] : -1, out_size, ws_size);
            grid = -1; return; }
        int dev = 0, cus = 0;
        if (hipGetDevice(&dev) != hipSuccess || hipDeviceGetAttribute(&cus, hipDeviceAttributeMultiprocessorCount, dev) != hipSuccess) { fprintf(stderr, "kernel_launch: device query failed\n"); grid = -1; return; }
        if (hipFuncSetAttribute((const void*)trunk_fwd, hipFuncAttributeMaxDynamicSharedMemorySize, LDS_BYTES) != hipSuccess) { fprintf(stderr, "kernel_launch: hipFuncSetAttribute failed\n"); grid = -1; return; }
        int per_cu = 0;
        if (hipOccupancyMaxActiveBlocksPerMultiprocessor(&per_cu, (const void*)trunk_fwd, NWAVES * 64, LDS_BYTES) != hipSuccess || per_cu < 1)
            fprintf(stderr, "kernel_launch: note: occupancy query reports %d workgroups per CU\n", per_cu);
        (void)hipGetLastError();
        grid = cus;
    }
    if (grid < 0) return;
    if (hipMemsetAsync((char*)d_ws + WS_CTL, 0, CTL_ZERO_BYTES, stream) != hipSuccess) { fprintf(stderr, "kernel_launch: hipMemsetAsync failed\n"); return; }
    Args a{};
    for (int i = 0; i < 19; ++i) a.in[i] = d_in[i];
    a.out = (float*)d_out; a.ws = (unsigned char*)d_ws;
#if MK_DEBUG
    dbg_launch_all(a, grid, stream);
#else
    for (int li = 0; li < N_LAUNCHES; ++li) {
        a.ph_lo = (N_LAUNCHES == NPH) ? li : 0; a.ph_hi = (N_LAUNCHES == NPH) ? li + 1 : NPH;
        hipLaunchKernelGGL(trunk_fwd, dim3(grid), dim3(NWAVES * 64), LDS_BYTES, stream, a);
        const hipError_t le = hipPeekAtLastError();
        if (le != hipSuccess) { fprintf(stderr, "kernel_launch: launch %d failed: %s\n", li, hipGetErrorName(le)); break; }
    }
#endif
}
```

```cpp
#include <hip/hip_runtime.h>
#include <cstdio>
#include <cstdint>

#ifndef MK_N_LAUNCHES
#define MK_N_LAUNCHES 1
#endif
#ifndef MK_DEBUG
#define MK_DEBUG 0
#endif

constexpr int NB = 4, SEQ = 4096, DM = 1024, M = NB * SEQ, EI = 2048;
constexpr int QL = 384, KVL = 256, RD = 64, NHEAD = 16, DN = 128, DV = 128;
constexpr int MLA_IN = QL + KVL + RD + EI;
constexpr float NORM_EPS = 1e-6f;
constexpr float ATTN_SCALE = 0.07216878364870322f;
constexpr float ROPE_BASE = 10000.0f;

constexpr size_t MiB = 1u << 20;
constexpr size_t WS_CTL = 0, CTL_ZERO_BYTES = 1 * MiB;
constexpr size_t WS_SSQ = 1 * MiB;
constexpr size_t WS_SSQQ = 2 * MiB;
constexpr size_t WS_SSQKV = 2 * MiB + 512 * 1024;
constexpr size_t WS_DBG = 3 * MiB;
constexpr size_t WS_COS = 4 * MiB, WS_SIN = 6 * MiB;
constexpr size_t WS_WGRPA = 8 * MiB;
constexpr size_t WS_WCONV_IN = 12 * MiB;
constexpr size_t WS_WCONV_OUT = 28 * MiB;
constexpr size_t WS_WPOOL0 = 32 * MiB, WS_WPOOL1 = 46 * MiB;
constexpr size_t WPOOL_IN = 0, WPOOL_GRP = 8 * MiB, WPOOL_OUT = 10 * MiB;
constexpr size_t WS_WMLA_B1 = 60 * MiB;
constexpr size_t WS_WMLA_BZ = 62 * MiB;
constexpr size_t WS_WMLA_QUP = 66 * MiB;
constexpr size_t WS_WMLA_KVUP = 69 * MiB;
constexpr size_t WS_WMLA_OUT = 71 * MiB;
constexpr size_t WS_XB = 76 * MiB;
constexpr size_t WS_A1 = 108 * MiB;
constexpr size_t WS_A2 = 172 * MiB;
constexpr size_t WS_QLAT = 236 * MiB;
constexpr size_t WS_KVLAT = 248 * MiB;
constexpr size_t WS_END = 256 * MiB;
constexpr size_t WS_QR = WS_WCONV_IN;
constexpr size_t WS_KROPE = 44 * MiB;

#define GAS __attribute__((address_space(1)))
#define LAS __attribute__((address_space(3)))
typedef unsigned short bf16;
typedef unsigned v4u __attribute__((ext_vector_type(4)));
typedef unsigned v2u __attribute__((ext_vector_type(2)));
typedef float f32x4 __attribute__((ext_vector_type(4)));
typedef float f32x2 __attribute__((ext_vector_type(2)));
typedef float f32x16 __attribute__((ext_vector_type(16)));
typedef short bf16x8 __attribute__((ext_vector_type(8)));
typedef short s16x4 __attribute__((ext_vector_type(4)));
typedef GAS unsigned gu32;
#define RLX_AGENT __ATOMIC_RELAXED, __HIP_MEMORY_SCOPE_AGENT
#define LDS_WAIT() asm volatile("s_waitcnt lgkmcnt(0)" ::: "memory")
#define VM_WAIT() asm volatile("s_waitcnt vmcnt(0)" ::: "memory")

__device__ __forceinline__ unsigned cvt_pk_bf16(float lo, float hi) { unsigned r; asm volatile("v_cvt_pk_bf16_f32 %0, %1, %2" : "=v"(r) : "v"(lo), "v"(hi)); return r; }
__device__ __forceinline__ float bf2f(unsigned short h) { return __uint_as_float((unsigned)h << 16); }
__device__ __forceinline__ float bflo(unsigned w) { return __uint_as_float(w << 16); }
__device__ __forceinline__ float bfhi(unsigned w) { return __uint_as_float(w & 0xffff0000u); }
__device__ __forceinline__ unsigned short f2bf_bits(float f) { return (unsigned short)(cvt_pk_bf16(f, 0.f) & 0xffffu); }
__device__ __forceinline__ v4u pack8(f32x4 a, f32x4 b) { v4u w; w.x = cvt_pk_bf16(a[0], a[1]); w.y = cvt_pk_bf16(a[2], a[3]); w.z = cvt_pk_bf16(b[0], b[1]); w.w = cvt_pk_bf16(b[2], b[3]); return w; }
__device__ __forceinline__ float silu_f(float z) { return z * __builtin_amdgcn_rcpf(1.0f + __builtin_amdgcn_exp2f(-1.4426950408889634f * z)); }
__device__ __forceinline__ f32x4 silu4(f32x4 z) { f32x4 r; r[0] = silu_f(z[0]); r[1] = silu_f(z[1]); r[2] = silu_f(z[2]); r[3] = silu_f(z[3]); return r; }
__device__ __forceinline__ float wave_sum(float v) {
#pragma unroll
    for (int o = 1; o < 64; o <<= 1) v += __shfl_xor(v, o);
    return v;
}
__device__ __forceinline__ float fq_sum(float s) { s += __shfl_xor(s, 16); s += __shfl_xor(s, 32); return s; }

namespace pg8 {
typedef unsigned short bf16_t;
constexpr int BM = 256, BK = 64, HALF = 128, HTB = HALF * BK * 2  , STAGE_BYTES = 8 * HTB, NXCD = 8, WGM = 8;

__host__ __device__ __forceinline__ int lds_byte(int r, int c) { const int st = (r >> 4) * 2 + (c >> 5), rr = r & 15, cc = c & 31, ob = rr * 64 + cc * 2; return st * 1024 + (ob ^ (((ob >> 9) & 1) << 5)); }
__host__ __device__ __forceinline__ void stage_rc(int b, int& R, int& C) { const int st = b / 1024, sb = b % 1024, swz = sb ^ (((sb >> 9) & 1) << 5); R = (st >> 1) * 16 + swz / 64; C = (st & 1) * 32 + (swz % 64) / 2; }
__host__ __device__ __forceinline__ int perm32(int rho) { const int n = rho >> 4, i = rho & 15; return 8 * (i >> 2) + 4 * n + (i & 3); }

struct Unit { int pm, pn; };
struct Gemm { const bf16_t* A; const bf16_t* Bt; int lda, ldb, K, agt, ags, bgt, bgs; };

struct StaticOrder {
    int nM, nN, nwg, G, c;
    __host__ __device__ void init(int M_, int N_, int G_, int c_) { nM = M_ / BM; nN = N_ / BM; nwg = nM * nN; G = G_; c = c_; }
    __host__ __device__ bool next(int i, Unit& u) const {
        const long L = (long)i * G + c; if (L >= nwg) return false;
        int wgid = (int)L; { const int q = nwg / NXCD, r = nwg % NXCD, xcd = wgid % NXCD, off = wgid / NXCD; wgid = (xcd < r ? xcd * (q + 1) : r * (q + 1) + (xcd - r) * q) + off; }
        const int nig = WGM * nN, gid = wgid / nig, fm = gid * WGM, gsz = (nM - fm) < WGM ? (nM - fm) : WGM;
        u.pm = fm + ((wgid % nig) % gsz); u.pn = (wgid % nig) / gsz; return true;
    }
};

template <class Epi, class Sched, bool ALIGN_EPI = false>
__device__ __forceinline__ void gemm_phase(LAS unsigned char* lds, const Gemm g, const Sched& S, const Epi& E) {
    int tid_ = threadIdx.x; asm volatile("" : "+v"(tid_));
    const int tid = tid_, wid = __builtin_amdgcn_readfirstlane(tid >> 6), lane = tid & 63, wr = wid >> 2, wc = wid & 3, fr = lane & 15, fq = lane >> 4;
    const int K = g.K, nt = K / BK;
    unsigned voffA[2], voffB[2];
#pragma unroll
    for (int i = 0; i < 2; ++i) { int R, C; stage_rc(tid * 16 + i * 8192, R, C); const int Rb = (R & ~31) + perm32(R & 31);
        voffA[i] = (unsigned)(R * g.lda + C) * 2u; voffB[i] = (unsigned)(Rb * g.ldb + C) * 2u; }
    const size_t kstep = (size_t)(BK * 2);
    const size_t hstepA = (size_t)HALF * g.lda * 2, hstepB = (size_t)HALF * g.ldb * 2;
    const unsigned ldsw = (unsigned)wid * 1024u;
    const int aoff = lds_byte(wr * 64 + fr, fq * 8), boff = lds_byte(wc * 32 + fr, fq * 8);
#define PG8_AOF(u) ((const char*)g.A + ((size_t)(u).pm * BM * g.lda + (g.agt ? (size_t)((u).pn / g.agt) * g.ags : (size_t)0)) * 2)
#define PG8_BOF(u) ((const char*)g.Bt + ((size_t)(u).pn * BM * g.ldb + (g.bgt ? (size_t)((u).pm / g.bgt) * g.bgs : (size_t)0)) * 2)
#define PG8_SA(b, h) (((b) * 2 + (h)) * HTB)
#define PG8_SB(b, h) ((4 + (b) * 2 + (h)) * HTB)
#define PG8_STAGE(bufoff, gbase, voff) do { _Pragma("unroll") for (int _i = 0; _i < 2; ++_i) \
        __builtin_amdgcn_global_load_lds((const unsigned*)((const char*)(gbase) + (voff)[_i]), (LAS unsigned*)(lds + (bufoff) + ldsw + _i * 8192), 16, 0, 0); } while (0)
#define PG8_LDA(dst, b, h) do { _Pragma("unroll") for (int m = 0; m < 4; ++m) _Pragma("unroll") for (int k = 0; k < 2; ++k) dst[m][k] = *(const LAS bf16x8*)(lds + PG8_SA(b, h) + aoff + m * 2048 + k * 1024); } while (0)
#define PG8_LDB(dst, b, h) do { _Pragma("unroll") for (int n = 0; n < 2; ++n) _Pragma("unroll") for (int k = 0; k < 2; ++k) dst[n][k] = *(const LAS bf16x8*)(lds + PG8_SB(b, h) + boff + n * 2048 + k * 1024); } while (0)
#define PG8_MMA(ai, bj, At, Bt) do { __builtin_amdgcn_s_setprio(1); _Pragma("unroll") for (int m = 0; m < 4; ++m) _Pragma("unroll") for (int n = 0; n < 2; ++n) _Pragma("unroll") for (int k = 0; k < 2; ++k) \
        acc[ai][bj][m][n] = __builtin_amdgcn_mfma_f32_16x16x32_bf16(Bt[n][k], At[m][k], acc[ai][bj][m][n], 0, 0, 0); __builtin_amdgcn_s_setprio(0); } while (0)
#define PG8_WAIT_V(n) asm volatile("s_waitcnt vmcnt(" #n ")" ::: "memory")
#define PG8_WAIT_L(n) asm volatile("s_waitcnt lgkmcnt(" #n ")" ::: "memory")
#define PG8_BAR __builtin_amdgcn_s_barrier()
#define PG8_SCHED __builtin_amdgcn_sched_barrier(0)
    Unit cur, nxt; int ui = 0;
    if (!S.next(0, cur)) return;
    f32x4 acc[2][2][4][2];
#pragma unroll
    for (int a = 0; a < 2; ++a)
#pragma unroll
        for (int b = 0; b < 2; ++b)
#pragma unroll
            for (int m = 0; m < 4; ++m)
#pragma unroll
                for (int n = 0; n < 2; ++n) acc[a][b][m][n] = (f32x4){0.f, 0.f, 0.f, 0.f};
    bf16x8 At[4][2], B0[2][2], B1[2][2];
    const char* cA = PG8_AOF(cur); const char* cB = PG8_BOF(cur);
    PG8_STAGE(PG8_SB(0, 0), cB, voffB); PG8_STAGE(PG8_SB(0, 1), cB + hstepB, voffB); PG8_STAGE(PG8_SA(0, 0), cA, voffA); PG8_STAGE(PG8_SA(0, 1), cA + hstepA, voffA);
    if (wr == 1) PG8_BAR;
    PG8_WAIT_V(2); PG8_BAR;
    PG8_STAGE(PG8_SB(1, 0), cB + kstep, voffB); PG8_STAGE(PG8_SA(1, 0), cA + kstep, voffA); PG8_STAGE(PG8_SB(1, 1), cB + hstepB + kstep, voffB);
    PG8_WAIT_V(6); PG8_BAR;
    for (;;) {
        const bool has_next = S.next(ui + 1, nxt);
        const char* nA = has_next ? PG8_AOF(nxt) : cA; const char* nB = has_next ? PG8_BOF(nxt) : cB;
#pragma nounroll
        for (int t = 0; t < nt; t += 2) {
            const bool last = (t == nt - 2);
            const char* a1 = cA + (size_t)(t + 1) * kstep;
            const char* a2 = last ? nA : cA + (size_t)(t + 2) * kstep; const char* b2 = last ? nB : cB + (size_t)(t + 2) * kstep;
            const char* a3 = a2 + kstep; const char* b3 = b2 + kstep;
            PG8_LDB(B0, 0, 0); PG8_LDB(B1, 0, 1); PG8_SCHED; PG8_LDA(At, 0, 0); PG8_STAGE(PG8_SA(1, 1), a1 + hstepA, voffA);
            PG8_WAIT_V(8); PG8_WAIT_L(0); PG8_BAR; PG8_MMA(0, 0, At, B0); PG8_MMA(0, 1, At, B1); PG8_BAR; PG8_SCHED;
            PG8_LDA(At, 0, 1); PG8_STAGE(PG8_SB(0, 0), b2, voffB); PG8_STAGE(PG8_SB(0, 1), b2 + hstepB, voffB); PG8_STAGE(PG8_SA(0, 0), a2, voffA);
            PG8_WAIT_V(8); PG8_WAIT_L(0); PG8_BAR; PG8_MMA(1, 0, At, B0); PG8_MMA(1, 1, At, B1); PG8_BAR; PG8_SCHED;
            PG8_LDB(B0, 1, 0); PG8_LDB(B1, 1, 1); PG8_SCHED; PG8_LDA(At, 1, 0); PG8_STAGE(PG8_SA(0, 1), a2 + hstepA, voffA);
            PG8_WAIT_V(8); PG8_WAIT_L(0); PG8_BAR; PG8_MMA(0, 0, At, B0); PG8_MMA(0, 1, At, B1); PG8_BAR; PG8_SCHED;
            PG8_LDA(At, 1, 1); PG8_STAGE(PG8_SB(1, 0), b3, voffB); PG8_STAGE(PG8_SB(1, 1), b3 + hstepB, voffB); PG8_STAGE(PG8_SA(1, 0), a3, voffA);
            PG8_WAIT_V(8); PG8_WAIT_L(0); PG8_BAR; PG8_MMA(1, 0, At, B0); PG8_MMA(1, 1, At, B1); PG8_BAR; PG8_SCHED;
        }
        if constexpr (ALIGN_EPI) { if (wr == 0) PG8_BAR; }
        E(acc, cur, wr, wc, fr, fq);
        if (!has_next) break;
#pragma unroll
        for (int a = 0; a < 2; ++a)
#pragma unroll
            for (int b = 0; b < 2; ++b)
#pragma unroll
                for (int m = 0; m < 4; ++m)
#pragma unroll
                    for (int n = 0; n < 2; ++n) acc[a][b][m][n] = (f32x4){0.f, 0.f, 0.f, 0.f};
        cur = nxt; cA = nA; cB = nB; ++ui;
        if constexpr (ALIGN_EPI) { if (wr == 1) PG8_BAR; }
    }
    PG8_WAIT_V(0);
    if constexpr (!ALIGN_EPI) { if (wr == 0) PG8_BAR; }
    PG8_BAR;
#undef PG8_AOF
#undef PG8_BOF
#undef PG8_SA
#undef PG8_SB
#undef PG8_STAGE
#undef PG8_LDA
#undef PG8_LDB
#undef PG8_MMA
#undef PG8_WAIT_V
#undef PG8_WAIT_L
#undef PG8_BAR
#undef PG8_SCHED
}
}

namespace epi {
using pg8::Unit; using pg8::BM; using pg8::HALF;
typedef f32x4 Acc[2][2][4][2];
__device__ __forceinline__ float sq8(f32x4 a, f32x4 b) { return (a[0] * a[0] + a[1] * a[1]) + (a[2] * a[2] + a[3] * a[3]) + (b[0] * b[0] + b[1] * b[1]) + (b[2] * b[2] + b[3] * b[3]); }
#define EPI_ROW(g) (row0 + ((g) >> 2) * HALF + ((g) & 3) * 16)
__device__ __forceinline__ void rstd16x8(float (&rs)[8], const float* SSQ, int row0, int fq, float inv_n) {
    f32x4 v[8];
#pragma unroll
    for (int g = 0; g < 8; ++g) v[g] = *(const f32x4*)(SSQ + (size_t)EPI_ROW(g) * 16 + fq * 4);
#pragma unroll
    for (int g = 0; g < 8; ++g) rs[g] = 1.0f / sqrtf(fq_sum((v[g][0] + v[g][1]) + (v[g][2] + v[g][3])) * inv_n + NORM_EPS);
}

struct EpiPoolIn {
    bf16* V; bf16* SZ; const float* SSQ; const float* scale;
    __device__ __forceinline__ void operator()(const Acc& acc, const Unit& u, int wr, int wc, int fr, int fq) const {
        const int row0 = u.pm * BM + wr * 64 + fr; const bool isz = u.pn >= 8; const int colt = (u.pn & 7) * BM + wc * 32 + 8 * fq;
        float rs[8]; rstd16x8(rs, SSQ, row0, fq, 1.0f / DM);
        f32x4 sc[2][2];
#pragma unroll
        for (int bj = 0; bj < 2; ++bj) { sc[bj][0] = *(const f32x4*)(scale + colt + bj * HALF); sc[bj][1] = *(const f32x4*)(scale + colt + bj * HALF + 4); }
#pragma unroll
        for (int g = 0; g < 8; ++g) { const int ai = g >> 2, m = g & 3; const int row = EPI_ROW(g);
#pragma unroll
            for (int bj = 0; bj < 2; ++bj) { f32x4 v0 = acc[ai][bj][m][0] * rs[g], v1 = acc[ai][bj][m][1] * rs[g]; const int col = colt + bj * HALF;
                if (isz) { v0 = silu4(v0); v1 = silu4(v1); *(v4u*)(SZ + (size_t)row * EI + col) = pack8(v0, v1); }
                else *(v4u*)(V + (size_t)row * EI + col) = pack8(v0 * sc[bj][0], v1 * sc[bj][1]); } }
    }
};
struct EpiW {
    bf16* W0; bf16* W1;
    __device__ __forceinline__ void operator()(const Acc& acc, const Unit& u, int wr, int wc, int fr, int fq) const {
        const int row0 = u.pm * BM + wr * 64 + fr; const int colt = u.pn * BM + wc * 32 + 8 * fq;
#pragma unroll
        for (int g = 0; g < 8; ++g) { const int ai = g >> 2, m = g & 3; const int row = EPI_ROW(g); bf16* dst = ((row >> 11) ? W1 : W0) + (size_t)(row & 2047) * DM + colt;
            *(v4u*)dst = pack8(acc[ai][0][m][0], acc[ai][0][m][1]); *(v4u*)(dst + HALF) = pack8(acc[ai][1][m][0], acc[ai][1][m][1]); }
    }
};
template <bool IN_F32, bool OUT_F32>
struct EpiResid {
    const float* Xin; float* Xout; bf16* XB; float* SSQ;
    __device__ __forceinline__ void operator()(const Acc& acc, const Unit& u, int wr, int wc, int fr, int fq) const {
        const int row0 = u.pm * BM + wr * 64 + fr; const int colt = u.pn * BM + wc * 32 + 8 * fq;
#pragma unroll
        for (int ai = 0; ai < 2; ++ai) { f32x4 x[4][2][2];
#pragma unroll
            for (int m = 0; m < 4; ++m)
#pragma unroll
                for (int bj = 0; bj < 2; ++bj) { const size_t off = (size_t)EPI_ROW(4 * ai + m) * DM + colt + bj * HALF;
                    if (IN_F32) { x[m][bj][0] = *(const f32x4*)(Xin + off); x[m][bj][1] = *(const f32x4*)(Xin + off + 4); }
                    else { const v4u z = *(const v4u*)(XB + off); x[m][bj][0] = (f32x4){bflo(z.x), bfhi(z.x), bflo(z.y), bfhi(z.y)}; x[m][bj][1] = (f32x4){bflo(z.z), bfhi(z.z), bflo(z.w), bfhi(z.w)}; } }
#pragma unroll
            for (int m = 0; m < 4; ++m) { const int row = EPI_ROW(4 * ai + m); float ss = 0.f;
#pragma unroll
                for (int bj = 0; bj < 2; ++bj) { const size_t off = (size_t)row * DM + colt + bj * HALF;
                    const f32x4 v0 = x[m][bj][0] + acc[ai][bj][m][0], v1 = x[m][bj][1] + acc[ai][bj][m][1];
                    if (OUT_F32) { *(f32x4*)(Xout + off) = v0; *(f32x4*)(Xout + off + 4) = v1; }
                    else { const v4u w = pack8(v0, v1); *(v4u*)(XB + off) = w;
                        ss += sq8((f32x4){bflo(w.x), bfhi(w.x), bflo(w.y), bfhi(w.y)}, (f32x4){bflo(w.z), bfhi(w.z), bflo(w.w), bfhi(w.w)}); } }
                if (!OUT_F32) { ss = fq_sum(ss); if (fq == 0) SSQ[(size_t)row * 16 + u.pn * 4 + wc] = ss; } }
            asm volatile("" ::: "memory"); }
    }
};
struct EpiConvIn {
    bf16* CH; bf16* BZ; const float* SSQ;
    __device__ __forceinline__ void operator()(const Acc& acc, const Unit& u, int wr, int wc, int fr, int fq) const {
        const int row0 = u.pm * BM + wr * 64 + fr; const int j0 = u.pn * 64 + (wc & 1) * 32 + 8 * fq; const bool isch = wc >= 2;
        float rs[8]; rstd16x8(rs, SSQ, row0, fq, 1.0f / DM);
#pragma unroll
        for (int g = 0; g < 8; ++g) { const int ai = g >> 2, m = g & 3; const int row = EPI_ROW(g); const float r = rs[g];
            const f32x4 p0 = acc[ai][0][m][0] * r, p1 = acc[ai][0][m][1] * r, q0 = acc[ai][1][m][0] * r, q1 = acc[ai][1][m][1] * r;
            if (isch) *(v4u*)(CH + (size_t)row * EI + j0) = pack8(p0 * q0, p1 * q1);
            else *(v4u*)(BZ + (size_t)row * EI + j0) = pack8(p0 * silu4(q0), p1 * silu4(q1)); }
    }
};
__device__ __forceinline__ v4u rope8v(f32x4 x1, f32x4 x2, f32x4 c, f32x4 s) { return pack8(x1 * c - x2 * s, x2 * c + x1 * s); }
struct EpiMlaIn {
    bf16* KVLAT; bf16* QLAT; bf16* KROPE; float* SSQKV; float* SSQQ; const float* SSQ; const float* COS; const float* SIN;
    __device__ __forceinline__ void operator()(const Acc& acc, const Unit& u, int wr, int wc, int fr, int fq) const {
        const int row0 = u.pm * BM + wr * 64 + fr; const int cl = wc * 32 + 8 * fq;
        float rs[8]; rstd16x8(rs, SSQ, row0, fq, 1.0f / DM);
        const bool dorope = u.pn == 2 && wc < 2; const int ii = 16 * (wc & 1) + 4 * fq;
#pragma unroll
        for (int ai = 0; ai < 2; ++ai) { f32x4 cs[4][2];
            if (dorope) {
#pragma unroll
                for (int m = 0; m < 4; ++m) { const size_t ro = (size_t)EPI_ROW(4 * ai + m) * 32 + ii; cs[m][0] = *(const f32x4*)(COS + ro); cs[m][1] = *(const f32x4*)(SIN + ro); } }
#pragma unroll
            for (int m = 0; m < 4; ++m) { const int row = EPI_ROW(4 * ai + m); const float r = rs[4 * ai + m];
                const f32x4 a0 = acc[ai][0][m][0] * r, a1 = acc[ai][0][m][1] * r, b0 = acc[ai][1][m][0] * r, b1 = acc[ai][1][m][1] * r;
                if (u.pn == 0) { *(v4u*)(KVLAT + (size_t)row * KVL + cl) = pack8(a0, a1); *(v4u*)(KVLAT + (size_t)row * KVL + HALF + cl) = pack8(b0, b1);
                    const float ss = fq_sum(sq8(a0, a1) + sq8(b0, b1)); if (fq == 0) SSQKV[(size_t)row * 4 + wc] = ss; }
                else if (u.pn == 1) { *(v4u*)(QLAT + (size_t)row * QL + cl) = pack8(a0, a1); *(v4u*)(QLAT + (size_t)row * QL + HALF + cl) = pack8(b0, b1);
                    const float ss = fq_sum(sq8(a0, a1) + sq8(b0, b1)); if (fq == 0) SSQQ[(size_t)row * 8 + wc] = ss; }
                else { *(v4u*)(QLAT + (size_t)row * QL + 256 + cl) = pack8(a0, a1);
                    const float ss = fq_sum(sq8(a0, a1)); if (fq == 0) SSQQ[(size_t)row * 8 + 4 + wc] = ss;
                    if (dorope) *(v4u*)(KROPE + (size_t)row * RD + cl) = rope8v(b0, b1, cs[m][0], cs[m][1]); } }
            asm volatile("" ::: "memory"); }
    }
};
struct EpiQUp {
    bf16* QN; bf16* QR; const float* SSQQ; const float* COS; const float* SIN;
    __device__ __forceinline__ void operator()(const Acc& acc, const Unit& u, int wr, int wc, int fr, int fq) const {
        const int row0 = u.pm * BM + wr * 64 + fr; const int cl = wc * 32 + 8 * fq;
        float rs[8];
        { f32x2 pq[8];
#pragma unroll
          for (int g = 0; g < 8; ++g) pq[g] = *(const f32x2*)(SSQQ + (size_t)EPI_ROW(g) * 8 + fq * 2);
#pragma unroll
          for (int g = 0; g < 8; ++g) rs[g] = 1.0f / sqrtf(fq_sum(pq[g][0] + pq[g][1]) * (1.0f / QL) + NORM_EPS); }
        const int hh = u.pn >= 6 ? 1 : 0, pnl = u.pn - 6 * hh; const bool isr = pnl >= 4; const int ii = 16 * (wc & 1) + 4 * fq;
#pragma unroll
        for (int ai = 0; ai < 2; ++ai) { f32x4 cs[4][2];
            if (isr) {
#pragma unroll
                for (int m = 0; m < 4; ++m) { const size_t ro = (size_t)EPI_ROW(4 * ai + m) * 32 + ii; cs[m][0] = *(const f32x4*)(COS + ro); cs[m][1] = *(const f32x4*)(SIN + ro); } }
#pragma unroll
            for (int m = 0; m < 4; ++m) { const int row = EPI_ROW(4 * ai + m); const float r = rs[4 * ai + m];
#pragma unroll
                for (int bj = 0; bj < 2; ++bj) { const f32x4 v0 = acc[ai][bj][m][0] * r, v1 = acc[ai][bj][m][1] * r;
                    if (!isr) *(v4u*)(QN + (size_t)row * EI + hh * 1024 + pnl * BM + bj * HALF + cl) = pack8(v0, v1);
                    else { const int hl = hh * 8 + (pnl - 4) * 4 + 2 * bj + (wc >> 1);
                        *(v4u*)(QR + (size_t)row * 1024 + hl * RD + 32 * (wc & 1) + 8 * fq) = rope8v(v0, v1, cs[m][0], cs[m][1]); } } }
            asm volatile("" ::: "memory"); }
    }
};
struct EpiKvUp {
    bf16* KV0; bf16* KV1; const float* SSQKV;
    __device__ __forceinline__ void operator()(const Acc& acc, const Unit& u, int wr, int wc, int fr, int fq) const {
        const int row0 = u.pm * BM + wr * 64 + fr; const int cl = (u.pn & 7) * DN + wc * 32 + 8 * fq; bf16* KN = u.pn >= 8 ? KV1 : KV0; bf16* V = KN + (size_t)M * 1024;
        float rs[8];
#pragma unroll
        for (int g = 0; g < 8; ++g) rs[g] = SSQKV[(size_t)EPI_ROW(g) * 4 + fq];
#pragma unroll
        for (int g = 0; g < 8; ++g) rs[g] = 1.0f / sqrtf(fq_sum(rs[g]) * (1.0f / KVL) + NORM_EPS);
#pragma unroll
        for (int g = 0; g < 8; ++g) { const int ai = g >> 2, m = g & 3; const int row = EPI_ROW(g);
            *(v4u*)(KN + (size_t)row * 1024 + cl) = pack8(acc[ai][0][m][0] * rs[g], acc[ai][0][m][1] * rs[g]);
            *(v4u*)(V + (size_t)row * 1024 + cl) = pack8(acc[ai][1][m][0] * rs[g], acc[ai][1][m][1] * rs[g]); }
    }
};
struct EpiGate {
    bf16* Y; const float* SSQ;
    __device__ __forceinline__ void operator()(const Acc& acc, const Unit& u, int wr, int wc, int fr, int fq) const {
        const int row0 = u.pm * BM + wr * 64 + fr; const int colt = u.pn * BM + wc * 32 + 8 * fq;
        float rs[8]; rstd16x8(rs, SSQ, row0, fq, 1.0f / DM);
#pragma unroll
        for (int ai = 0; ai < 2; ++ai) { v4u s[4][2];
#pragma unroll
            for (int m = 0; m < 4; ++m)
#pragma unroll
                for (int bj = 0; bj < 2; ++bj) s[m][bj] = *(const v4u*)(Y + (size_t)EPI_ROW(4 * ai + m) * EI + colt + bj * HALF);
#pragma unroll
            for (int m = 0; m < 4; ++m)
#pragma unroll
                for (int bj = 0; bj < 2; ++bj) { const v4u z = s[m][bj]; const float r = rs[4 * ai + m];
                    const f32x4 v0 = silu4(acc[ai][bj][m][0] * r) * (f32x4){bflo(z.x), bfhi(z.x), bflo(z.y), bfhi(z.y)};
                    const f32x4 v1 = silu4(acc[ai][bj][m][1] * r) * (f32x4){bflo(z.z), bfhi(z.z), bflo(z.w), bfhi(z.w)};
                    *(v4u*)(Y + (size_t)EPI_ROW(4 * ai + m) * EI + colt + bj * HALF) = pack8(v0, v1); }
            asm volatile("" ::: "memory"); }
    }
};
#undef EPI_ROW
}

namespace att {
constexpr int NW = 8, QBLK = 32, KVBLK = 64, QB = NW * QBLK, D = 128;
constexpr int PQN = 2048, PQR = 1024, PKV = 1024, PKR = 64;
constexpr int SHM_V = KVBLK * D * 2, SHM_K = KVBLK * D * 2, KR_ROWB = 144, SHM_KR = KVBLK * KR_ROWB;
constexpr int OFF_K = 2 * SHM_V, OFF_KR = 2 * SHM_V + 2 * SHM_K, OFF_WS = OFF_KR + 2 * SHM_KR;
constexpr int OFF_QRL = OFF_WS + NW * 64 * 4;
constexpr int NQREG = 4;
constexpr int QRL_WAVE = (12 - NQREG) * 1024;
constexpr int LDS_BYTES = OFF_QRL + NW * QRL_WAVE;
constexpr float SCALE = ATTN_SCALE;
constexpr float THR = 8.f;
#define KSWZ(row, colB) ((row) * 256 + ((colB) ^ (((row) & 7) << 4)))
#define SBAR() __builtin_amdgcn_sched_barrier(0)
__device__ __forceinline__ int v_st(int k, int c) { const int kk = (k & ~0xC) | ((k & 4) << 1) | ((k & 8) >> 1); return ((kk >> 3) * 4 + (c >> 5)) * 512 + ((kk & 7) * 32 + (c & 31)) * 2; }
__device__ __forceinline__ int v_rd_base(int lane) { return ((lane & 3) << 3) | (((lane >> 2) & 3) << 6) | (((lane >> 4) & 1) << 5) | (((lane >> 5) & 1) << 8); }
constexpr int v_rd_off(int d0, int ks, int half) { return d0 * 512 + ks * 4096 + half * 2048; }
__device__ __forceinline__ int crow(int r, int hi) { return (r & 3) + 8 * (r >> 2) + 4 * hi; }
__device__ __forceinline__ unsigned cvtpk(float lo, float hi) { unsigned r; asm volatile("v_cvt_pk_bf16_f32 %0, %1, %2" : "=v"(r) : "v"(lo), "v"(hi)); return r; }
__device__ __forceinline__ bf16x8 load8(const bf16* p) { return *reinterpret_cast<const bf16x8*>(p); }
__device__ __forceinline__ void mask_tile(f32x16& p0, f32x16& p1, int dq) {
    const float NEG = -__builtin_inff();
#pragma unroll
    for (int r = 0; r < 16; ++r) {
        const int c = (r & 3) + 8 * (r >> 2);
        if (dq - c < 0) p0[r] = NEG;
        if (dq - c - 32 < 0) p1[r] = NEG;
    }
}
__device__ __forceinline__ void partialSM(f32x16& p0, f32x16& p1, float& m_reg, float& mn, float& alpha) {
    float pmax = p0[0]; for (int r = 1; r < 16; ++r) pmax = fmaxf(pmax, p0[r]); for (int r = 0; r < 16; ++r) pmax = fmaxf(pmax, p1[r]);
    { auto rr = __builtin_amdgcn_permlane32_swap(__float_as_uint(pmax), __float_as_uint(pmax), false, false);
      pmax = fmaxf(__uint_as_float(rr[0]), __uint_as_float(rr[1])); }
    constexpr float C2 = 1.4426950408889634f * SCALE;
    if (__builtin_expect(__all((pmax - m_reg) * SCALE <= THR), 1)) { mn = m_reg; alpha = 1.f; }
    else { mn = fmaxf(m_reg, pmax); alpha = __builtin_amdgcn_exp2f((m_reg - mn) * C2); m_reg = mn; }
    const float mnL = -mn * C2;
    for (int r = 0; r < 16; ++r) p0[r] = fmaf(p0[r], C2, mnL); for (int r = 0; r < 16; ++r) p1[r] = fmaf(p1[r], C2, mnL);
    for (int r = 0; r < 16; ++r) p0[r] = __builtin_amdgcn_exp2f(p0[r]);
}
__device__ __forceinline__ void finishSM(f32x16& p0, f32x16& p1, float alpha, float& l_reg, bf16x8& pa0, bf16x8& pa1, bf16x8& pa2, bf16x8& pa3) {
    for (int r = 0; r < 16; ++r) p1[r] = __builtin_amdgcn_exp2f(p1[r]);
    float ps = 0; for (int r = 0; r < 16; ++r) ps += p0[r]; for (int r = 0; r < 16; ++r) ps += p1[r];
    { auto rr = __builtin_amdgcn_permlane32_swap(__float_as_uint(ps), __float_as_uint(ps), false, false);
      ps = __uint_as_float(rr[0]) + __uint_as_float(rr[1]); }
    l_reg = l_reg * alpha + ps;
#define PK4(P, B_, OUT) do { unsigned a0 = cvtpk(P[B_+0], P[B_+1]), a1 = cvtpk(P[B_+2], P[B_+3]);                          \
        unsigned b0 = cvtpk(P[B_+4], P[B_+5]), b1 = cvtpk(P[B_+6], P[B_+7]);                                             \
        auto r0 = __builtin_amdgcn_permlane32_swap(a0, b0, false, false); auto r1 = __builtin_amdgcn_permlane32_swap(a1, b1, false, false); \
        v4u w = {r0[0], r1[0], r0[1], r1[1]}; OUT = *reinterpret_cast<bf16x8*>(&w); } while (0)
    PK4(p0, 0, pa0); PK4(p0, 8, pa1); PK4(p1, 0, pa2); PK4(p1, 8, pa3);
#undef PK4
}
template <int KB>
__device__ __forceinline__ void qkt(f32x16& p0, f32x16& p1, const char* lds, int r32, int hi, const bf16x8* qr, const char* qrl) {
    p0 = f32x16{}; p1 = f32x16{};
    const char* kb[4];
#pragma unroll
    for (int dd = 0; dd < 4; ++dd) kb[dd] = lds + OFF_K + KB * SHM_K + KSWZ(r32, (dd * 16 + hi * 8) * 2);
#pragma unroll
    for (int d0 = 0; d0 < 8; ++d0) { const char* a = kb[d0 & 3] + (d0 >> 2) * 128;
        bf16x8 b0 = *reinterpret_cast<const bf16x8*>(a);
        bf16x8 b1 = *reinterpret_cast<const bf16x8*>(a + 32 * 256);
        bf16x8 qf; if (d0 < NQREG) qf = qr[d0]; else qf = *reinterpret_cast<const bf16x8*>(qrl + (4 + d0 - NQREG) * 1024);
        p0 = __builtin_amdgcn_mfma_f32_32x32x16_bf16(b0, qf, p0, 0, 0, 0);
        p1 = __builtin_amdgcn_mfma_f32_32x32x16_bf16(b1, qf, p1, 0, 0, 0); }
    const char* kr = lds + OFF_KR + KB * SHM_KR + r32 * KR_ROWB + hi * 16;
#pragma unroll
    for (int d0 = 0; d0 < 4; ++d0) {
        bf16x8 b0 = *reinterpret_cast<const bf16x8*>(kr + d0 * 32);
        bf16x8 b1 = *reinterpret_cast<const bf16x8*>(kr + d0 * 32 + 32 * KR_ROWB);
        const bf16x8 qf = *reinterpret_cast<const bf16x8*>(qrl + d0 * 1024);
        p0 = __builtin_amdgcn_mfma_f32_32x32x16_bf16(b0, qf, p0, 0, 0, 0);
        p1 = __builtin_amdgcn_mfma_f32_32x32x16_bf16(b1, qf, p1, 0, 0, 0); }
}
template <int VB>
__device__ __forceinline__ void pv_tile(f32x16* o, int vb0, bf16x8 pa0, bf16x8 pa1, bf16x8 pa2, bf16x8 pa3) {
#define TRRD(dst, off) asm volatile("ds_read_b64_tr_b16 %0, %1 offset:%2" : "=&v"(dst) : "v"(vb0), "i"(off) : "memory")
#define PV_D0(d0) do { s16x4 l0, l1, l2, l3, h0, h1, h2, h3; constexpr int b_ = VB * SHM_V + v_rd_off(d0, 0, 0); \
        TRRD(l0, b_); TRRD(h0, b_ + 2048); TRRD(l1, b_ + 4096); TRRD(h1, b_ + 6144); TRRD(l2, b_ + 8192); TRRD(h2, b_ + 10240); TRRD(l3, b_ + 12288); TRRD(h3, b_ + 14336); \
        asm volatile("s_waitcnt lgkmcnt(0)" ::: "memory"); SBAR();   \
        o[d0] = __builtin_amdgcn_mfma_f32_32x32x16_bf16(pa0, (bf16x8){l0[0], l0[1], l0[2], l0[3], h0[0], h0[1], h0[2], h0[3]}, o[d0], 0, 0, 0);   \
        o[d0] = __builtin_amdgcn_mfma_f32_32x32x16_bf16(pa1, (bf16x8){l1[0], l1[1], l1[2], l1[3], h1[0], h1[1], h1[2], h1[3]}, o[d0], 0, 0, 0);   \
        o[d0] = __builtin_amdgcn_mfma_f32_32x32x16_bf16(pa2, (bf16x8){l2[0], l2[1], l2[2], l2[3], h2[0], h2[1], h2[2], h2[3]}, o[d0], 0, 0, 0);   \
        o[d0] = __builtin_amdgcn_mfma_f32_32x32x16_bf16(pa3, (bf16x8){l3[0], l3[1], l3[2], l3[3], h3[0], h3[1], h3[2], h3[3]}, o[d0], 0, 0, 0); } while (0)
    PV_D0(0); PV_D0(1); PV_D0(2); PV_D0(3);
#undef PV_D0
#undef TRRD
}
struct BlockRef { const bf16* Q; const bf16* QR; const bf16* K; const bf16* V; const bf16* KR; bf16* O; int P0; };
struct Seam { bf16x8 qr[NQREG]; bf16x8 st_v0, st_v1, st_k0, st_k1, st_kr; };
#define ROWKV(p, k0, rr) ((p) + (size_t)((k0) + (rr)) * PKV + sc)
#define VMW() asm volatile("s_waitcnt vmcnt(0)" ::: "memory")
#define VMWN(n) asm volatile("s_waitcnt vmcnt(%0)" :: "i"(n) : "memory")
#define SLOAD_H(Kp, Vp, KRp, k0) do { S.st_v0 = load8(ROWKV(Vp, k0, sr)); S.st_v1 = load8(ROWKV(Vp, k0, 32 + sr));              \
                         S.st_k0 = load8(ROWKV(Kp, k0, sr)); S.st_k1 = load8(ROWKV(Kp, k0, 32 + sr)); S.st_kr = load8((KRp) + (size_t)((k0) + krr) * PKR + krc); } while (0)
#define SWRITE_HK(bf) do { *(bf16x8*)(K_lds + (bf) * SHM_K + kws) = S.st_k0; *(bf16x8*)(K_lds + (bf) * SHM_K + kws + 32 * 256) = S.st_k1; *(bf16x8*)(KR_lds + (bf) * SHM_KR + krws) = S.st_kr; } while (0)
#define SWRITE_HV(bf) do { *(bf16x8*)(V_lds + (bf) * SHM_V + vst0) = S.st_v0; *(bf16x8*)(V_lds + (bf) * SHM_V + vst1) = S.st_v1; } while (0)
#define SWRITE_H(bf) do { SWRITE_HV(bf); SWRITE_HK(bf); } while (0)
#define QLOAD(R) do { _Pragma("unroll") for (int d0 = 0; d0 < NQREG; ++d0) S.qr[d0] = load8((R).Q + (size_t)(wid * QBLK + r32) * PQN + d0 * 16 + hi * 8); } while (0)
#define QRLOAD(R) do { _Pragma("unroll") for (int d0 = 0; d0 < 4; ++d0) *(bf16x8*)(qrl + d0 * 1024) = load8((R).QR + (size_t)(wid * QBLK + r32) * PQR + d0 * 16 + hi * 8); \
                       _Pragma("unroll") for (int d0 = NQREG; d0 < 8; ++d0) *(bf16x8*)(qrl + (4 + d0 - NQREG) * 1024) = load8((R).Q + (size_t)(wid * QBLK + r32) * PQN + d0 * 16 + hi * 8); } while (0)
__device__ __forceinline__ void attn_prime(const BlockRef& cur, char* lds, Seam& S) {
    int tid_ = threadIdx.x; asm volatile("" : "+v"(tid_));
    const int tid = tid_, wid = __builtin_amdgcn_readfirstlane(tid >> 6), lane = tid & 63, r32 = lane & 31, hi = lane >> 5;
    const int sr = tid >> 4, sc = (tid & 15) * 8, kws = KSWZ(sr, sc * 2); char* K_lds = lds + OFF_K; char* KR_lds = lds + OFF_KR;
    const int krr = tid >> 3, krc = (tid & 7) * 8, krws = krr * KR_ROWB + krc * 2;
    char* qrl = lds + OFF_QRL + wid * QRL_WAVE + lane * 16;
    QLOAD(cur); QRLOAD(cur);
    SLOAD_H(cur.K, cur.V, cur.KR, 0); VMW(); SWRITE_HK(0);
    __syncthreads();
}
__device__ __forceinline__ void attn_block(const BlockRef& cur, const BlockRef& nxt, char* lds, Seam& S) {
    int tid_ = threadIdx.x; asm volatile("" : "+v"(tid_));
    const int tid = tid_, wid = __builtin_amdgcn_readfirstlane(tid >> 6), lane = tid & 63, r32 = lane & 31, hi = lane >> 5;
    const int NT = (cur.P0 + QB) / KVBLK;
    const int qlo = cur.P0 + wid * QBLK, qm = qlo + r32 - 4 * hi;
    char* V_lds = lds; char* K_lds = lds + OFF_K; char* KR_lds = lds + OFF_KR;
    float* ws = (float*)(lds + OFF_WS) + wid * 64; float* li_l = ws, * al_l = ws + 32;
    float m_reg = -1e30f, l_reg = 0; f32x16 o[4] = {};
    const int sr = tid >> 4, sc = (tid & 15) * 8, vst0 = v_st(sr, sc), vst1 = v_st(32 + sr, sc), kws = KSWZ(sr, sc * 2);
    const int krr = tid >> 3, krc = (tid & 7) * 8, krws = krr * KR_ROWB + krc * 2;
    const int vb0 = (int)(uintptr_t)V_lds + v_rd_base(lane);
    char* qrl = lds + OFF_QRL + wid * QRL_WAVE + lane * 16;
    const bf16* Kh = cur.K; const bf16* Vh = cur.V; const bf16* KRh = cur.KR;
#define RESC(a) do { if (__any((a) < 1.f)) { if (hi == 0) al_l[r32] = (a); asm volatile("s_waitcnt lgkmcnt(0)" ::: "memory");              \
                     for (int d_ = 0; d_ < 4; ++d_) for (int r = 0; r < 16; ++r) o[d_][r] *= al_l[crow(r, hi)]; } } while (0)
#define KBASE(t) ((t) * KVBLK)
#define MASKT(P0_, P1_, t) do { const int kb_ = KBASE(t); if (kb_ + KVBLK - 1 > qlo) mask_tile(P0_, P1_, qm - kb_); } while (0)
    constexpr int NQL = NQREG;
#define SEAM_K0() do { VMWN(NQL); SWRITE_HK(0); SBAR(); } while (0)
    f32x16 pA0, pA1, pB0, pB1; float mnA, mnB, alA, alB; bf16x8 pa0, pa1, pa2, pa3;
    SWRITE_HV(0); SBAR();
    if (NT > 1) { SLOAD_H(Kh, Vh, KRh, KBASE(1)); }
    SBAR(); qkt<0>(pA0, pA1, lds, r32, hi, S.qr, qrl);
    MASKT(pA0, pA1, 0); partialSM(pA0, pA1, m_reg, mnA, alA);
    if (NT > 1) { VMW(); SWRITE_H(1); }
    __syncthreads();
#define HALF_STEP(PX0, PX1, mnX, alX, PY0, PY1, alY, t, KB, VB, SB) do {                                                      \
        SBAR(); qkt<KB>(PX0, PX1, lds, r32, hi, S.qr, qrl);                                             \
        finishSM(PY0, PY1, alY, l_reg, pa0, pa1, pa2, pa3); SBAR();                                                           \
        if ((t) + 1 < NT) { SLOAD_H(Kh, Vh, KRh, KBASE((t) + 1)); SBAR(); }                                               \
        pv_tile<VB>(o, vb0, pa0, pa1, pa2, pa3); MASKT(PX0, PX1, (t)); partialSM(PX0, PX1, m_reg, mnX, alX);                                        \
        __syncthreads();                                                                                                      \
        if ((t) + 1 < NT) { VMW(); SWRITE_H(SB); }                                                                          \
        RESC(alX); __syncthreads(); } while (0)
    for (int t = 1; t + 1 < NT; t += 2) {
        HALF_STEP(pB0, pB1, mnB, alB, pA0, pA1, alA, t, 1, 0, 0);
        HALF_STEP(pA0, pA1, mnA, alA, pB0, pB1, alB, t + 1, 0, 1, 1);
    }
    const bool even = (NT & 1) == 0;
    if (even) { SBAR(); qkt<1>(pB0, pB1, lds, r32, hi, S.qr, qrl); SBAR(); }
    SLOAD_H(nxt.K, nxt.V, nxt.KR, 0); SBAR();
    QLOAD(nxt);
    SBAR();
    finishSM(pA0, pA1, alA, l_reg, pa0, pa1, pa2, pa3); SBAR();
    pv_tile<0>(o, vb0, pa0, pa1, pa2, pa3);
    if (even) { MASKT(pB0, pB1, NT - 1); partialSM(pB0, pB1, m_reg, mnB, alB); __syncthreads(); RESC(alB);
        finishSM(pB0, pB1, alB, l_reg, pa0, pa1, pa2, pa3); SBAR(); pv_tile<1>(o, vb0, pa0, pa1, pa2, pa3); }
    SBAR(); SEAM_K0();
    if (hi == 0) li_l[r32] = l_reg; asm volatile("s_waitcnt lgkmcnt(0)" ::: "memory");
    float rli[16];
#pragma unroll
    for (int r = 0; r < 16; ++r) rli[r] = __builtin_amdgcn_rcpf(li_l[crow(r, hi)]);
    int hio = hi; asm volatile("" : "+v"(hio));
    bf16* Ow = cur.O + (size_t)(wid * QBLK + 4 * hio) * PQN + r32;
#pragma unroll
    for (int r = 0; r < 16; ++r) { const int orow = (r & 3) + 8 * (r >> 2);
#pragma unroll
        for (int d0 = 0; d0 < 4; ++d0) { const float v = o[d0][r] * rli[r];
            const float vn = __shfl_xor(v, 1);
            if ((r32 & 1) == 0) *(unsigned*)(Ow + (size_t)orow * PQN + d0 * 32) = cvtpk(v, vn); }
        if ((r & 3) == 3) asm volatile("" ::: "memory"); }
    QRLOAD(nxt);
    __syncthreads();
#undef RESC
#undef KBASE
#undef MASKT
#undef SEAM_K0
#undef HALF_STEP
}
#undef ROWKV
#undef VMW
#undef VMWN
#undef SLOAD_H
#undef SWRITE_HK
#undef SWRITE_HV
#undef SWRITE_H
#undef QLOAD
#undef QRLOAD
#undef KSWZ
#undef SBAR
__device__ __forceinline__ BlockRef block_ref(int L, int pass, const bf16* QN, const bf16* QR, const bf16* KV0, const bf16* KV1, const bf16* KR, bf16* O) {
    const int hh = L >> 8, Ll = L & 255, x = Ll & 7, k = Ll >> 3, bh = x * 4 + (k >> 3), y = k & 7, b = bh >> 3, h8 = bh & 7, qb = pass ? 15 - y : y;
    const size_t row0 = (size_t)b * SEQ + (size_t)qb * QB, rowb = (size_t)b * SEQ;
    const bf16* KN = hh ? KV1 : KV0; const bf16* V = KN + (size_t)M * 1024;
    BlockRef r;
    r.Q = QN + row0 * PQN + (hh * 8 + h8) * DN; r.O = O + row0 * PQN + (hh * 8 + h8) * DN; r.QR = QR + row0 * PQR + (hh * 8 + h8) * RD;
    r.K = KN + rowb * PKV + h8 * DN; r.V = V + rowb * PKV + h8 * DV; r.KR = KR + rowb * PKR; r.P0 = qb * QB;
    return r;
}
__device__ __forceinline__ void attn_phase(char* lds, const bf16* QN, const bf16* QR, const bf16* KV0, const bf16* KV1, const bf16* KR, bf16* O, int bid, int G) {
    constexpr int NITEM = 512;
    int L = bid; if (L >= NITEM) return;
    int pass = 0;
    BlockRef cur = block_ref(L, 0, QN, QR, KV0, KV1, KR, O);
    Seam S;
    attn_prime(cur, lds, S);
    for (;;) {
        const bool more_pass = pass == 0, more_item = L + G < NITEM, last = !more_pass && !more_item;
        int passn = pass + 1, Ln = L;
        if (!more_pass) { passn = 0; Ln = more_item ? L + G : L; }
        const BlockRef nxt = last ? cur : block_ref(Ln, passn, QN, QR, KV0, KV1, KR, O);
        attn_block(cur, nxt, lds, S);
        if (last) break;
        cur = nxt; pass = passn; L = Ln;
    }
}
}

constexpr int NWAVES = 8;
constexpr int NPH = 17;
constexpr int N_LAUNCHES = MK_N_LAUNCHES;
static_assert(N_LAUNCHES == 1 || N_LAUNCHES == NPH, "MK_N_LAUNCHES is 1 or NPH");
constexpr int CW_BAR = 4096;
constexpr int RING_OFF = 0, RING_BYTES = 155648;
constexpr int LDSCTL_OFF = RING_BYTES, MISC_OFF = LDSCTL_OFF + 320;
constexpr int LDS_BYTES = RING_BYTES + 1024;
static_assert(att::LDS_BYTES <= RING_BYTES, "attention LDS");

#define XB_TMO      128
#define XB_XCNT(j)  (256  + 64 * (j))
#define XB_XSUB(j)  (1280 + 64 * (j))
#define XB_XGEN(j)  (2304 + 64 * (j))
#define XB_TOP      3328
#define XB_TOPGEN   3392
#define XCD_BAR_WORDS 3456
#define XB_SPIN_CAP (1u << 18)
__device__ __forceinline__ unsigned xb_ld(unsigned* p)              { return __hip_atomic_load(p, __ATOMIC_RELAXED, __HIP_MEMORY_SCOPE_AGENT); }
__device__ __forceinline__ unsigned xb_add(unsigned* p, unsigned v) { return __hip_atomic_fetch_add(p, v, __ATOMIC_RELAXED, __HIP_MEMORY_SCOPE_AGENT); }
__device__ __forceinline__ unsigned xb_xcc_id() { return (unsigned)__builtin_amdgcn_s_getreg((3 << 11) | 20) & 0xFu; }
#define XB_SPIN(cond, bar) do { unsigned _sp = 0; while (cond) { __builtin_amdgcn_s_sleep(1); \
    if ((++_sp & 255u) == 0u) { if (xb_ld(&(bar)[XB_TMO])) break; if (_sp > XB_SPIN_CAP) { atomicAdd(&(bar)[XB_TMO], 1u); break; } } } } while (0)
struct XcdBarrier { unsigned* bar; unsigned x; volatile LAS unsigned* st; };
__device__ __forceinline__ XcdBarrier xcd_barrier_post(unsigned* bar, volatile LAS unsigned* st) {
    XcdBarrier b; b.bar = bar; b.x = xb_xcc_id(); b.st = st;
    if (threadIdx.x == 0) (void)xb_add(&bar[XB_XCNT(b.x)], 1u);
    return b;
}
__device__ __forceinline__ void xcd_barrier_complete(unsigned* bar, unsigned x, unsigned& nloc, unsigned& nx) {
    const unsigned G = gridDim.x * gridDim.y * gridDim.z;
    unsigned sum, cnt, mine, sp = 0u;
    for (;;) {
        sum = 0u; cnt = 0u; mine = 0u;
#pragma unroll
        for (unsigned j = 0; j < 16; ++j) { const unsigned c = xb_ld(&bar[XB_XCNT(j)]); sum += c; cnt += (c > 0u) ? 1u : 0u; mine = (j == x) ? c : mine; }
        if (sum == G) break;
        __builtin_amdgcn_s_sleep(1);
        if ((++sp & 255u) == 0u) { if (xb_ld(&bar[XB_TMO])) break; if (sp > XB_SPIN_CAP) { atomicAdd(&bar[XB_TMO], 1u); break; } }
    }
    nloc = mine > 0u ? mine : 1u; nx = cnt > 0u ? cnt : 1u;
}
__device__ __forceinline__ void xcd_barrier(const XcdBarrier& b) {
    asm volatile("s_waitcnt vmcnt(0)" ::: "memory");
    __syncthreads();
    if (threadIdx.x == 0) {
        unsigned* bar = b.bar;
        __builtin_amdgcn_s_waitcnt(0);
        unsigned nloc = b.st[0], nx = b.st[1];
        if (nloc == 0u) { xcd_barrier_complete(bar, b.x, nloc, nx); b.st[0] = nloc; b.st[1] = nx; }
        const unsigned old = xb_add(&bar[XB_XSUB(b.x)], 1u);
        const unsigned gen = old / nloc;
        if (old + 1u == (gen + 1u) * nloc) {
            __builtin_amdgcn_fence(__ATOMIC_RELEASE, "agent");
            asm volatile("s_waitcnt vmcnt(0)" ::: "memory");
            const unsigned og = xb_add(&bar[XB_TOP], 1u);
            const unsigned tg = og / nx;
            if (og + 1u == (tg + 1u) * nx) xb_add(&bar[XB_TOPGEN], 1u);
            else XB_SPIN(xb_ld(&bar[XB_TOPGEN]) == tg, bar);
            __builtin_amdgcn_fence(__ATOMIC_ACQUIRE, "agent");
            xb_add(&bar[XB_XGEN(b.x)], 1u);
            asm volatile("s_waitcnt vmcnt(0)" ::: "memory");
        } else {
            XB_SPIN(xb_ld(&bar[XB_XGEN(b.x)]) == gen, bar);
            __builtin_amdgcn_fence(__ATOMIC_ACQUIRE, "agent");
            asm volatile("s_waitcnt vmcnt(0)" ::: "memory");
        }
    }
    __syncthreads();
}

struct Args { const void* in[19]; float* out; unsigned char* ws; int ph_lo, ph_hi; };
static_assert(sizeof(Args) == 19 * 8 + 8 + 8 + 8, "Args has no padding");

struct Frame { LAS unsigned char* lds; int tid, lane, wave, vcu, G; const Args* ap; };

enum { MAP_ID = 0, MAP_CONV = 1, MAP_MLAIN = 2, MAP_QUP = 3, MAP_UCOPY = 4 };
__device__ __forceinline__ int map_row(int mapid, int s) {
    if (mapid == MAP_ID) return s;
    if (mapid == MAP_CONV) { const int kind = s >> 11, j = s & 2047, pn = j >> 6, jl = j & 63;
        const int wchi = (kind == 1 || kind == 2) ? 1 : 0, bj = (kind >= 2) ? 1 : 0;
        return pn * 256 + bj * 128 + (wchi * 2 + (jl >> 5)) * 32 + (jl & 31); }
    if (mapid == MAP_MLAIN) {
        if (s < QL) return 256 + s;
        if (s < QL + KVL) return s - QL;
        if (s < QL + KVL + RD) { const int e = s - (QL + KVL), half = e >> 5, ii = e & 31; return 640 + 32 * (ii >> 4) + 8 * ((ii >> 2) & 3) + 4 * half + (ii & 3); }
        return 768 + (s - (QL + KVL + RD)); }
    { const int h = s / 192, d = s % 192, hh = h >> 3, h8 = h & 7;
        if (d < DN) return hh * 1536 + h8 * DN + d;
        const int e = d - DN, half = e >> 5, ii = e & 31, tr = h8 >> 2, hl = h8 & 3, bj = hl >> 1, wc = (hl & 1) * 2 + (ii >> 4);
        return hh * 1536 + 1024 + tr * 256 + bj * 128 + wc * 32 + 8 * ((ii >> 2) & 3) + 4 * half + (ii & 3); }
}
struct PrepItem { const float* src; const float* gk; bf16* dst; int Nsrc, ldd, mapid, n0; };
__device__ __forceinline__ PrepItem prep_decode(const Args* ap, int it) {
    unsigned char* ws = ap->ws;
#define AIN(i) ((const float*)ap->in[i])
    constexpr int I_PIN = 16 * 128, I_PGRP = 8 * 16, I_POUT = 32 * 32, I_CIN = 16 * 256, I_COUT = 32 * 32, I_MIN = 16 * 86, I_QUP = 6 * 96, I_KVUP = 4 * 128;
    constexpr int I_POOL = I_PIN + 4 * I_PGRP + I_POUT;
    const float* W; const float* gk = nullptr; bf16* WT; int Nsrc, ldd, mapid = MAP_ID; int r = it; bool ispin = false; int jpin = 0;
    if (r < 2 * I_POOL) { const int j = r / I_POOL; r -= j * I_POOL; unsigned char* wb = ws + (j ? WS_WPOOL1 : WS_WPOOL0);
        if (r < I_PIN) { W = AIN(3) + (size_t)j * DM * 4096; Nsrc = 4096; gk = AIN(2) + j * DM; WT = (bf16*)(wb + WPOOL_IN); ldd = DM; ispin = true; jpin = j; }
        else if (r < I_PIN + 4 * I_PGRP) { r -= I_PIN; const int g = r / I_PGRP; r -= g * I_PGRP; W = AIN(4) + ((size_t)j * 4 + g) * 512 * 512; Nsrc = 512; WT = (bf16*)(ws + WS_WGRPA) + ((size_t)j * 4 + g) * 512 * 512; ldd = 512; }
        else { r -= I_PIN + 4 * I_PGRP; W = AIN(6) + (size_t)j * EI * DM; Nsrc = DM; WT = (bf16*)(wb + WPOOL_OUT); ldd = EI; } }
    else { r -= 2 * I_POOL;
        if (r < I_CIN) { W = AIN(8); Nsrc = 8192; gk = AIN(7); WT = (bf16*)(ws + WS_WCONV_IN); ldd = DM; mapid = MAP_CONV; }
        else if (r < I_CIN + I_COUT) { r -= I_CIN; W = AIN(10); Nsrc = DM; WT = (bf16*)(ws + WS_WCONV_OUT); ldd = EI; }
        else if (r < I_CIN + I_COUT + I_MIN) { r -= I_CIN + I_COUT; W = AIN(12); Nsrc = MLA_IN; gk = AIN(11); WT = (bf16*)(ws + WS_WMLA_B1); ldd = DM; mapid = MAP_MLAIN; }
        else if (r < I_CIN + I_COUT + I_MIN + I_QUP) { r -= I_CIN + I_COUT + I_MIN; W = AIN(14); Nsrc = 3072; gk = AIN(13); WT = (bf16*)(ws + WS_WMLA_QUP); ldd = QL; mapid = MAP_QUP; }
        else if (r < I_CIN + I_COUT + I_MIN + I_QUP + I_KVUP) { r -= I_CIN + I_COUT + I_MIN + I_QUP; W = AIN(16); Nsrc = 4096; gk = AIN(15); WT = (bf16*)(ws + WS_WMLA_KVUP); ldd = KVL; }
        else { r -= I_CIN + I_COUT + I_MIN + I_QUP + I_KVUP; W = AIN(17); Nsrc = DM; WT = (bf16*)(ws + WS_WMLA_OUT); ldd = EI; } }
#undef AIN
    const int nblk = Nsrc / 32, kb = r / nblk, nb = r % nblk, k0 = 64 * kb, n0 = 32 * nb;
    PrepItem d; d.src = W + (size_t)k0 * Nsrc + n0; d.gk = gk ? gk + k0 : nullptr; d.dst = WT + k0; d.Nsrc = Nsrc; d.ldd = ldd; d.mapid = mapid; d.n0 = n0;
    if (ispin && n0 < EI) { d.mapid = MAP_UCOPY; d.dst = (bf16*)(ws + WS_A1) + (size_t)jpin * 4 * DM * 512 + (size_t)k0 * 512; }
    return d;
}
__device__ __forceinline__ void prep_load(const PrepItem& d, float (&v)[32], int lane) {
    const float* p = d.src + (size_t)(lane >> 5) * d.Nsrc + (lane & 31);
#pragma unroll
    for (int i = 0; i < 32; ++i) v[i] = p[(size_t)(2 * i) * d.Nsrc];
}
__device__ __forceinline__ void prep_store(const PrepItem& d, const float (&v)[32], LAS float* scr, int lane) {
    const int c = lane & 7;
    f32x4 g0 = (f32x4){1.f, 1.f, 1.f, 1.f}, g1 = g0;
    if (d.gk) { g0 = *(const f32x4*)(d.gk + 8 * c); g1 = *(const f32x4*)(d.gk + 8 * c + 4); }
#pragma unroll
    for (int i = 0; i < 32; ++i) scr[(2 * i + (lane >> 5)) * 33 + (lane & 31)] = v[i];
    LDS_WAIT(); asm volatile("" ::: "memory");
    if (d.mapid == MAP_UCOPY) {
        const float gkv = d.gk[lane]; bf16* o = d.dst + (size_t)(d.n0 >> 9) * DM * 512 + (size_t)lane * 512 + (d.n0 & 511); const LAS float* s = scr + lane * 33;
#pragma unroll
        for (int ch = 0; ch < 4; ++ch) { v4u w; w.x = cvt_pk_bf16(s[8 * ch] * gkv, s[8 * ch + 1] * gkv); w.y = cvt_pk_bf16(s[8 * ch + 2] * gkv, s[8 * ch + 3] * gkv);
            w.z = cvt_pk_bf16(s[8 * ch + 4] * gkv, s[8 * ch + 5] * gkv); w.w = cvt_pk_bf16(s[8 * ch + 6] * gkv, s[8 * ch + 7] * gkv); *(GAS v4u*)(o + 8 * ch) = w; }
        LDS_WAIT(); asm volatile("" ::: "memory"); return; }
#pragma unroll
    for (int j = 0; j < 4; ++j) { const int n = (lane >> 3) + 8 * j; const LAS float* s = scr + (8 * c) * 33 + n;
        v4u o; o.x = cvt_pk_bf16(s[0 * 33] * g0[0], s[1 * 33] * g0[1]); o.y = cvt_pk_bf16(s[2 * 33] * g0[2], s[3 * 33] * g0[3]);
        o.z = cvt_pk_bf16(s[4 * 33] * g1[0], s[5 * 33] * g1[1]); o.w = cvt_pk_bf16(s[6 * 33] * g1[2], s[7 * 33] * g1[3]);
        *(GAS v4u*)(d.dst + (size_t)map_row(d.mapid, d.n0 + n) * d.ldd + 8 * c) = o; }
    LDS_WAIT(); asm volatile("" ::: "memory");
}
#define INP(i) ((const float*)F.ap->in[i])
__device__ __forceinline__ void p0_prologue(Frame& F) {
    unsigned char* ws = F.ap->ws;
    LAS float* scr = (LAS float*)(F.lds + RING_OFF + F.wave * 16384);
    const int gw = F.vcu * NWAVES + F.wave, NGW = F.G * NWAVES;
    constexpr int NITEMS = 2 * (16 * 128 + 4 * 8 * 16 + 32 * 32) + 16 * 256 + 32 * 32 + 16 * 86 + 6 * 96 + 4 * 128 + 32 * 32;
    { int it = gw; float va[32], vb[32]; PrepItem da, db;
      if (it < NITEMS) { da = prep_decode(F.ap, it); prep_load(da, va, F.lane); }
      while (it < NITEMS) {
          const int itb = it + NGW; if (itb < NITEMS) { db = prep_decode(F.ap, itb); prep_load(db, vb, F.lane); }
          prep_store(da, va, scr, F.lane);
          if (itb >= NITEMS) break;
          const int ita = itb + NGW; if (ita < NITEMS) { da = prep_decode(F.ap, ita); prep_load(da, va, F.lane); }
          prep_store(db, vb, scr, F.lane);
          it = ita; } }
    for (int i = gw * 64 + F.lane; i < 64 * 128; i += NGW * 64) *(GAS v4u*)((bf16*)(ws + WS_WMLA_B1) + (size_t)704 * DM + (size_t)i * 8) = (v4u){0u, 0u, 0u, 0u};
}

__device__ __forceinline__ void p0_xb_rope(Frame& F, int wi, int nw) {
    unsigned char* ws = F.ap->ws;
    const int gw = wi * NWAVES + F.wave, NGW = nw * NWAVES;
    { const float* x = INP(0); bf16* XB = (bf16*)(ws + WS_XB); float* SSQ = (float*)(ws + WS_SSQ);
      for (int m = gw; m < M; m += 2 * NGW) { const int m2 = m + NGW; const bool two = m2 < M;
          const GAS f32x4* xr = (const GAS f32x4*)(x + (size_t)m * DM) + F.lane; const GAS f32x4* xr2 = (const GAS f32x4*)(x + (size_t)(two ? m2 : m) * DM) + F.lane; f32x4 v[4], w[4];
#pragma unroll
          for (int j = 0; j < 4; ++j) v[j] = xr[64 * j];
#pragma unroll
          for (int j = 0; j < 4; ++j) w[j] = xr2[64 * j];
          float s = 0.f, s2 = 0.f;
#pragma unroll
          for (int j = 0; j < 4; ++j) { s += (v[j].x * v[j].x + v[j].y * v[j].y) + (v[j].z * v[j].z + v[j].w * v[j].w); s2 += (w[j].x * w[j].x + w[j].y * w[j].y) + (w[j].z * w[j].z + w[j].w * w[j].w); }
          s = wave_sum(s); s2 = wave_sum(s2);
          GAS v2u* o8 = (GAS v2u*)(XB + (size_t)m * DM) + F.lane;
#pragma unroll
          for (int j = 0; j < 4; ++j) o8[64 * j] = (v2u){cvt_pk_bf16(v[j].x, v[j].y), cvt_pk_bf16(v[j].z, v[j].w)};
          if (F.lane < 16) SSQ[(size_t)m * 16 + F.lane] = F.lane == 0 ? s : 0.f;
          if (two) { GAS v2u* p8 = (GAS v2u*)(XB + (size_t)m2 * DM) + F.lane;
#pragma unroll
              for (int j = 0; j < 4; ++j) p8[64 * j] = (v2u){cvt_pk_bf16(w[j].x, w[j].y), cvt_pk_bf16(w[j].z, w[j].w)};
              if (F.lane < 16) SSQ[(size_t)m2 * 16 + F.lane] = F.lane == 0 ? s2 : 0.f; } } }
    { const int* pos = (const int*)F.ap->in[1]; float* COS = (float*)(ws + WS_COS); float* SIN = (float*)(ws + WS_SIN);
      for (int e = wi * (NWAVES * 64) + F.tid; e < M * 32; e += nw * NWAVES * 64) { const int row = e >> 5, i = e & 31;
          const float invf = powf(ROPE_BASE, -(float)(2 * i) / (float)RD); const float ang = (float)pos[row] * invf;
          const double a = (double)ang; const double n = __builtin_rint(a * 0.15915494309189535); const float r = (float)__builtin_fma(n, -6.283185307179586, a);
          COS[e] = cosf(r); SIN[e] = sinf(r); } }
}

template <int W>
__device__ __forceinline__ void pool_rows(const v4u (&v)[23], const v4u (&z)[8], int t0, bf16* out_base) {
    float s[8];
#pragma unroll
    for (int c = 0; c < 8; ++c) s[c] = 0.f;
#pragma unroll
    for (int j = 0; j < W; ++j) { const v4u w = v[15 - j];
        s[0] += bflo(w.x); s[1] += bfhi(w.x); s[2] += bflo(w.y); s[3] += bfhi(w.y); s[4] += bflo(w.z); s[5] += bfhi(w.z); s[6] += bflo(w.w); s[7] += bfhi(w.w); }
#pragma unroll
    for (int i = 0; i < 8; ++i) {
        const int t = t0 + i; const float inv = __builtin_amdgcn_rcpf((float)(t + 1 < W ? t + 1 : W));
        const v4u cu = v[15 + i], g = z[i];
        const float o0 = (s[0] * inv - bflo(cu.x)) * bflo(g.x), o1 = (s[1] * inv - bfhi(cu.x)) * bfhi(g.x), o2 = (s[2] * inv - bflo(cu.y)) * bflo(g.y), o3 = (s[3] * inv - bfhi(cu.y)) * bfhi(g.y);
        const float o4 = (s[4] * inv - bflo(cu.z)) * bflo(g.z), o5 = (s[5] * inv - bfhi(cu.z)) * bfhi(g.z), o6 = (s[6] * inv - bflo(cu.w)) * bflo(g.w), o7 = (s[7] * inv - bfhi(cu.w)) * bfhi(g.w);
        *(GAS v4u*)(out_base + (size_t)i * EI) = (v4u){cvt_pk_bf16(o0, o1), cvt_pk_bf16(o2, o3), cvt_pk_bf16(o4, o5), cvt_pk_bf16(o6, o7)};
        if (i < 7) { const v4u a = v[16 + i], d = v[16 + i - W];
            s[0] += bflo(a.x) - bflo(d.x); s[1] += bfhi(a.x) - bfhi(d.x); s[2] += bflo(a.y) - bflo(d.y); s[3] += bfhi(a.y) - bfhi(d.y);
            s[4] += bflo(a.z) - bflo(d.z); s[5] += bfhi(a.z) - bfhi(d.z); s[6] += bflo(a.w) - bflo(d.w); s[7] += bfhi(a.w) - bfhi(d.w); }
        asm volatile("" ::: "memory");
    }
}
template <int W>
__device__ __forceinline__ void pool_mix_group(Frame& F, const bf16* V, bf16* SZ, int g, const __amdgpu_buffer_rsrc_t rv, const __amdgpu_buffer_rsrc_t rz) {
    const int cb = F.tid & 15, rb = F.tid >> 4;
    for (int unit = F.vcu; unit < 64 * 4; unit += F.G) {
        const int pm = unit >> 2, cs = 4 * g + (unit & 3), col = cs * 128 + cb * 8;
        const int r0 = pm * 256 + rb * 8, t0 = r0 & (SEQ - 1);
        const int voff = (r0 * EI + col) * 2;
        v4u v[23], z[8];
#pragma unroll
        for (int i = 0; i < 23; ++i) { const int dr = i - 15; if (t0 + dr >= 0) v[i] = __builtin_amdgcn_raw_buffer_load_b128(rv, voff, i * EI * 2, 0); else v[i] = (v4u){0u, 0u, 0u, 0u}; }
#pragma unroll
        for (int i = 0; i < 8; ++i) z[i] = __builtin_amdgcn_raw_buffer_load_b128(rz, voff, i * EI * 2, 0);
        pool_rows<W>(v, z, t0, SZ + (size_t)r0 * EI + col);
        asm volatile("" ::: "memory");
    }
}
__device__ __forceinline__ void pool_mix_phase(Frame& F, const bf16* V, bf16* SZ) {
    const __amdgpu_buffer_rsrc_t rv = __builtin_amdgcn_make_buffer_rsrc((void*)(V - (size_t)15 * EI), 0, (int)(((size_t)M + 15) * EI * 2), 0x00020000);
    const __amdgpu_buffer_rsrc_t rz = __builtin_amdgcn_make_buffer_rsrc((void*)SZ, 0, (int)((size_t)M * EI * 2), 0x00020000);
    pool_mix_group<2>(F, V, SZ, 0, rv, rz); pool_mix_group<4>(F, V, SZ, 1, rv, rz); pool_mix_group<8>(F, V, SZ, 2, rv, rz); pool_mix_group<16>(F, V, SZ, 3, rv, rz);
}
__device__ __forceinline__ void conv_mix_phase(Frame& F, const bf16* CH, bf16* BZ, const float* cw) {
    const int cb = F.tid & 31, rb = F.tid >> 5;
    for (int unit = F.vcu; unit < 64 * 8; unit += F.G) {
        const int pm = unit >> 3, cs = unit & 7, col = cs * 256 + cb * 8;
        const int r0 = pm * 256 + rb * 16, t0 = r0 & (SEQ - 1);
        float w[3][8];
#pragma unroll
        for (int j = 0; j < 3; ++j) { const f32x4 a = *(const GAS f32x4*)(cw + j * EI + col), b = *(const GAS f32x4*)(cw + j * EI + col + 4);
            w[j][0] = a[0]; w[j][1] = a[1]; w[j][2] = a[2]; w[j][3] = a[3]; w[j][4] = b[0]; w[j][5] = b[1]; w[j][6] = b[2]; w[j][7] = b[3]; }
        v4u c[18];
#pragma unroll
        for (int i = 0; i < 18; ++i) { const int dr = i - 2; if (t0 + dr >= 0) c[i] = *(const GAS v4u*)(CH + (size_t)(r0 + dr) * EI + col); else c[i] = (v4u){0u, 0u, 0u, 0u}; }
#pragma unroll
        for (int i = 0; i < 16; ++i) { bf16* p = BZ + (size_t)(r0 + i) * EI + col; const v4u z = *(const GAS v4u*)p; const v4u x0 = c[i], x1 = c[i + 1], x2 = c[i + 2];
            float o[8];
#define CV(k, X0, X1, X2, Z) o[k] = (Z) * (w[0][k] * (X0) + w[1][k] * (X1) + w[2][k] * (X2))
            CV(0, bflo(x0.x), bflo(x1.x), bflo(x2.x), bflo(z.x)); CV(1, bfhi(x0.x), bfhi(x1.x), bfhi(x2.x), bfhi(z.x));
            CV(2, bflo(x0.y), bflo(x1.y), bflo(x2.y), bflo(z.y)); CV(3, bfhi(x0.y), bfhi(x1.y), bfhi(x2.y), bfhi(z.y));
            CV(4, bflo(x0.z), bflo(x1.z), bflo(x2.z), bflo(z.z)); CV(5, bfhi(x0.z), bfhi(x1.z), bfhi(x2.z), bfhi(z.z));
            CV(6, bflo(x0.w), bflo(x1.w), bflo(x2.w), bflo(z.w)); CV(7, bfhi(x0.w), bfhi(x1.w), bfhi(x2.w), bfhi(z.w));
#undef CV
            *(GAS v4u*)p = (v4u){cvt_pk_bf16(o[0], o[1]), cvt_pk_bf16(o[2], o[3]), cvt_pk_bf16(o[4], o[5]), cvt_pk_bf16(o[6], o[7])}; }
    }
}
__device__ __forceinline__ void final_norm_phase(Frame& F, float* X, const float* gain) {
    const int gw = F.vcu * NWAVES + F.wave, NGW = F.G * NWAVES;
    f32x4 gv[4];
#pragma unroll
    for (int j = 0; j < 4; ++j) gv[j] = *((const GAS f32x4*)gain + F.lane + 64 * j);
    for (int m = gw; m < M; m += NGW) { GAS f32x4* xr = (GAS f32x4*)(X + (size_t)m * DM) + F.lane; f32x4 v[4]; float s = 0.f;
#pragma unroll
        for (int j = 0; j < 4; ++j) { v[j] = xr[64 * j]; s += (v[j].x * v[j].x + v[j].y * v[j].y) + (v[j].z * v[j].z + v[j].w * v[j].w); }
        const float rs = 1.0f / sqrtf(wave_sum(s) * (1.0f / DM) + NORM_EPS);
#pragma unroll
        for (int j = 0; j < 4; ++j) xr[64 * j] = v[j] * rs * gv[j]; }
}

__device__ __forceinline__ void run_phase(Frame& F, int ph) {
    { int t_ = threadIdx.x; asm volatile("" : "+v"(t_)); F.tid = t_; F.lane = t_ & 63; F.wave = __builtin_amdgcn_readfirstlane(t_ >> 6); }
    unsigned char* ws = F.ap->ws; const int bid = (int)blockIdx.x;
    bf16* XB = (bf16*)(ws + WS_XB); bf16* A1 = (bf16*)(ws + WS_A1); bf16* A2 = (bf16*)(ws + WS_A2);
    float* SSQ = (float*)(ws + WS_SSQ); float* X = F.ap->out;
    const float* COS = (const float*)(ws + WS_COS); const float* SIN = (const float*)(ws + WS_SIN);
    LAS unsigned char* ring = F.lds + RING_OFF;
    if (ph == 0) { p0_prologue(F); return; }
    if (ph == 1) {
        constexpr int NPROD = 64;
        if (bid < NPROD || F.G <= NPROD) {
            pg8::Gemm g{(const bf16*)(ws + WS_WGRPA), A1, 512, 512, 512, 0, 0, 2, DM * 512}; pg8::StaticOrder S; S.init(4096, DM, F.G < NPROD ? F.G : NPROD, bid);
            epi::EpiW E{(bf16*)(ws + WS_WPOOL0 + WPOOL_IN), (bf16*)(ws + WS_WPOOL1 + WPOOL_IN)};
            pg8::gemm_phase<epi::EpiW, pg8::StaticOrder, true>(ring, g, S, E); }
        if (F.G <= NPROD) p0_xb_rope(F, bid, F.G); else if (bid >= NPROD) p0_xb_rope(F, bid - NPROD, F.G - NPROD);
        return; }
    if (ph == 16) { final_norm_phase(F, X, INP(18)); return; }
    const bool pool = (ph >= 2 && ph <= 4) || (ph >= 13 && ph <= 15);
    const int j = ph >= 13 ? 1 : 0, pp = pool ? (ph >= 13 ? ph - 13 : ph - 2) : -1;
    unsigned char* wpool = ws + (j ? WS_WPOOL1 : WS_WPOOL0);
    if (pool && pp == 0) {
        pg8::Gemm g{XB, (const bf16*)(wpool + WPOOL_IN), DM, DM, DM, 0, 0, 0, 0}; pg8::StaticOrder S; S.init(M, 4096, F.G, bid);
        epi::EpiPoolIn E{A1, A2, SSQ, INP(5) + j * EI};
        pg8::gemm_phase<epi::EpiPoolIn, pg8::StaticOrder, true>(ring, g, S, E); return; }
    if (pool && pp == 1) { pool_mix_phase(F, A1, A2); return; }
    if ((pool && pp == 2) || ph == 7 || ph == 12) {
        const bf16* Y = ph == 12 ? A1 : A2;
        const bf16* Wt = pool ? (const bf16*)(wpool + WPOOL_OUT) : ph == 7 ? (const bf16*)(ws + WS_WCONV_OUT) : (const bf16*)(ws + WS_WMLA_OUT);
        pg8::Gemm g{Y, Wt, EI, EI, EI, 0, 0, 0, 0}; pg8::StaticOrder S; S.init(M, DM, F.G, bid);
        if (ph == 4) { epi::EpiResid<true, false> E{INP(0), nullptr, XB, SSQ}; pg8::gemm_phase<epi::EpiResid<true, false>, pg8::StaticOrder, false>(ring, g, S, E); }
        else if (ph == 15) { epi::EpiResid<false, true> E{nullptr, X, XB, SSQ}; pg8::gemm_phase<epi::EpiResid<false, true>, pg8::StaticOrder, false>(ring, g, S, E); }
        else { epi::EpiResid<false, false> E{nullptr, nullptr, XB, SSQ}; pg8::gemm_phase<epi::EpiResid<false, false>, pg8::StaticOrder, false>(ring, g, S, E); }
        return; }
    if (ph == 5) {
        pg8::Gemm g{XB, (const bf16*)(ws + WS_WCONV_IN), DM, DM, DM, 0, 0, 0, 0}; pg8::StaticOrder S; S.init(M, 8192, F.G, bid);
        epi::EpiConvIn E{A1, A2, SSQ};
        pg8::gemm_phase<epi::EpiConvIn, pg8::StaticOrder, true>(ring, g, S, E); return; }
    if (ph == 6) { conv_mix_phase(F, A1, A2, INP(9)); return; }
    bf16* KVLAT = (bf16*)(ws + WS_KVLAT); bf16* QLAT = (bf16*)(ws + WS_QLAT); bf16* KROPE = (bf16*)(ws + WS_KROPE); bf16* QR = (bf16*)(ws + WS_QR);
    float* SSQQ = (float*)(ws + WS_SSQQ); float* SSQKV = (float*)(ws + WS_SSQKV);
    bf16* KV1 = (bf16*)X;
    if (ph == 8) {
        pg8::Gemm g{XB, (const bf16*)(ws + WS_WMLA_B1), DM, DM, DM, 0, 0, 0, 0}; pg8::StaticOrder S; S.init(M, 768, F.G, bid);
        epi::EpiMlaIn E{KVLAT, QLAT, KROPE, SSQKV, SSQQ, SSQ, COS, SIN};
        pg8::gemm_phase<epi::EpiMlaIn, pg8::StaticOrder, false>(ring, g, S, E); return; }
    if (ph == 9) {
        { pg8::Gemm g{QLAT, (const bf16*)(ws + WS_WMLA_QUP), QL, QL, QL, 0, 0, 0, 0}; pg8::StaticOrder S; S.init(M, 3072, F.G, bid);
          epi::EpiQUp E{A1, QR, SSQQ, COS, SIN};
          pg8::gemm_phase<epi::EpiQUp, pg8::StaticOrder, true>(ring, g, S, E); }
        { pg8::Gemm g{KVLAT, (const bf16*)(ws + WS_WMLA_KVUP), KVL, KVL, KVL, 0, 0, 0, 0}; pg8::StaticOrder S; S.init(M, 4096, F.G, bid);
          epi::EpiKvUp E{A2, KV1, SSQKV};
          pg8::gemm_phase<epi::EpiKvUp, pg8::StaticOrder, true>(ring, g, S, E); }
        return; }
    if (ph == 10) { att::attn_phase((char*)ring, A1, QR, A2, KV1, KROPE, A1, bid, F.G); return; }
    if (ph == 11) {
        pg8::Gemm g{XB, (const bf16*)(ws + WS_WMLA_B1) + (size_t)768 * DM, DM, DM, DM, 0, 0, 0, 0}; pg8::StaticOrder S; S.init(M, EI, F.G, bid);
        epi::EpiGate E{A1, SSQ};
        pg8::gemm_phase<epi::EpiGate, pg8::StaticOrder, true>(ring, g, S, E); return; }
}

__global__ void __launch_bounds__(NWAVES * 64, 2) trunk_fwd(Args args) {
    extern __shared__ __attribute__((aligned(16))) unsigned char lds[];
    Frame F;
    F.lds = (LAS unsigned char*)lds; F.ap = &args;
    F.tid = threadIdx.x; F.lane = F.tid & 63; F.wave = __builtin_amdgcn_readfirstlane(F.tid >> 6);
    F.G = gridDim.x; { const int bx = blockIdx.x; F.vcu = (F.G % 8 == 0) ? (bx % 8) * (F.G / 8) + bx / 8 : bx; }
    for (int u = F.tid; u < (LDS_BYTES - LDSCTL_OFF) / 4; u += NWAVES * 64) ((LAS unsigned*)(F.lds + LDSCTL_OFF))[u] = 0u;
    __syncthreads();
    XcdBarrier bar; bar.bar = (unsigned*)(args.ws + WS_CTL) + CW_BAR; bar.x = 0; bar.st = nullptr;
    if (N_LAUNCHES == 1) bar = xcd_barrier_post((unsigned*)(args.ws + WS_CTL) + CW_BAR, (volatile LAS unsigned*)(F.lds + MISC_OFF) + 8);
    const int lo = args.ph_lo, hi = args.ph_hi;
#define PHASE(k) if (lo <= (k) && (k) < hi) { run_phase(F, (k)); if ((k) + 1 < hi) { if (N_LAUNCHES == 1) xcd_barrier(bar); } }
    PHASE(0)
    PHASE(1)
    PHASE(2)
    PHASE(3)
    PHASE(4)
    PHASE(5)
    PHASE(6)
    PHASE(7)
    PHASE(8)
    PHASE(9)
    PHASE(10)
    PHASE(11)
    PHASE(12)
    PHASE(13)
    PHASE(14)
    PHASE(15)
    PHASE(16)
#undef PHASE
}


extern "C" void kernel_launch(void* const* d_in, const int* in_sizes, int n_in, void* d_out, int out_size, void* d_ws, size_t ws_size, hipStream_t stream) {
    static int grid = 0;
    if (grid == 0) {
        if (n_in != 19 || in_sizes[0] != M * DM || out_size != M * DM || ws_size < WS_END) {
            fprintf(stderr, "kernel_launch: built for 19 inputs, x/out of %d floats, >= %zu bytes of workspace; got n_in %d, in0 %d, out %d, ws %zu; nothing launched\n", M * DM, (size_t)WS_END, n_in, n_in > 0 ? in_sizes[0] : -1, out_size, ws_size);
            grid = -1; return; }
        int dev = 0, cus = 0;
        if (hipGetDevice(&dev) != hipSuccess || hipDeviceGetAttribute(&cus, hipDeviceAttributeMultiprocessorCount, dev) != hipSuccess) { fprintf(stderr, "kernel_launch: device query failed\n"); grid = -1; return; }
        if (hipFuncSetAttribute((const void*)trunk_fwd, hipFuncAttributeMaxDynamicSharedMemorySize, LDS_BYTES) != hipSuccess) { fprintf(stderr, "kernel_launch: hipFuncSetAttribute failed\n"); grid = -1; return; }
        int per_cu = 0;
        if (hipOccupancyMaxActiveBlocksPerMultiprocessor(&per_cu, (const void*)trunk_fwd, NWAVES * 64, LDS_BYTES) != hipSuccess || per_cu < 1)
            fprintf(stderr, "kernel_launch: note: occupancy query reports %d workgroups per CU\n", per_cu);
        (void)hipGetLastError();
        grid = cus;
    }
    if (grid < 0) return;
    if (hipMemsetAsync((char*)d_ws + WS_CTL, 0, CTL_ZERO_BYTES, stream) != hipSuccess) { fprintf(stderr, "kernel_launch: hipMemsetAsync failed\n"); return; }
    Args a{};
    for (int i = 0; i < 19; ++i) a.in[i] = d_in[i];
    a.out = (float*)d_out; a.ws = (unsigned char*)d_ws;
#if MK_DEBUG
    dbg_launch_all(a, grid, stream);
#else
    for (int li = 0; li < N_LAUNCHES; ++li) {
        a.ph_lo = (N_LAUNCHES == NPH) ? li : 0; a.ph_hi = (N_LAUNCHES == NPH) ? li + 1 : NPH;
        hipLaunchKernelGGL(trunk_fwd, dim3(grid), dim3(NWAVES * 64), LDS_BYTES, stream, a);
        const hipError_t le = hipPeekAtLastError();
        if (le != hipSuccess) { fprintf(stderr, "kernel_launch: launch %d failed: %s\n", li, hipGetErrorName(le)); break; }
    }
#endif
}
```
